# Optimizing an MI355X kernel written in HIP

```python
import math
import jax, jax.numpy as jnp
from jax import lax
import numpy as np


D_MODEL = 2048
BATCH = 1
SEQ = 16384
DEPTH = 4

HEAD_DIM = 128
ROPE_THETA = 10000.0
RMS_EPS = 1e-6
Q_BLOCK = 128
GRID_W = 64
MLA_HEADS = 4
MLA_Q_LORA = 512
MLA_KV_LORA = 512
MLA_NOPE = 128
MLA_ROPE = 64
MLA_V = 128
DIFF_HEADS = 4
DIFF_QK = HEAD_DIM // 2
SWA_HEADS = 4
SWA_KV_HEADS = 2
SWA_WINDOW = 128
SWA_BLOCK = 128
AX_HEADS = 4
AX_KV_HEADS = 2
N_BRANCH = 4
BRANCH_W = 4 * HEAD_DIM
FFN_DIM = ((8 * D_MODEL + 3 * 256 - 1) // (3 * 256)) * 256
PLE_DIM = 256

MLA_COLS = MLA_Q_LORA + MLA_KV_LORA + MLA_ROPE
DIFF_COLS = 3 * DIFF_HEADS * HEAD_DIM
SWA_COLS = (SWA_HEADS + 2 * SWA_KV_HEADS) * HEAD_DIM
AX_COLS = (AX_HEADS + 2 * AX_KV_HEADS) * HEAD_DIM
IN_COLS = MLA_COLS + DIFF_COLS + SWA_COLS + AX_COLS
IN_SPLITS = (MLA_COLS, MLA_COLS + DIFF_COLS, MLA_COLS + DIFF_COLS + SWA_COLS)

kernel_name = 'hybrid_parallel_gated_encoder'


def _rmsnorm(x, g):
    xf = x.astype(jnp.float32)
    y = xf * lax.rsqrt(jnp.mean(xf * xf, axis=-1, keepdims=True) + RMS_EPS)
    return (y * g.astype(jnp.float32)).astype(x.dtype)


def _rope_tables(pos, dim):
    inv_freq = ROPE_THETA ** (-jnp.arange(0, dim, 2, dtype=jnp.float32) / dim)
    ang = pos.astype(jnp.float32)[:, None] * inv_freq[None, :]
    return jnp.cos(ang), jnp.sin(ang)


def _apply_rope(x, cs):
    cos, sin = cs
    c = cos[None, :, None, :].astype(x.dtype)
    s = sin[None, :, None, :].astype(x.dtype)
    x1, x2 = jnp.split(x, 2, axis=-1)
    return jnp.concatenate([x1 * c - x2 * s, x2 * c + x1 * s], axis=-1)


def _axial_rope(x, row_cs, col_cs):
    xr, xc = jnp.split(x, 2, axis=-1)
    return jnp.concatenate([_apply_rope(xr, row_cs), _apply_rope(xc, col_cs)], axis=-1)


def _to_blocks(t):
    b, s = t.shape[:2]
    return jnp.swapaxes(t.reshape(b, s // Q_BLOCK, Q_BLOCK, *t.shape[2:]), 0, 1)


def _from_blocks(t):
    nb, b, qb = t.shape[:3]
    return jnp.swapaxes(t, 0, 1).reshape(b, nb * qb, *t.shape[3:])


def _blocked_attention(q, k, v, scale):
    b, s, hq, dk = q.shape
    hkv = k.shape[2]
    qg = q.reshape(b, s, hkv, hq // hkv, dk)

    def step(qb):
        sc = jnp.einsum('bqhgd,bkhd->bhgqk', qb, k).astype(jnp.float32) * scale
        pr = jax.nn.softmax(sc, axis=-1).astype(v.dtype)
        return jnp.einsum('bhgqk,bkhe->bqhge', pr, v)

    out = _from_blocks(lax.map(step, _to_blocks(qg)))
    return out.reshape(b, s, hq * v.shape[-1])


def _banded_attention(q, k, v, sink, scale):
    b, s, hq, d = q.shape
    hkv = k.shape[2]
    g = hq // hkv
    wb = SWA_BLOCK
    nb = s // wb
    qb = q.reshape(b, nb, wb, hkv, g, d)

    def band(t):
        tb = t.reshape(b, nb, wb, hkv, t.shape[-1])
        tp = jnp.pad(tb, ((0, 0), (1, 1), (0, 0), (0, 0), (0, 0)))
        return jnp.concatenate([tp[:, :-2], tp[:, 1:-1], tp[:, 2:]], axis=2)

    kb, vb = band(k), band(v)
    sc = jnp.einsum('bnqhgd,bnkhd->bnhgqk', qb, kb).astype(jnp.float32) * scale
    blk = jnp.arange(nb)
    qpos = blk[:, None] * wb + jnp.arange(wb)[None, :]
    kpos = blk[:, None] * wb - wb + jnp.arange(3 * wb)[None, :]
    rel = kpos[:, None, :] - qpos[:, :, None]
    valid = (jnp.abs(rel) <= SWA_WINDOW) & (kpos[:, None, :] >= 0) & (kpos[:, None, :] < s)
    sc = jnp.where(valid[None, :, None, None], sc, -jnp.inf)
    sink_col = jnp.broadcast_to(sink.astype(jnp.float32).reshape(1, 1, hkv, g, 1, 1), (b, nb, hkv, g, wb, 1))
    pr = jax.nn.softmax(jnp.concatenate([sc, sink_col], axis=-1), axis=-1)[..., :-1]
    out = jnp.einsum('bnhgqk,bnkhd->bnqhgd', pr.astype(v.dtype), vb)
    return out.reshape(b, s, hq * d)


def _mla(z, qa_norm, w_uq, kva_norm, w_ukv, rope_cs):
    b, s, _ = z.shape
    c_q, c_kv, k_r = jnp.split(z, [MLA_Q_LORA, MLA_Q_LORA + MLA_KV_LORA], axis=-1)
    q = (_rmsnorm(c_q, qa_norm) @ w_uq).reshape(b, s, MLA_HEADS, MLA_NOPE + MLA_ROPE)
    q = jnp.concatenate([q[..., :MLA_NOPE], _apply_rope(q[..., MLA_NOPE:], rope_cs)], axis=-1)
    kv = (_rmsnorm(c_kv, kva_norm) @ w_ukv).reshape(b, s, MLA_HEADS, MLA_NOPE + MLA_V)
    k_r = _apply_rope(k_r.reshape(b, s, 1, MLA_ROPE), rope_cs)
    k = jnp.concatenate([kv[..., :MLA_NOPE], jnp.broadcast_to(k_r, (b, s, MLA_HEADS, MLA_ROPE))], axis=-1)
    v = kv[..., MLA_NOPE:]
    return _blocked_attention(q, k, v, (MLA_NOPE + MLA_ROPE) ** -0.5)


def _diff(z, lam_params, subln, lam_init, rope_cs):
    b, s, _ = z.shape
    hw = DIFF_HEADS * HEAD_DIM
    q, k, v = jnp.split(z, [hw, 2 * hw], axis=-1)
    q = _apply_rope(q.reshape(b, s, DIFF_HEADS * 2, DIFF_QK), rope_cs).reshape(b, s, DIFF_HEADS, 2, DIFF_QK)
    k = _apply_rope(k.reshape(b, s, DIFF_HEADS * 2, DIFF_QK), rope_cs).reshape(b, s, DIFF_HEADS, 2, DIFF_QK)
    v = v.reshape(b, s, DIFF_HEADS, HEAD_DIM)
    q1, q2 = q[:, :, :, 0], q[:, :, :, 1]
    k1, k2 = k[:, :, :, 0], k[:, :, :, 1]
    lp = lam_params.astype(jnp.float32)
    lam = jnp.exp(jnp.sum(lp[0] * lp[1])) - jnp.exp(jnp.sum(lp[2] * lp[3])) + lam_init
    scale = DIFF_QK ** -0.5

    def step(blk):
        q1b, q2b = blk
        a1 = jax.nn.softmax(jnp.einsum('bqhd,bkhd->bhqk', q1b, k1).astype(jnp.float32) * scale, axis=-1)
        a2 = jax.nn.softmax(jnp.einsum('bqhd,bkhd->bhqk', q2b, k2).astype(jnp.float32) * scale, axis=-1)
        return jnp.einsum('bhqk,bkhe->bqhe', (a1 - lam * a2).astype(v.dtype), v)

    o = _from_blocks(lax.map(step, (_to_blocks(q1), _to_blocks(q2))))
    o = _rmsnorm(o, subln) * (1.0 - lam_init)
    return o.reshape(b, s, DIFF_HEADS * HEAD_DIM)


def _swa(z, sink, rope_cs):
    b, s, _ = z.shape
    q, k, v = jnp.split(z, [SWA_HEADS * HEAD_DIM, (SWA_HEADS + SWA_KV_HEADS) * HEAD_DIM], axis=-1)
    q = _apply_rope(q.reshape(b, s, SWA_HEADS, HEAD_DIM), rope_cs)
    k = _apply_rope(k.reshape(b, s, SWA_KV_HEADS, HEAD_DIM), rope_cs)
    v = v.reshape(b, s, SWA_KV_HEADS, HEAD_DIM)
    return _banded_attention(q, k, v, sink, HEAD_DIM ** -0.5)


def _axial(z, q_norm, k_norm, row_cs, col_cs):
    b, s, _ = z.shape
    q, k, v = jnp.split(z, [AX_HEADS * HEAD_DIM, (AX_HEADS + AX_KV_HEADS) * HEAD_DIM], axis=-1)
    q = _axial_rope(_rmsnorm(q.reshape(b, s, AX_HEADS, HEAD_DIM), q_norm), row_cs, col_cs)
    k = _axial_rope(_rmsnorm(k.reshape(b, s, AX_KV_HEADS, HEAD_DIM), k_norm), row_cs, col_cs)
    v = v.reshape(b, s, AX_KV_HEADS, HEAD_DIM)
    return _blocked_attention(q, k, v, HEAD_DIM ** -0.5)


def setup_inputs(seed: int = 0) -> dict:
    key = jax.random.key(seed)
    ks = jax.random.split(key, 24)
    f32 = jnp.float32

    def dense(k, shape, fan_in):
        return jax.random.normal(k, shape, f32) * (fan_in ** -0.5)

    def gain(k, shape):
        return 1.0 + 0.05 * jax.random.normal(k, shape, f32)

    return {
        'x': jax.random.normal(ks[0], (BATCH, SEQ, D_MODEL), f32),
        'p': jax.random.normal(ks[1], (DEPTH, BATCH, SEQ, PLE_DIM), f32),
        'norm_mix_pre': gain(ks[2], (DEPTH, D_MODEL)),
        'norm_mix_post': gain(ks[3], (DEPTH, D_MODEL)),
        'norm_ffn_pre': gain(ks[4], (DEPTH, D_MODEL)),
        'norm_ffn_post': gain(ks[5], (DEPTH, D_MODEL)),
        'norm_ple_post': gain(ks[6], (DEPTH, D_MODEL)),
        'w_in': dense(ks[7], (DEPTH, D_MODEL, IN_COLS), D_MODEL),
        'mla_qa_norm': gain(ks[8], (DEPTH, MLA_Q_LORA)),
        'mla_w_uq': dense(ks[9], (DEPTH, MLA_Q_LORA, MLA_HEADS * (MLA_NOPE + MLA_ROPE)), MLA_Q_LORA),
        'mla_kva_norm': gain(ks[10], (DEPTH, MLA_KV_LORA)),
        'mla_w_ukv': dense(ks[11], (DEPTH, MLA_KV_LORA, MLA_HEADS * (MLA_NOPE + MLA_V)), MLA_KV_LORA),
        'diff_lambda': 0.1 * jax.random.normal(ks[12], (DEPTH, 4, DIFF_QK), f32),
        'diff_subln': gain(ks[13], (DEPTH, HEAD_DIM)),
        'swa_sink': 0.5 * jax.random.normal(ks[14], (DEPTH, SWA_HEADS), f32),
        'ax_q_norm': gain(ks[15], (DEPTH, HEAD_DIM)),
        'ax_k_norm': gain(ks[16], (DEPTH, HEAD_DIM)),
        'w_branch': dense(ks[17], (DEPTH, N_BRANCH, BRANCH_W, D_MODEL), BRANCH_W),
        'w_branch_gate': dense(ks[18], (DEPTH, N_BRANCH, D_MODEL, D_MODEL), D_MODEL),
        'w_o': dense(ks[19], (DEPTH, D_MODEL, D_MODEL), D_MODEL),
        'w_ffn_in': dense(ks[20], (DEPTH, D_MODEL, 2 * FFN_DIM), D_MODEL),
        'w_ffn_out': dense(ks[21], (DEPTH, FFN_DIM, D_MODEL), FFN_DIM),
        'w_ple': dense(ks[22], (DEPTH, PLE_DIM, D_MODEL), PLE_DIM),
        'w_ple_gate': dense(ks[23], (DEPTH, D_MODEL, D_MODEL), D_MODEL),
    }


def reference(x, p, norm_mix_pre, norm_mix_post, norm_ffn_pre, norm_ffn_post, norm_ple_post,
              w_in, mla_qa_norm, mla_w_uq, mla_kva_norm, mla_w_ukv, diff_lambda, diff_subln,
              swa_sink, ax_q_norm, ax_k_norm, w_branch, w_branch_gate, w_o,
              w_ffn_in, w_ffn_out, w_ple, w_ple_gate):
    b, s, _ = x.shape
    rows = s // GRID_W
    t = jnp.arange(s)
    row_pos = jnp.broadcast_to(jnp.arange(rows)[:, None], (rows, GRID_W)).reshape(s)
    col_pos = jnp.broadcast_to(jnp.arange(GRID_W)[None, :], (rows, GRID_W)).reshape(s)
    rope_mla = _rope_tables(t, MLA_ROPE)
    rope_diff = _rope_tables(t, DIFF_QK)
    rope_swa = _rope_tables(t, HEAD_DIM)
    rope_row = _rope_tables(row_pos, HEAD_DIM // 2)
    rope_col = _rope_tables(col_pos, HEAD_DIM // 2)

    for i in range(DEPTH):
        lam_init = 0.8 - 0.6 * math.exp(-0.3 * i)
        h = _rmsnorm(x, norm_mix_pre[i])
        z_a, z_b, z_c, z_d = jnp.split(h @ w_in[i], IN_SPLITS, axis=-1)
        branches = (
            _mla(z_a, mla_qa_norm[i], mla_w_uq[i], mla_kva_norm[i], mla_w_ukv[i], rope_mla),
            _diff(z_b, diff_lambda[i], diff_subln[i], lam_init, rope_diff),
            _swa(z_c, swa_sink[i], rope_swa),
            _axial(z_d, ax_q_norm[i], ax_k_norm[i], rope_row, rope_col),
        )
        merged = jax.nn.sigmoid(h @ w_branch_gate[i, 0]) * (branches[0] @ w_branch[i, 0])
        for j in range(1, N_BRANCH):
            merged = merged + jax.nn.sigmoid(h @ w_branch_gate[i, j]) * (branches[j] @ w_branch[i, j])
        x = x + _rmsnorm(merged @ w_o[i], norm_mix_post[i])
        h = _rmsnorm(x, norm_ffn_pre[i])
        gate, up = jnp.split(h @ w_ffn_in[i], 2, axis=-1)
        x = x + _rmsnorm((jax.nn.silu(gate) * up) @ w_ffn_out[i], norm_ffn_post[i])
        ple = jax.nn.sigmoid(x @ w_ple_gate[i]) * (p[i] @ w_ple[i])
        x = x + _rmsnorm(ple, norm_ple_post[i])
    return x
```

```cpp
#include <hip/hip_runtime.h>
#include <cstdio>
#include <cstdint>
#include <cmath>

#ifndef MK_DEBUG
#define MK_DEBUG 0
#endif

#define GAS __attribute__((address_space(1)))
#define LAS __attribute__((address_space(3)))
typedef unsigned short bf16;
typedef unsigned v4u __attribute__((ext_vector_type(4)));
typedef unsigned v2u __attribute__((ext_vector_type(2)));
typedef float f32x4 __attribute__((ext_vector_type(4)));
typedef float f32x2 __attribute__((ext_vector_type(2)));
typedef short bf16x8 __attribute__((ext_vector_type(8)));
typedef short s16x4 __attribute__((ext_vector_type(4)));
typedef float f32x16 __attribute__((ext_vector_type(16)));
typedef GAS unsigned gu32;
#define RLX_AGENT __ATOMIC_RELAXED, __HIP_MEMORY_SCOPE_AGENT
#define LDS_WAIT() asm volatile("s_waitcnt lgkmcnt(0)" ::: "memory")
#define VM_WAIT() asm volatile("s_waitcnt vmcnt(0)" ::: "memory")

constexpr int S = 16384, D = 2048, DEPTH = 4, FF = 5632, PLE = 256;
constexpr int ZC = 4672, ZP = 4864, NG = 8192, N1 = ZP + NG;
constexpr int Z_CQ = 0, Z_CKV = 512, Z_KR = 1024, Z_DQ = 1088, Z_DK = 1600, Z_DV = 2112, Z_SQ = 2624, Z_SK = 3136, Z_SV = 3392, Z_AQ = 3648, Z_AK = 4160, Z_AV = 4416;
constexpr int QM_P = 768, KVM_P = 1024;
constexpr float RMS_EPS = 1e-6f;
constexpr float LOG2E = 1.4426950408889634f;

constexpr size_t MiB = 1u << 20;
constexpr size_t WS_CTL = 0, CTL_ZERO_BYTES = 1 * MiB;
constexpr size_t WS_TAB64 = 1 * MiB;
constexpr size_t WS_TAB128 = 5 * MiB;
constexpr size_t WS_W = 13 * MiB;
constexpr size_t WL_W1 = 0;
constexpr size_t WL_UQKV = WL_W1 + (size_t)N1 * D;
constexpr size_t WL_BR = WL_UQKV + (size_t)1792 * 512;
constexpr size_t WL_WO = WL_BR + (size_t)4 * D * 512;
constexpr size_t WL_FI = WL_WO + (size_t)D * D;
constexpr size_t WL_FO = WL_FI + (size_t)2 * FF * D;
constexpr size_t WL_PLE = WL_FO + (size_t)D * FF;
constexpr size_t WL_PG = WL_PLE + (size_t)D * PLE;
constexpr size_t WL_ELEMS = WL_PG + (size_t)D * D;
constexpr size_t WL_BYTES = WL_ELEMS * 2;
constexpr size_t WS_PB = WS_W + ((4 * WL_BYTES + MiB - 1) / MiB) * MiB;
constexpr size_t WS_H = WS_PB + 32 * MiB;
constexpr size_t WS_Z = WS_H + 64 * MiB;
constexpr size_t WS_GT = WS_Z + 152 * MiB;
constexpr size_t WS_QM = WS_GT + 256 * MiB;
constexpr size_t WS_KVM = WS_QM + 24 * MiB;
constexpr size_t WS_BR = WS_KVM + 32 * MiB;
constexpr size_t WS_END = WS_BR + 64 * MiB;
constexpr size_t WS_DBG_ZCOPY = WS_END;
constexpr size_t WS_DBG_END = WS_DBG_ZCOPY + 152 * MiB;

constexpr int CW_TMO = 0, CW_CODE = 1;
constexpr int CW_ERR = 64;
constexpr int CW_BAR = 4096;

constexpr int NWAVES = 8;
constexpr int RING_OFF = 0, RING_BYTES = 131072;
constexpr int LDSCTL_OFF = RING_BYTES, MISC_OFF = LDSCTL_OFF + 320;
constexpr int LDS_BYTES = 147456;

__device__ __forceinline__ unsigned f2bf(float f) { unsigned u = __builtin_bit_cast(unsigned, f); return (u + 0x7fffu + ((u >> 16) & 1u)) >> 16; }
__device__ __forceinline__ unsigned pk2(float lo, float hi) { return f2bf(lo) | (f2bf(hi) << 16); }
__device__ __forceinline__ float bf2f(unsigned b) { return __builtin_bit_cast(float, b << 16); }
__device__ __forceinline__ float bflo(unsigned w) { return __builtin_bit_cast(float, w << 16); }
__device__ __forceinline__ float bfhi(unsigned w) { return __builtin_bit_cast(float, w & 0xffff0000u); }
typedef __bf16 bf16x2_t __attribute__((ext_vector_type(2)));
__device__ __forceinline__ unsigned cvt_pk_bf16(float lo, float hi) { const f32x2 v = {lo, hi}; const bf16x2_t b = __builtin_convertvector(v, bf16x2_t); return __builtin_bit_cast(unsigned, b); }
__device__ __forceinline__ float wave_sum(float v) {
#pragma unroll
    for (int o = 1; o < 64; o <<= 1) v += __shfl_xor(v, o);
    return v;
}
__device__ __forceinline__ int opq_tid() { int t = threadIdx.x; asm volatile("" : "+v"(t)); return t; }
__device__ __forceinline__ float sigmoidf_(float v) { return __builtin_amdgcn_rcpf(1.0f + __builtin_amdgcn_exp2f(-v * LOG2E)); }

#define XB_TMO      128
#define XB_XCNT(j)  (256  + 64 * (j))
#define XB_XSUB(j)  (1280 + 64 * (j))
#define XB_XGEN(j)  (2304 + 64 * (j))
#define XB_TOP      3328
#define XB_TOPGEN   3392
#define XCD_BAR_WORDS 3456
#define XB_SPIN_CAP (1u << 18)

__device__ __forceinline__ unsigned xb_ld(unsigned* p)              { return __hip_atomic_load(p, __ATOMIC_RELAXED, __HIP_MEMORY_SCOPE_AGENT); }
__device__ __forceinline__ unsigned xb_add(unsigned* p, unsigned v) { return __hip_atomic_fetch_add(p, v, __ATOMIC_RELAXED, __HIP_MEMORY_SCOPE_AGENT); }
__device__ __forceinline__ unsigned xb_xcc_id() { return (unsigned)__builtin_amdgcn_s_getreg((3 << 11) | 20) & 0xFu; }
#define XB_SPIN(cond, bar) do { unsigned _sp = 0; while (cond) { __builtin_amdgcn_s_sleep(1); \
    if ((++_sp & 255u) == 0u) { if (xb_ld(&(bar)[XB_TMO])) break; if (_sp > XB_SPIN_CAP) { atomicAdd(&(bar)[XB_TMO], 1u); break; } } } } while (0)

struct XcdBarrier {
    unsigned* bar; unsigned x;
    volatile LAS unsigned* st;
};
__device__ __forceinline__ XcdBarrier xcd_barrier_post(unsigned* bar, volatile LAS unsigned* st) {
    XcdBarrier b; b.bar = bar; b.x = xb_xcc_id(); b.st = st;
    if (threadIdx.x == 0) (void)xb_add(&bar[XB_XCNT(b.x)], 1u);
    return b;
}
__device__ __forceinline__ void xcd_barrier_complete(unsigned* bar, unsigned x, unsigned& nloc, unsigned& nx) {
    const unsigned G = gridDim.x * gridDim.y * gridDim.z;
    unsigned sum, cnt, mine, sp = 0u;
    for (;;) {
        sum = 0u; cnt = 0u; mine = 0u;
#pragma unroll
        for (unsigned j = 0; j < 16; ++j) { const unsigned c = xb_ld(&bar[XB_XCNT(j)]); sum += c; cnt += (c > 0u) ? 1u : 0u; mine = (j == x) ? c : mine; }
        if (sum == G) break;
        __builtin_amdgcn_s_sleep(1);
        if ((++sp & 255u) == 0u) { if (xb_ld(&bar[XB_TMO])) break; if (sp > XB_SPIN_CAP) { atomicAdd(&bar[XB_TMO], 1u); break; } }
    }
    nloc = mine > 0u ? mine : 1u; nx = cnt > 0u ? cnt : 1u;
}
__device__ __forceinline__ void xcd_barrier(const XcdBarrier& b) {
    asm volatile("s_waitcnt vmcnt(0)" ::: "memory");
    __syncthreads();
    if (threadIdx.x == 0) {
        unsigned* bar = b.bar;
        __builtin_amdgcn_s_waitcnt(0);
        unsigned nloc = b.st[0], nx = b.st[1];
        if (nloc == 0u) { xcd_barrier_complete(bar, b.x, nloc, nx); b.st[0] = nloc; b.st[1] = nx; }
        const unsigned old = xb_add(&bar[XB_XSUB(b.x)], 1u);
        const unsigned gen = old / nloc;
        if (old + 1u == (gen + 1u) * nloc) {
            __builtin_amdgcn_fence(__ATOMIC_RELEASE, "agent");
            asm volatile("s_waitcnt vmcnt(0)" ::: "memory");
            const unsigned og = xb_add(&bar[XB_TOP], 1u);
            const unsigned tg = og / nx;
            if (og + 1u == (tg + 1u) * nx) xb_add(&bar[XB_TOPGEN], 1u);
            else XB_SPIN(xb_ld(&bar[XB_TOPGEN]) == tg, bar);
            __builtin_amdgcn_fence(__ATOMIC_ACQUIRE, "agent");
            xb_add(&bar[XB_XGEN(b.x)], 1u);
            asm volatile("s_waitcnt vmcnt(0)" ::: "memory");
        } else {
            XB_SPIN(xb_ld(&bar[XB_XGEN(b.x)]) == gen, bar);
            __builtin_amdgcn_fence(__ATOMIC_ACQUIRE, "agent");
            asm volatile("s_waitcnt vmcnt(0)" ::: "memory");
        }
    }
    __syncthreads();
}
namespace pg8 {
#define PG8_LAS __attribute__((address_space(3)))
typedef unsigned short bf16_t;
constexpr int BM = 256, BK = 64, HALF = 128, HTB = HALF * BK * 2  , STAGE_BYTES = 8 * HTB, NXCD = 8, WGM = 8;

__host__ __device__ __forceinline__ int lds_byte(int r, int c) { const int st = (r >> 4) * 2 + (c >> 5), rr = r & 15, cc = c & 31, ob = rr * 64 + cc * 2; return st * 1024 + (ob ^ (((ob >> 9) & 1) << 5)); }
__host__ __device__ __forceinline__ void stage_rc(int b, int& R, int& C) { const int st = b / 1024, sb = b % 1024, swz = sb ^ (((sb >> 9) & 1) << 5); R = (st >> 1) * 16 + swz / 64; C = (st & 1) * 32 + (swz % 64) / 2; }
__host__ __device__ __forceinline__ int perm32(int rho) { const int n = rho >> 4, i = rho & 15; return 8 * (i >> 2) + 4 * n + (i & 3); }

struct Unit { int pm, pn, j; };

__device__ __forceinline__ void tile_of(int L, int nM, int nN, int& pm, int& pn) {
    const int nwg = nM * nN; int wgid = L;
    { const int q = nwg / NXCD, r = nwg % NXCD, xcd = wgid % NXCD, off = wgid / NXCD; wgid = (xcd < r ? xcd * (q + 1) : r * (q + 1) + (xcd - r) * q) + off; }
    const int nig = WGM * nN, gid = wgid / nig, fm = gid * WGM, gsz = (nM - fm) < WGM ? (nM - fm) : WGM;
    pm = fm + ((wgid % nig) % gsz); pn = (wgid % nig) / gsz;
}
struct StaticOrder {
    const bf16_t* A; const bf16_t* Bt; int lda, ldb; int nM, nN, nwg, G, c;
    __device__ void init(const bf16_t* A_, int lda_, const bf16_t* Bt_, int ldb_, int M, int N, int G_, int c_) { A = A_; Bt = Bt_; lda = lda_; ldb = ldb_; nM = M / BM; nN = N / BM; nwg = nM * nN; G = G_; c = c_; }
    __device__ __forceinline__ bool next(int i, Unit& u) const { const long L = (long)i * G + c; if (L >= nwg) return false; tile_of((int)L, nM, nN, u.pm, u.pn); u.j = 0; return true; }
    __device__ __forceinline__ const char* pa(const Unit& u) const { return (const char*)(A + (size_t)u.pm * BM * lda); }
    __device__ __forceinline__ const char* pb(const Unit& u) const { return (const char*)(Bt + (size_t)u.pn * BM * ldb); }
    __device__ __forceinline__ void a_ready(const Unit&) const {}
    __device__ __forceinline__ void done(const Unit&) const {}
};
struct OrderG2 {
    const bf16_t* A; const bf16_t* Bt; int G, c;
    __device__ __forceinline__ bool next(int i, Unit& u) const { const long L = (long)i * G + c; if (L >= 64 * 7) return false; tile_of((int)L, 64, 7, u.pm, u.pn); u.j = 0; return true; }
    __device__ __forceinline__ const char* pa(const Unit& u) const { return (const char*)(A + (size_t)u.pm * BM * ZP + (u.pn < 3 ? 0 : 512)); }
    __device__ __forceinline__ const char* pb(const Unit& u) const { return (const char*)(Bt + (size_t)u.pn * BM * 512); }
    __device__ __forceinline__ void a_ready(const Unit&) const {}
    __device__ __forceinline__ void done(const Unit&) const {}
};
struct OrderG3 {
    const bf16_t* A; const bf16_t* Bt; int G, c;
    __device__ __forceinline__ bool next(int i, Unit& u) const { const long t = (long)(i >> 2) * G + c; if (t >= 512) return false; tile_of((int)t, 64, 8, u.pm, u.pn); u.j = i & 3; return true; }
    __device__ __forceinline__ const char* pa(const Unit& u) const { return (const char*)(A + (size_t)u.pm * BM * D + u.j * 512); }
    __device__ __forceinline__ const char* pb(const Unit& u) const { return (const char*)(Bt + (size_t)u.j * D * 512 + (size_t)u.pn * BM * 512); }
    __device__ __forceinline__ void a_ready(const Unit&) const {}
    __device__ __forceinline__ void done(const Unit&) const {}
};

__device__ __forceinline__ v4u pack8(const f32x4 v0, const f32x4 v1) { v4u w; w.x = cvt_pk_bf16(v0[0], v0[1]); w.y = cvt_pk_bf16(v0[2], v0[3]); w.z = cvt_pk_bf16(v1[0], v1[1]); w.w = cvt_pk_bf16(v1[2], v1[3]); return w; }
__device__ __forceinline__ f32x4 sig4(const f32x4 v) { f32x4 r; r[0] = sigmoidf_(v[0]); r[1] = sigmoidf_(v[1]); r[2] = sigmoidf_(v[2]); r[3] = sigmoidf_(v[3]); return r; }
__device__ __forceinline__ void unpack8(const v4u w, f32x4& a, f32x4& b) { a[0] = bflo(w.x); a[1] = bfhi(w.x); a[2] = bflo(w.y); a[3] = bfhi(w.y); b[0] = bflo(w.z); b[1] = bfhi(w.z); b[2] = bflo(w.w); b[3] = bfhi(w.w); }

struct EpiG1 {
    bf16_t* Z; bf16_t* GT;
    __device__ __forceinline__ void operator()(const f32x4 (&acc)[2][2][4][2], const Unit& u, int wr, int wc, int fr, int fq) const {
        const int row0 = u.pm * BM + wr * 64 + fr, cw = wc * 32 + 8 * fq;
        if (u.pn < 19) {
            bf16_t* base = Z + u.pn * BM + cw;
#pragma unroll
            for (int ai = 0; ai < 2; ++ai)
#pragma unroll
                for (int m = 0; m < 4; ++m) { bf16_t* rowp = base + (size_t)(row0 + ai * HALF + m * 16) * ZP;
#pragma unroll
                    for (int bj = 0; bj < 2; ++bj) *(v4u*)(rowp + bj * HALF) = pack8(acc[ai][bj][m][0], acc[ai][bj][m][1]); }
        } else {
            bf16_t* base = GT + (u.pn - 19) * BM + cw;
#pragma unroll
            for (int ai = 0; ai < 2; ++ai)
#pragma unroll
                for (int m = 0; m < 4; ++m) { bf16_t* rowp = base + (size_t)(row0 + ai * HALF + m * 16) * NG;
#pragma unroll
                    for (int bj = 0; bj < 2; ++bj) *(v4u*)(rowp + bj * HALF) = pack8(sig4(acc[ai][bj][m][0]), sig4(acc[ai][bj][m][1])); }
        }
    }
};
struct EpiG2 {
    bf16_t* QM; bf16_t* KVM;
    __device__ __forceinline__ void operator()(const f32x4 (&acc)[2][2][4][2], const Unit& u, int wr, int wc, int fr, int fq) const {
        const int row0 = u.pm * BM + wr * 64 + fr, cw = wc * 32 + 8 * fq;
        const int ldc = u.pn < 3 ? QM_P : KVM_P; bf16_t* base = (u.pn < 3 ? QM + u.pn * BM : KVM + (u.pn - 3) * BM) + cw;
#pragma unroll
        for (int ai = 0; ai < 2; ++ai)
#pragma unroll
            for (int m = 0; m < 4; ++m) { bf16_t* rowp = base + (size_t)(row0 + ai * HALF + m * 16) * ldc;
#pragma unroll
                for (int bj = 0; bj < 2; ++bj) *(v4u*)(rowp + bj * HALF) = pack8(acc[ai][bj][m][0], acc[ai][bj][m][1]); }
    }
};
struct EpiPlain {
    bf16_t* O; int ldc;
    __device__ __forceinline__ void operator()(const f32x4 (&acc)[2][2][4][2], const Unit& u, int wr, int wc, int fr, int fq) const {
        const int row0 = u.pm * BM + wr * 64 + fr; bf16_t* base = O + u.pn * BM + wc * 32 + 8 * fq;
#pragma unroll
        for (int ai = 0; ai < 2; ++ai)
#pragma unroll
            for (int m = 0; m < 4; ++m) { bf16_t* rowp = base + (size_t)(row0 + ai * HALF + m * 16) * ldc;
#pragma unroll
                for (int bj = 0; bj < 2; ++bj) *(v4u*)(rowp + bj * HALF) = pack8(acc[ai][bj][m][0], acc[ai][bj][m][1]); }
    }
};
struct EpiSwiGLU {
    bf16_t* Hd;
    __device__ __forceinline__ void operator()(const f32x4 (&acc)[2][2][4][2], const Unit& u, int wr, int wc, int fr, int fq) const {
        const int row0 = u.pm * BM + wr * 64 + fr; bf16_t* base = Hd + u.pn * HALF + wc * 32 + 8 * fq;
#pragma unroll
        for (int ai = 0; ai < 2; ++ai)
#pragma unroll
            for (int m = 0; m < 4; ++m) { bf16_t* rowp = base + (size_t)(row0 + ai * HALF + m * 16) * FF;
                const f32x4 g0 = acc[ai][0][m][0], g1 = acc[ai][0][m][1];
                const f32x4 v0 = g0 * sig4(g0) * acc[ai][1][m][0], v1 = g1 * sig4(g1) * acc[ai][1][m][1];
                *(v4u*)rowp = pack8(v0, v1); }
    }
};
struct EpiPle {
    const bf16_t* P2; bf16_t* O;
    __device__ __forceinline__ void operator()(const f32x4 (&acc)[2][2][4][2], const Unit& u, int wr, int wc, int fr, int fq) const {
        const int row0 = u.pm * BM + wr * 64 + fr; const int c0 = u.pn * BM + wc * 32 + 8 * fq;
#pragma unroll
        for (int ai = 0; ai < 2; ++ai)
#pragma unroll
            for (int m = 0; m < 4; ++m) { const size_t ro = (size_t)(row0 + ai * HALF + m * 16) * D + c0;
#pragma unroll
                for (int bj = 0; bj < 2; ++bj) { f32x4 p0, p1; unpack8(*(const v4u*)(P2 + ro + bj * HALF), p0, p1);
                    *(v4u*)(O + ro + bj * HALF) = pack8(sig4(acc[ai][bj][m][0]) * p0, sig4(acc[ai][bj][m][1]) * p1); }
                asm volatile("" ::: "memory"); }
    }
};
struct EpiG3 {
    const bf16_t* GT; float* MF; bf16_t* MG;
    __device__ __forceinline__ void operator()(const f32x4 (&acc)[2][2][4][2], const Unit& u, int wr, int wc, int fr, int fq) const {
        const int row0 = u.pm * BM + wr * 64 + fr; const int c0 = u.pn * BM + wc * 32 + 8 * fq; const int j = u.j;
#pragma unroll
        for (int ai = 0; ai < 2; ++ai)
#pragma unroll
            for (int m = 0; m < 4; ++m) { const size_t row = (size_t)(row0 + ai * HALF + m * 16);
#pragma unroll
                for (int bj = 0; bj < 2; ++bj) { const int c = c0 + bj * HALF;
                    f32x4 g0, g1; unpack8(*(const v4u*)(GT + row * NG + j * D + c), g0, g1);
                    f32x4 v0 = g0 * acc[ai][bj][m][0], v1 = g1 * acc[ai][bj][m][1];
                    float* mf = MF + row * D + c;
                    if (j > 0) { v0 += *(const f32x4*)mf; v1 += *(const f32x4*)(mf + 4); }
                    if (j < 3) { *(f32x4*)mf = v0; *(f32x4*)(mf + 4) = v1; }
                    else *(v4u*)(MG + row * D + c) = pack8(v0, v1); }
                asm volatile("" ::: "memory"); }
    }
};

template <class Epi, class Sched>
__device__ __forceinline__ void gemm_phase(PG8_LAS unsigned char* lds, const int K, const int lda, const int ldb, const Sched& S, const Epi& E) {
    const int tid = opq_tid(), wid = __builtin_amdgcn_readfirstlane(tid >> 6), lane = tid & 63, wr = wid >> 2, wc = wid & 3, fr = lane & 15, fq = lane >> 4;
    const int nt = K / BK;
    unsigned voffA[2], voffB[2];
#pragma unroll
    for (int i = 0; i < 2; ++i) { int R, C; stage_rc(tid * 16 + i * 8192, R, C); const int Rb = (R & ~31) + perm32(R & 31);
        voffA[i] = (unsigned)(R * lda + C) * 2u; voffB[i] = (unsigned)(Rb * ldb + C) * 2u; }
    const size_t kstep = (size_t)(BK * 2);
    const size_t hstepA = (size_t)HALF * lda * 2, hstepB = (size_t)HALF * ldb * 2;
    const unsigned ldsw = (unsigned)wid * 1024u;
    const int aoff = lds_byte(wr * 64 + fr, fq * 8), boff = lds_byte(wc * 32 + fr, fq * 8);
#define PG8_SA(b, h) (((b) * 2 + (h)) * HTB)
#define PG8_SB(b, h) ((4 + (b) * 2 + (h)) * HTB)
#define PG8_STAGE(bufoff, gbase, voff) do { _Pragma("unroll") for (int _i = 0; _i < 2; ++_i) \
        __builtin_amdgcn_global_load_lds((const unsigned*)((const char*)(gbase) + (voff)[_i]), (PG8_LAS unsigned*)(lds + (bufoff) + ldsw + _i * 8192), 16, 0, 0); } while (0)
#define PG8_LDA(dst, b, h) do { _Pragma("unroll") for (int m = 0; m < 4; ++m) _Pragma("unroll") for (int k = 0; k < 2; ++k) dst[m][k] = *(const PG8_LAS bf16x8*)(lds + PG8_SA(b, h) + aoff + m * 2048 + k * 1024); } while (0)
#define PG8_LDB(dst, b, h) do { _Pragma("unroll") for (int n = 0; n < 2; ++n) _Pragma("unroll") for (int k = 0; k < 2; ++k) dst[n][k] = *(const PG8_LAS bf16x8*)(lds + PG8_SB(b, h) + boff + n * 2048 + k * 1024); } while (0)
#define PG8_MMA(ai, bj, At, Bt) do { __builtin_amdgcn_s_setprio(1); _Pragma("unroll") for (int m = 0; m < 4; ++m) _Pragma("unroll") for (int n = 0; n < 2; ++n) _Pragma("unroll") for (int k = 0; k < 2; ++k) \
        acc[ai][bj][m][n] = __builtin_amdgcn_mfma_f32_16x16x32_bf16(Bt[n][k], At[m][k], acc[ai][bj][m][n], 0, 0, 0); __builtin_amdgcn_s_setprio(0); } while (0)
#define PG8_WAIT_V(n) asm volatile("s_waitcnt vmcnt(" #n ")" ::: "memory")
#define PG8_WAIT_L(n) asm volatile("s_waitcnt lgkmcnt(" #n ")" ::: "memory")
#define PG8_BAR __builtin_amdgcn_s_barrier()
#define PG8_SCHED __builtin_amdgcn_sched_barrier(0)
    Unit cur, nxt; int ui = 0;
    if (!S.next(0, cur)) return;
    f32x4 acc[2][2][4][2];
#pragma unroll
    for (int a = 0; a < 2; ++a)
#pragma unroll
        for (int b = 0; b < 2; ++b)
#pragma unroll
            for (int m = 0; m < 4; ++m)
#pragma unroll
                for (int n = 0; n < 2; ++n) acc[a][b][m][n] = (f32x4){0.f, 0.f, 0.f, 0.f};
    bf16x8 At[4][2], B0[2][2], B1[2][2];
    const char* cA = S.pa(cur); const char* cB = S.pb(cur);
    S.a_ready(cur);
    PG8_STAGE(PG8_SB(0, 0), cB, voffB); PG8_STAGE(PG8_SB(0, 1), cB + hstepB, voffB); PG8_STAGE(PG8_SA(0, 0), cA, voffA); PG8_STAGE(PG8_SA(0, 1), cA + hstepA, voffA);
    if (wr == 1) PG8_BAR;
    PG8_WAIT_V(2); PG8_BAR;
    PG8_STAGE(PG8_SB(1, 0), cB + kstep, voffB); PG8_STAGE(PG8_SA(1, 0), cA + kstep, voffA); PG8_STAGE(PG8_SB(1, 1), cB + hstepB + kstep, voffB);
    PG8_WAIT_V(6); PG8_BAR;
    for (;;) {
        const bool has_next = S.next(ui + 1, nxt);
        const char* nA = has_next ? S.pa(nxt) : cA; const char* nB = has_next ? S.pb(nxt) : cB;
        for (int t = 0; t < nt; t += 2) {
            const bool last = (t == nt - 2);
            const char* a1 = cA + (size_t)(t + 1) * kstep;
            const char* a2 = last ? nA : cA + (size_t)(t + 2) * kstep; const char* b2 = last ? nB : cB + (size_t)(t + 2) * kstep;
            const char* a3 = a2 + kstep; const char* b3 = b2 + kstep;
            if (last && has_next) S.a_ready(nxt);
            PG8_LDB(B0, 0, 0); PG8_LDB(B1, 0, 1); PG8_SCHED; PG8_LDA(At, 0, 0); PG8_STAGE(PG8_SA(1, 1), a1 + hstepA, voffA);
            PG8_WAIT_V(8); PG8_WAIT_L(0); PG8_BAR; PG8_MMA(0, 0, At, B0); PG8_MMA(0, 1, At, B1); PG8_BAR; PG8_SCHED;
            PG8_LDA(At, 0, 1); PG8_STAGE(PG8_SB(0, 0), b2, voffB); PG8_STAGE(PG8_SB(0, 1), b2 + hstepB, voffB); PG8_STAGE(PG8_SA(0, 0), a2, voffA);
            PG8_WAIT_V(8); PG8_WAIT_L(0); PG8_BAR; PG8_MMA(1, 0, At, B0); PG8_MMA(1, 1, At, B1); PG8_BAR; PG8_SCHED;
            PG8_LDB(B0, 1, 0); PG8_LDB(B1, 1, 1); PG8_SCHED; PG8_LDA(At, 1, 0); PG8_STAGE(PG8_SA(0, 1), a2 + hstepA, voffA);
            PG8_WAIT_V(8); PG8_WAIT_L(0); PG8_BAR; PG8_MMA(0, 0, At, B0); PG8_MMA(0, 1, At, B1); PG8_BAR; PG8_SCHED;
            PG8_LDA(At, 1, 1); PG8_STAGE(PG8_SB(1, 0), b3, voffB); PG8_STAGE(PG8_SB(1, 1), b3 + hstepB, voffB); PG8_STAGE(PG8_SA(1, 0), a3, voffA);
            PG8_WAIT_V(8); PG8_WAIT_L(0); PG8_BAR; PG8_MMA(1, 0, At, B0); PG8_MMA(1, 1, At, B1); PG8_BAR; PG8_SCHED;
        }
        if (wr == 0) PG8_BAR;
        E(acc, cur, wr, wc, fr, fq); S.done(cur);
        if (!has_next) break;
#pragma unroll
        for (int a = 0; a < 2; ++a)
#pragma unroll
            for (int b = 0; b < 2; ++b)
#pragma unroll
                for (int m = 0; m < 4; ++m)
#pragma unroll
                    for (int n = 0; n < 2; ++n) acc[a][b][m][n] = (f32x4){0.f, 0.f, 0.f, 0.f};
        cur = nxt; cA = nA; cB = nB; ++ui;
        if (wr == 1) PG8_BAR;
    }
    PG8_WAIT_V(0);
    PG8_BAR;
#undef PG8_SA
#undef PG8_SB
#undef PG8_STAGE
#undef PG8_LDA
#undef PG8_LDB
#undef PG8_MMA
#undef PG8_WAIT_V
#undef PG8_WAIT_L
#undef PG8_BAR
#undef PG8_SCHED
}
}
namespace att {
constexpr int KVBLK = 64;
constexpr int SHM_V = 16384, SHM_K = 16384, SHM_KR = 8192;
constexpr int OFF_V = 0, OFF_K = 2 * SHM_V, OFF_KR = OFF_K + 2 * SHM_K, OFF_WS = OFF_KR + 2 * SHM_KR, OFF_QR = OFF_WS + 8 * 64 * 4, LDS_ATT = OFF_QR + 8 * 4096;
#define KSWZ(row, colB) ((row) * 256 + ((colB) ^ (((row) & 7) << 4)))
#define KRSWZ(row, chunk) ((row) * 128 + ((((chunk) ^ (((row) >> 1) & 7))) << 4))
#define SBAR() __builtin_amdgcn_sched_barrier(0)
__device__ __forceinline__ int crow(int r, int hi) { return (r & 3) + 8 * (r >> 2) + 4 * hi; }
__device__ __forceinline__ unsigned cvtpk(float lo, float hi) { return cvt_pk_bf16(lo, hi); }

__device__ __forceinline__ void partialSM(f32x16& p0, f32x16& p1, float& m_reg, float& mn, float& alpha, const float C, const float thr) {
  float pmax = p0[0];
#pragma unroll
  for (int r = 1; r < 16; ++r) pmax = fmaxf(pmax, p0[r]);
#pragma unroll
  for (int r = 0; r < 16; ++r) pmax = fmaxf(pmax, p1[r]);
  { auto rr = __builtin_amdgcn_permlane32_swap(__float_as_uint(pmax), __float_as_uint(pmax), false, false);
    pmax = fmaxf(__uint_as_float(rr[0]), __uint_as_float(rr[1])); }
  if (__builtin_expect(__all(pmax - m_reg <= thr), 1)) { mn = m_reg; alpha = 1.f; }
  else { mn = fmaxf(m_reg, pmax); alpha = __builtin_amdgcn_exp2f((m_reg - mn) * C); m_reg = mn; }
  const float mnC = -mn * C;
#pragma unroll
  for (int r = 0; r < 16; ++r) p0[r] = fmaf(p0[r], C, mnC);
#pragma unroll
  for (int r = 0; r < 16; ++r) p1[r] = fmaf(p1[r], C, mnC);
#pragma unroll
  for (int r = 0; r < 16; ++r) p0[r] = __builtin_amdgcn_exp2f(p0[r]);
}
__device__ __forceinline__ void finishSM(f32x16& p0, f32x16& p1, float alpha, float& l_reg, bf16x8& pa0, bf16x8& pa1, bf16x8& pa2, bf16x8& pa3) {
#pragma unroll
  for (int r = 0; r < 16; ++r) p1[r] = __builtin_amdgcn_exp2f(p1[r]);
  float ps = 0;
#pragma unroll
  for (int r = 0; r < 16; ++r) ps += p0[r];
#pragma unroll
  for (int r = 0; r < 16; ++r) ps += p1[r];
  { auto rr = __builtin_amdgcn_permlane32_swap(__float_as_uint(ps), __float_as_uint(ps), false, false);
    ps = __uint_as_float(rr[0]) + __uint_as_float(rr[1]); }
  l_reg = l_reg * alpha + ps;
#define PK4(P, BASE, OUT) do { unsigned a0 = cvtpk(P[BASE + 0], P[BASE + 1]), a1 = cvtpk(P[BASE + 2], P[BASE + 3]);   \
    unsigned b0 = cvtpk(P[BASE + 4], P[BASE + 5]), b1 = cvtpk(P[BASE + 6], P[BASE + 7]);                              \
    auto r0 = __builtin_amdgcn_permlane32_swap(a0, b0, false, false); auto r1 = __builtin_amdgcn_permlane32_swap(a1, b1, false, false); \
    v4u w = {r0[0], r1[0], r0[1], r1[1]}; OUT = __builtin_bit_cast(bf16x8, w); } while (0)
  PK4(p0, 0, pa0); PK4(p0, 8, pa1); PK4(p1, 0, pa2); PK4(p1, 8, pa3);
#undef PK4
}
template <int NQ, bool ROPEK>
__device__ __forceinline__ void qkt(f32x16& p0, f32x16& p1, const LAS char* Ks, const LAS char* KRs, const LAS char* QRs, const bf16x8 (&qr)[NQ], int r32, int hi, int kd0) {
  p0 = f32x16{}; p1 = f32x16{};
#pragma unroll
  for (int d0 = 0; d0 < NQ; ++d0) { const int cb = ((kd0 + d0) * 16 + hi * 8) * 2;
    const bf16x8 b0 = *(const LAS bf16x8*)(Ks + KSWZ(r32, cb));
    const bf16x8 b1 = *(const LAS bf16x8*)(Ks + KSWZ(32 + r32, cb));
    p0 = __builtin_amdgcn_mfma_f32_32x32x16_bf16(b0, qr[d0], p0, 0, 0, 0);
    p1 = __builtin_amdgcn_mfma_f32_32x32x16_bf16(b1, qr[d0], p1, 0, 0, 0); }
  if constexpr (ROPEK) {
#pragma unroll
    for (int d0 = 0; d0 < 4; ++d0) { const int ch = d0 * 2 + hi;
      const bf16x8 b0 = *(const LAS bf16x8*)(KRs + KRSWZ(r32, ch));
      const bf16x8 b1 = *(const LAS bf16x8*)(KRs + KRSWZ(32 + r32, ch));
      const bf16x8 qq = *(const LAS bf16x8*)(QRs + d0 * 1024);
      p0 = __builtin_amdgcn_mfma_f32_32x32x16_bf16(b0, qq, p0, 0, 0, 0);
      p1 = __builtin_amdgcn_mfma_f32_32x32x16_bf16(b1, qq, p1, 0, 0, 0); }
  }
}
__device__ __forceinline__ void band_mask(f32x16& p0, f32x16& p1, int kb, int qpos, int hi) {
  const float NEG = -INFINITY;
#pragma unroll
  for (int r = 0; r < 16; ++r) { const int d = kb + crow(r, hi) - qpos; if (d > 128 || d < -128) p0[r] = NEG; if (d + 32 > 128 || d + 32 < -128) p1[r] = NEG; }
}
__device__ __forceinline__ int v_st(int k, int c) { const int kk = (k & ~0xC) | ((k & 4) << 1) | ((k & 8) >> 1); return ((kk >> 3) * 4 + (c >> 5)) * 512 + ((kk & 7) * 32 + (c & 31)) * 2; }
__device__ __forceinline__ int v_rd_base(int lane) { return ((lane & 3) << 3) | (((lane >> 2) & 3) << 6) | (((lane >> 4) & 1) << 5) | (((lane >> 5) & 1) << 8); }
constexpr int v_rd_off(int d0, int ks, int half) { return d0 * 512 + ks * 4096 + half * 2048; }
template <int OFF> __device__ __forceinline__ s16x4 tr_read(int vb) {
  s16x4 r; asm volatile("ds_read_b64_tr_b16 %0, %1 offset:%2" : "=&v"(r) : "v"(vb), "i"(OFF) : "memory"); return r;
}
template <int D0> __device__ __forceinline__ void pv_one(f32x16& od, int vb, bf16x8 pa0, bf16x8 pa1, bf16x8 pa2, bf16x8 pa3) {
  const s16x4 l0 = tr_read<v_rd_off(D0, 0, 0)>(vb), h0 = tr_read<v_rd_off(D0, 0, 1)>(vb), l1 = tr_read<v_rd_off(D0, 1, 0)>(vb), h1 = tr_read<v_rd_off(D0, 1, 1)>(vb);
  const s16x4 l2 = tr_read<v_rd_off(D0, 2, 0)>(vb), h2 = tr_read<v_rd_off(D0, 2, 1)>(vb), l3 = tr_read<v_rd_off(D0, 3, 0)>(vb), h3 = tr_read<v_rd_off(D0, 3, 1)>(vb);
  asm volatile("s_waitcnt lgkmcnt(0)" ::: "memory"); SBAR();
#define PK(L, H) (bf16x8){L[0], L[1], L[2], L[3], H[0], H[1], H[2], H[3]}
  od = __builtin_amdgcn_mfma_f32_32x32x16_bf16(pa0, PK(l0, h0), od, 0, 0, 0);
  od = __builtin_amdgcn_mfma_f32_32x32x16_bf16(pa1, PK(l1, h1), od, 0, 0, 0);
  od = __builtin_amdgcn_mfma_f32_32x32x16_bf16(pa2, PK(l2, h2), od, 0, 0, 0);
  od = __builtin_amdgcn_mfma_f32_32x32x16_bf16(pa3, PK(l3, h3), od, 0, 0, 0);
#undef PK
}
__device__ __forceinline__ void pv_d0(f32x16 (&o)[4], int vb, bf16x8 pa0, bf16x8 pa1, bf16x8 pa2, bf16x8 pa3) {
  pv_one<0>(o[0], vb, pa0, pa1, pa2, pa3); pv_one<1>(o[1], vb, pa0, pa1, pa2, pa3); pv_one<2>(o[2], vb, pa0, pa1, pa2, pa3); pv_one<3>(o[3], vb, pa0, pa1, pa2, pa3);
}
__device__ __forceinline__ bf16x8 ld8(const bf16* p) { return *reinterpret_cast<const bf16x8*>(p); }

__device__ __forceinline__ void glds16(const void* gsrc, unsigned lds_dst) { unsigned keep;
  asm volatile("s_mov_b32 %0, m0\n\ts_mov_b32 m0, %2\n\ts_nop 0\n\tglobal_load_lds_dwordx4 %1, off\n\ts_mov_b32 m0, %0" : "=&s"(keep) : "v"(gsrc), "s"(lds_dst) : "memory"); }
#define WAIT_BAR() asm volatile("s_waitcnt vmcnt(0) lgkmcnt(0)\n\ts_barrier" ::: "memory")

template <int NQ, bool ROPEK, bool SWA>
__device__ __forceinline__ void attn_core(LAS char* lds, const bf16x8 (&qr)[NQ],
                                          const bf16* __restrict__ Kh, const bf16* __restrict__ Vh, const int ldk, const bf16* __restrict__ KRh, const int ldkr,
                                          const int NT, const float C, const float thr, const int kd0, const int qpos, const int kpos0,
                                          f32x16 (&o)[4], float& m_reg, float& l_reg) {
  const int tid = opq_tid(), lane = tid & 63, r32 = lane & 31, hi = lane >> 5;
  const int wid = __builtin_amdgcn_readfirstlane(tid >> 6);
  LAS char* V_lds = lds + OFF_V; LAS char* K_lds = lds + OFF_K; LAS char* KR_lds = lds + OFF_KR;
  LAS float* al_l = (LAS float*)(lds + OFF_WS) + wid * 64 + 32;
  const LAS char* QR_lds = lds + OFF_QR + wid * 4096 + lane * 16;
  const unsigned lds0 = (unsigned)(uintptr_t)lds;
  const int vb0 = (int)lds0 + OFF_V + v_rd_base(lane);
  unsigned kofs[2], vofs[2], krofs = 0u;
#pragma unroll
  for (int i = 0; i < 2; ++i) { const int p = wid * 2 + i;
    { const int row = p * 4 + (lane >> 4), ch = (lane & 15) ^ (row & 7); kofs[i] = (unsigned)(row * ldk + ch * 8) * 2u; }
    { const int sub = 2 * p + (lane >> 5), kk = (sub >> 2) * 8 + ((lane & 31) >> 2), k = (kk & ~0xC) | ((kk & 4) << 1) | ((kk & 8) >> 1), c = (sub & 3) * 32 + (lane & 3) * 8;
      vofs[i] = (unsigned)(k * ldk + c) * 2u; } }
  if constexpr (ROPEK) { const int row = wid * 8 + (lane >> 3), ch = (lane & 7) ^ ((row >> 1) & 7); krofs = (unsigned)(row * ldkr + ch * 8) * 2u; }
  const size_t tstepK = (size_t)KVBLK * ldk * 2, tstepKR = (size_t)KVBLK * ldkr * 2;
#define RFL(x) ((unsigned)__builtin_amdgcn_readfirstlane((int)(x)))
#define DMA_K(t, b) do { const char* g_ = (const char*)Kh + (size_t)(t) * tstepK; \
    glds16(g_ + kofs[0], RFL(lds0 + OFF_K + (b) * SHM_K + (wid * 2) * 1024)); glds16(g_ + kofs[1], RFL(lds0 + OFF_K + (b) * SHM_K + (wid * 2 + 1) * 1024)); \
    if constexpr (ROPEK) glds16((const char*)KRh + (size_t)(t) * tstepKR + krofs, RFL(lds0 + OFF_KR + (b) * SHM_KR + wid * 1024)); } while (0)
#define DMA_V(t, b) do { const char* g_ = (const char*)Vh + (size_t)(t) * tstepK; \
    glds16(g_ + vofs[0], RFL(lds0 + OFF_V + (b) * SHM_V + (wid * 2) * 1024)); glds16(g_ + vofs[1], RFL(lds0 + OFF_V + (b) * SHM_V + (wid * 2 + 1) * 1024)); } while (0)
#define RESC(a) do { if (__any((a) < 1.f)) { if (hi == 0) al_l[r32] = (a); asm volatile("s_waitcnt lgkmcnt(0)" ::: "memory"); \
    _Pragma("unroll") for (int d = 0; d < 4; ++d) _Pragma("unroll") for (int r = 0; r < 16; ++r) o[d][r] *= al_l[crow(r, hi)]; } } while (0)
#define QKT(P0, P1, b, tile) do { qkt<NQ, ROPEK>(P0, P1, K_lds + (b) * SHM_K, KR_lds + (b) * SHM_KR, QR_lds, qr, r32, hi, kd0); \
    if constexpr (SWA) band_mask(P0, P1, kpos0 + (tile) * KVBLK, qpos, hi); } while (0)
  f32x16 pA0, pA1, pB0, pB1; float mnA, mnB, alA, alB; bf16x8 pa0, pa1, pa2, pa3;
  DMA_K(0, 0); DMA_V(0, 0); DMA_K(1, 1);
  WAIT_BAR();
  QKT(pA0, pA1, 0, 0); partialSM(pA0, pA1, m_reg, mnA, alA, C, thr);
  WAIT_BAR();
  if (2 < NT) DMA_K(2, 0);
  DMA_V(1, 1);
  for (int j = 1; j + 1 < NT; j += 2) {
    SBAR(); QKT(pB0, pB1, 1, j);
    finishSM(pA0, pA1, alA, l_reg, pa0, pa1, pa2, pa3); SBAR();
    pv_d0(o, vb0, pa0, pa1, pa2, pa3); partialSM(pB0, pB1, m_reg, mnB, alB, C, thr);
    WAIT_BAR();
    if (j + 2 < NT) DMA_K(j + 2, 1);
    DMA_V(j + 1, 0);
    RESC(alB);
    SBAR(); QKT(pA0, pA1, 0, j + 1);
    finishSM(pB0, pB1, alB, l_reg, pa0, pa1, pa2, pa3); SBAR();
    pv_d0(o, vb0 + SHM_V, pa0, pa1, pa2, pa3); partialSM(pA0, pA1, m_reg, mnA, alA, C, thr);
    WAIT_BAR();
    if (j + 3 < NT) DMA_K(j + 3, 0);
    if (j + 2 < NT) DMA_V(j + 2, 1);
    RESC(alA);
  }
  SBAR(); QKT(pB0, pB1, 1, NT - 1);
  finishSM(pA0, pA1, alA, l_reg, pa0, pa1, pa2, pa3); SBAR();
  pv_d0(o, vb0, pa0, pa1, pa2, pa3); partialSM(pB0, pB1, m_reg, mnB, alB, C, thr);
  WAIT_BAR(); RESC(alB);
  finishSM(pB0, pB1, alB, l_reg, pa0, pa1, pa2, pa3); SBAR();
  pv_d0(o, vb0 + SHM_V, pa0, pa1, pa2, pa3);
#undef RFL
#undef DMA_K
#undef DMA_V
#undef RESC
#undef QKT
}

__device__ __forceinline__ void store_o(LAS char* lds, const f32x16 (&o)[4], float l_reg, bf16* Ow, const int ldo) {
  const int tid = opq_tid(), lane = tid & 63, r32 = lane & 31, hi = lane >> 5; const int wid = __builtin_amdgcn_readfirstlane(tid >> 6);
  LAS float* li_l = (LAS float*)(lds + OFF_WS) + wid * 64;
  if (hi == 0) li_l[r32] = l_reg; asm volatile("s_waitcnt lgkmcnt(0)" ::: "memory");
  float rli[16];
#pragma unroll
  for (int r = 0; r < 16; ++r) rli[r] = __builtin_amdgcn_rcpf(li_l[crow(r, hi)]);
#pragma unroll
  for (int r = 0; r < 16; ++r) { const int orow = crow(r, hi);
#pragma unroll
    for (int d0 = 0; d0 < 4; ++d0) Ow[(long)orow * ldo + d0 * 32 + r32] = (bf16)f2bf(o[d0][r] * rli[r]); }
}
}
struct Frame {
    LAS unsigned char* lds;
    volatile LAS unsigned* MISC;
    gu32* ctl;
    int tid, lane, wave;
    int vcu, G;
};

__device__ __forceinline__ void transpose_item(const float* __restrict__ W, int N, int k0, int n0, bf16* __restrict__ WT, int K, int drow0, LAS float* scr, int lane) {
    const int lr = lane >> 3, lc = (lane & 7) * 4;
#pragma unroll
    for (int i = 0; i < 8; ++i) { const int kk = 8 * i + lr; const f32x4 v = *(const f32x4*)(W + (size_t)(k0 + kk) * N + n0 + lc);
        LAS float* s = scr + kk * 33 + lc; s[0] = v[0]; s[1] = v[1]; s[2] = v[2]; s[3] = v[3]; }
    LDS_WAIT(); asm volatile("" ::: "memory");
    const int c = lane & 7;
#pragma unroll
    for (int j = 0; j < 4; ++j) { const int n = (lane >> 3) + 8 * j; const LAS float* s = scr + (8 * c) * 33 + n;
        v4u o; o.x = pk2(s[0 * 33], s[1 * 33]); o.y = pk2(s[2 * 33], s[3 * 33]); o.z = pk2(s[4 * 33], s[5 * 33]); o.w = pk2(s[6 * 33], s[7 * 33]);
        *(v4u*)(WT + (size_t)(drow0 + n) * K + k0 + 8 * c) = o; }
    LDS_WAIT(); asm volatile("" ::: "memory");
}
struct WSrc { const float *w_in, *w_uq, *w_ukv, *w_br, *w_bg, *w_o, *w_fi, *w_fo, *w_ple, *w_pg; };
constexpr int IT_IN = 146 * 32, IT_BG = 4 * 64 * 32, IT_UQ = 24 * 8, IT_UKV = 32 * 8, IT_BR = 4 * 64 * 8, IT_WO = 64 * 32, IT_FI = 352 * 32, IT_FO = 64 * 88, IT_PLE = 64 * 4, IT_PG = 64 * 32;
constexpr int IT_LAYER = IT_IN + IT_BG + IT_UQ + IT_UKV + IT_BR + IT_WO + IT_FI + IT_FO + IT_PLE + IT_PG;
__device__ __forceinline__ void convert_item(const WSrc& ws, bf16* WL, int L, int r, LAS float* scr, int lane) {
    if (r < IT_IN) { const int kb = r / 146, nb = r % 146; transpose_item(ws.w_in + (size_t)L * D * ZC, ZC, 64 * kb, 32 * nb, WL + WL_W1, D, 32 * nb, scr, lane); return; } r -= IT_IN;
    if (r < IT_BG) { const int j = r / (64 * 32), q = r % (64 * 32), kb = q / 64, nb = q % 64; transpose_item(ws.w_bg + ((size_t)L * 4 + j) * D * D, D, 64 * kb, 32 * nb, WL + WL_W1, D, ZP + j * D + 32 * nb, scr, lane); return; } r -= IT_BG;
    if (r < IT_UQ) { const int kb = r / 24, nb = r % 24; transpose_item(ws.w_uq + (size_t)L * 512 * 768, 768, 64 * kb, 32 * nb, WL + WL_UQKV, 512, 32 * nb, scr, lane); return; } r -= IT_UQ;
    if (r < IT_UKV) { const int kb = r / 32, nb = r % 32; transpose_item(ws.w_ukv + (size_t)L * 512 * 1024, 1024, 64 * kb, 32 * nb, WL + WL_UQKV, 512, 768 + 32 * nb, scr, lane); return; } r -= IT_UKV;
    if (r < IT_BR) { const int j = r / (64 * 8), q = r % (64 * 8), kb = q / 64, nb = q % 64; transpose_item(ws.w_br + ((size_t)L * 4 + j) * 512 * D, D, 64 * kb, 32 * nb, WL + WL_BR + (size_t)j * D * 512, 512, 32 * nb, scr, lane); return; } r -= IT_BR;
    if (r < IT_WO) { const int kb = r / 64, nb = r % 64; transpose_item(ws.w_o + (size_t)L * D * D, D, 64 * kb, 32 * nb, WL + WL_WO, D, 32 * nb, scr, lane); return; } r -= IT_WO;
    if (r < IT_FI) { const int kb = r / 352, nb = r % 352; const int c0 = 32 * nb; const int up = c0 >= FF ? 1 : 0, cc = c0 - up * FF;
        transpose_item(ws.w_fi + (size_t)L * D * 2 * FF, 2 * FF, 64 * kb, c0, WL + WL_FI, D, (cc >> 7) * 256 + up * 128 + (cc & 127), scr, lane); return; } r -= IT_FI;
    if (r < IT_FO) { const int kb = r / 64, nb = r % 64; transpose_item(ws.w_fo + (size_t)L * FF * D, D, 64 * kb, 32 * nb, WL + WL_FO, FF, 32 * nb, scr, lane); return; } r -= IT_FO;
    if (r < IT_PLE) { const int kb = r / 64, nb = r % 64; transpose_item(ws.w_ple + (size_t)L * PLE * D, D, 64 * kb, 32 * nb, WL + WL_PLE, PLE, 32 * nb, scr, lane); return; } r -= IT_PLE;
    { const int kb = r / 64, nb = r % 64; transpose_item(ws.w_pg + (size_t)L * D * D, D, 64 * kb, 32 * nb, WL + WL_PG, D, 32 * nb, scr, lane); }
}

template <int MODE>
__device__ __forceinline__ void thin_phase(Frame& F, const float* __restrict__ xin, const bf16* __restrict__ y, float* __restrict__ x, bf16* __restrict__ h,
                                           const float* __restrict__ gpost, const float* __restrict__ gpre) {
    const int tid_ = opq_tid(), lane = tid_ & 63, wave_ = __builtin_amdgcn_readfirstlane(tid_ >> 6);
    const int gw = F.vcu * NWAVES + wave_, NGW = F.G * NWAVES;
    f32x4 gp[8], gq[8];
#pragma unroll
    for (int j = 0; j < 8; ++j) { gp[j] = (MODE >= 1) ? *(const f32x4*)(gpost + 256 * j + 4 * lane) : (f32x4){0.f, 0.f, 0.f, 0.f};
                                  gq[j] = (MODE <= 1) ? *(const f32x4*)(gpre + 256 * j + 4 * lane) : (f32x4){0.f, 0.f, 0.f, 0.f}; }
    for (int row = gw; row < S; row += NGW) {
        const float* xr = (MODE == 0 ? xin : x) + (size_t)row * D + 4 * lane;
        f32x4 v[8];
#pragma unroll
        for (int j = 0; j < 8; ++j) v[j] = *(const f32x4*)(xr + 256 * j);
        if constexpr (MODE >= 1) {
            const bf16* yr = y + (size_t)row * D + 4 * lane; f32x4 yv[8]; float s = 0.f;
#pragma unroll
            for (int j = 0; j < 8; ++j) { const v2u w = *(const v2u*)(yr + 256 * j); yv[j] = (f32x4){bflo(w.x), bfhi(w.x), bflo(w.y), bfhi(w.y)};
                s += (yv[j][0] * yv[j][0] + yv[j][1] * yv[j][1]) + (yv[j][2] * yv[j][2] + yv[j][3] * yv[j][3]); }
            const float rstd = 1.0f / sqrtf(wave_sum(s) * (1.0f / D) + RMS_EPS);
#pragma unroll
            for (int j = 0; j < 8; ++j) v[j] += yv[j] * rstd * gp[j];
        }
        float* xo = x + (size_t)row * D + 4 * lane;
#pragma unroll
        for (int j = 0; j < 8; ++j) *(f32x4*)(xo + 256 * j) = v[j];
        if constexpr (MODE <= 1) {
            float s = 0.f;
#pragma unroll
            for (int j = 0; j < 8; ++j) s += (v[j][0] * v[j][0] + v[j][1] * v[j][1]) + (v[j][2] * v[j][2] + v[j][3] * v[j][3]);
            const float rstd = 1.0f / sqrtf(wave_sum(s) * (1.0f / D) + RMS_EPS);
            bf16* hr = h + (size_t)row * D + 4 * lane;
#pragma unroll
            for (int j = 0; j < 8; ++j) { const f32x4 t = v[j] * rstd * gq[j]; v2u w; w.x = pk2(t[0], t[1]); w.y = pk2(t[2], t[3]); *(v2u*)(hr + 256 * j) = w; }
        }
        if constexpr (MODE == 2) {
            bf16* hr = h + (size_t)row * D + 4 * lane;
#pragma unroll
            for (int j = 0; j < 8; ++j) { v2u w; w.x = pk2(v[j][0], v[j][1]); w.y = pk2(v[j][2], v[j][3]); *(v2u*)(hr + 256 * j) = w; }
        }
    }
}

struct PrepP { bf16* Z; const float *c64, *s64, *c128, *s128; const float *qa, *kva, *axq, *axk; };
template <bool NORM>
__device__ __forceinline__ void rope64_span(bf16* zr, int base, const float* c64, const float* s64, int pos_e, int pos_o, const float* g, int lane, bool active) {
    const int chunk = lane >> 4, jp = lane & 15, col = base + chunk * 64 + 2 * jp;
    if (!active && !NORM) return;
    unsigned w1 = 0u, w2 = 0u;
    if (active) { w1 = *(const unsigned*)(zr + col); w2 = *(const unsigned*)(zr + col + 32); }
    float a0 = bflo(w1), a1 = bfhi(w1), b0 = bflo(w2), b1 = bfhi(w2);
    if constexpr (NORM) {
        float s = (a0 * a0 + a1 * a1) + (b0 * b0 + b1 * b1);
        s += __shfl_xor(s, 1); s += __shfl_xor(s, 2); s += __shfl_xor(s, 4); s += __shfl_xor(s, 8); s += __shfl_xor(s, 16);
        const float rstd = 1.0f / sqrtf(s * (1.0f / 128.0f) + RMS_EPS);
        const int gi = (chunk & 1) * 64 + 2 * jp;
        a0 *= rstd * g[gi]; a1 *= rstd * g[gi + 1]; b0 *= rstd * g[gi + 32]; b1 *= rstd * g[gi + 33];
    }
    const int pos = (chunk & 1) ? pos_o : pos_e;
    const f32x2 c = *(const f32x2*)(c64 + (size_t)pos * 32 + 2 * jp), s = *(const f32x2*)(s64 + (size_t)pos * 32 + 2 * jp);
    const float n0 = a0 * c[0] - b0 * s[0], n1 = a1 * c[1] - b1 * s[1], m0 = b0 * c[0] + a0 * s[0], m1 = b1 * c[1] + a1 * s[1];
    if (active) { *(unsigned*)(zr + col) = pk2(n0, n1); *(unsigned*)(zr + col + 32) = pk2(m0, m1); }
}
__device__ __forceinline__ void rope128_span(bf16* zr, int base, const float* c128, const float* s128, int pos, int lane) {
    const int head = lane >> 5, jp = lane & 31, col = base + head * 128 + 2 * jp;
    const unsigned w1 = *(const unsigned*)(zr + col), w2 = *(const unsigned*)(zr + col + 64);
    const float a0 = bflo(w1), a1 = bfhi(w1), b0 = bflo(w2), b1 = bfhi(w2);
    const f32x2 c = *(const f32x2*)(c128 + (size_t)pos * 64 + 2 * jp), s = *(const f32x2*)(s128 + (size_t)pos * 64 + 2 * jp);
    *(unsigned*)(zr + col) = pk2(a0 * c[0] - b0 * s[0], a1 * c[1] - b1 * s[1]);
    *(unsigned*)(zr + col + 64) = pk2(b0 * c[0] + a0 * s[0], b1 * c[1] + a1 * s[1]);
}
__device__ __forceinline__ void latent_norm(bf16* zr, int base, const float* g, int lane) {
    const v4u w = *(const v4u*)(zr + base + 8 * lane);
    f32x4 a, b; pg8::unpack8(w, a, b);
    float s = (a[0] * a[0] + a[1] * a[1]) + (a[2] * a[2] + a[3] * a[3]) + (b[0] * b[0] + b[1] * b[1]) + (b[2] * b[2] + b[3] * b[3]);
    const float rstd = 1.0f / sqrtf(wave_sum(s) * (1.0f / 512.0f) + RMS_EPS);
    const f32x4 g0 = *(const f32x4*)(g + 8 * lane), g1 = *(const f32x4*)(g + 8 * lane + 4);
    a = a * rstd * g0; b = b * rstd * g1;
    v4u o; o.x = pk2(a[0], a[1]); o.y = pk2(a[2], a[3]); o.z = pk2(b[0], b[1]); o.w = pk2(b[2], b[3]);
    *(v4u*)(zr + base + 8 * lane) = o;
}
__device__ __forceinline__ void prep_phase(Frame& F, const PrepP& P) {
    const int tid_ = opq_tid(), lane = tid_ & 63, wave_ = __builtin_amdgcn_readfirstlane(tid_ >> 6);
    const int gw = F.vcu * NWAVES + wave_, NGW = F.G * NWAVES;
    for (int t = gw; t < S; t += NGW) {
        bf16* zr = P.Z + (size_t)t * ZP;
        latent_norm(zr, Z_CQ, P.qa, lane);
        latent_norm(zr, Z_CKV, P.kva, lane);
        rope64_span<false>(zr, Z_KR, P.c64, P.s64, t, t, nullptr, lane, lane < 16);
        rope64_span<false>(zr, Z_DQ, P.c64, P.s64, t, t, nullptr, lane, true);
        rope64_span<false>(zr, Z_DQ + 256, P.c64, P.s64, t, t, nullptr, lane, true);
        rope64_span<false>(zr, Z_DK, P.c64, P.s64, t, t, nullptr, lane, true);
        rope64_span<false>(zr, Z_DK + 256, P.c64, P.s64, t, t, nullptr, lane, true);
        rope128_span(zr, Z_SQ, P.c128, P.s128, t, lane);
        rope128_span(zr, Z_SQ + 256, P.c128, P.s128, t, lane);
        rope128_span(zr, Z_SK, P.c128, P.s128, t, lane);
        rope64_span<true>(zr, Z_AQ, P.c64, P.s64, t >> 6, t & 63, P.axq, lane, true);
        rope64_span<true>(zr, Z_AQ + 256, P.c64, P.s64, t >> 6, t & 63, P.axq, lane, true);
        rope64_span<true>(zr, Z_AK, P.c64, P.s64, t >> 6, t & 63, P.axk, lane, true);
    }
}

#ifndef SD_AX
#define SD_AX 2
#endif
#ifndef SD_SWA
#define SD_SWA 1
#endif
#ifndef SD_MLA
#define SD_MLA 1
#endif
#ifndef SD_DIFF
#define SD_DIFF 1
#endif
struct AttP { const bf16* Z; const bf16* QM; const bf16* KVM; bf16* BR; const float *c64, *s64; const float* sink; const float* lam_p; const float* subln; float lam_init; };

__device__ __forceinline__ void unit_axial(Frame& F, const AttP& P, int h, int qb) {
    using namespace att;
    const int tid_ = opq_tid(), lane = tid_ & 63, r32 = lane & 31, hi = lane >> 5, wid = __builtin_amdgcn_readfirstlane(tid_ >> 6);
    LAS char* lds = (LAS char*)F.lds;
    const int row = qb * 256 + wid * 32 + r32;
    const bf16* Qw = P.Z + (size_t)row * ZP + Z_AQ + h * 128 + hi * 8;
    bf16x8 qr[8];
#pragma unroll
    for (int d0 = 0; d0 < 8; ++d0) qr[d0] = ld8(Qw + d0 * 16);
    f32x16 o[4] = {}; float m_reg = -1e30f, l_reg = 0.f;
    const float scale = 0.088388347648318440f;
    attn_core<8, false, false>(lds, qr, P.Z + Z_AK + (h >> 1) * 128, P.Z + Z_AV + (h >> 1) * 128, ZP, nullptr, 0, S / KVBLK, scale * LOG2E, 8.f / scale, 0, 0, 0, o, m_reg, l_reg);
    store_o(lds, o, l_reg, P.BR + (size_t)(qb * 256 + wid * 32) * D + 1536 + h * 128, D);
}
__device__ __forceinline__ void unit_swa(Frame& F, const AttP& P, int h, int qb) {
    using namespace att;
    const int tid_ = opq_tid(), lane = tid_ & 63, r32 = lane & 31, hi = lane >> 5, wid = __builtin_amdgcn_readfirstlane(tid_ >> 6);
    LAS char* lds = (LAS char*)F.lds;
    const int row = qb * 256 + wid * 32 + r32;
    const bf16* Qw = P.Z + (size_t)row * ZP + Z_SQ + h * 128 + hi * 8;
    bf16x8 qr[8];
#pragma unroll
    for (int d0 = 0; d0 < 8; ++d0) qr[d0] = ld8(Qw + d0 * 16);
    f32x16 o[4] = {}; float m_reg = -1e30f, l_reg = 0.f;
    const float scale = 0.088388347648318440f, C = scale * LOG2E;
    int k_lo = qb * 256 - 128; if (k_lo < 0) k_lo = 0; int k_hi = qb * 256 + 384; if (k_hi > S) k_hi = S;
    const int NT = (k_hi - k_lo) / KVBLK;
    attn_core<8, false, true>(lds, qr, P.Z + (size_t)k_lo * ZP + Z_SK + (h >> 1) * 128, P.Z + (size_t)k_lo * ZP + Z_SV + (h >> 1) * 128, ZP, nullptr, 0, NT, C, 8.f / scale, 0, row, k_lo, o, m_reg, l_reg);
    l_reg += __builtin_amdgcn_exp2f(P.sink[h] * LOG2E - m_reg * C);
    store_o(lds, o, l_reg, P.BR + (size_t)(qb * 256 + wid * 32) * D + 1024 + h * 128, D);
}
__device__ __forceinline__ void unit_mla(Frame& F, const AttP& P, int h, int qb) {
    using namespace att;
    const int tid_ = opq_tid(), lane = tid_ & 63, r32 = lane & 31, hi = lane >> 5, wid = __builtin_amdgcn_readfirstlane(tid_ >> 6);
    LAS char* lds = (LAS char*)F.lds;
    const int row = qb * 256 + wid * 32 + r32;
    const bf16* Qw = P.QM + (size_t)row * QM_P + h * 192 + hi * 8;
    bf16x8 qr[8];
    LAS char* QRw = lds + OFF_QR + wid * 4096 + lane * 16;
#pragma unroll
    for (int d0 = 0; d0 < 8; ++d0) qr[d0] = ld8(Qw + d0 * 16);
#pragma unroll
    for (int d = 0; d < 2; ++d) {
        const v4u wa = __builtin_bit_cast(v4u, ld8(Qw + 128 + d * 16)), wb = __builtin_bit_cast(v4u, ld8(Qw + 160 + d * 16));
        f32x4 a0, a1, b0, b1; pg8::unpack8(wa, a0, a1); pg8::unpack8(wb, b0, b1);
        const float* cp = P.c64 + (size_t)row * 32 + d * 16 + hi * 8; const float* sp = P.s64 + (size_t)row * 32 + d * 16 + hi * 8;
        const f32x4 c0 = *(const f32x4*)cp, c1 = *(const f32x4*)(cp + 4), s0 = *(const f32x4*)sp, s1 = *(const f32x4*)(sp + 4);
        const f32x4 n0 = a0 * c0 - b0 * s0, n1 = a1 * c1 - b1 * s1, m0 = b0 * c0 + a0 * s0, m1 = b1 * c1 + a1 * s1;
        v4u o1, o2; o1.x = pk2(n0[0], n0[1]); o1.y = pk2(n0[2], n0[3]); o1.z = pk2(n1[0], n1[1]); o1.w = pk2(n1[2], n1[3]);
        o2.x = pk2(m0[0], m0[1]); o2.y = pk2(m0[2], m0[3]); o2.z = pk2(m1[0], m1[1]); o2.w = pk2(m1[2], m1[3]);
        *(LAS v4u*)(QRw + d * 1024) = o1; *(LAS v4u*)(QRw + (2 + d) * 1024) = o2;
    }
    f32x16 o[4] = {}; float m_reg = -1e30f, l_reg = 0.f;
    const float scale = 0.072168783648703220f;
    attn_core<8, true, false>(lds, qr, P.KVM + h * 256, P.KVM + h * 256 + 128, KVM_P, P.Z + Z_KR, ZP, S / KVBLK, scale * LOG2E, 8.f / scale, 0, 0, 0, o, m_reg, l_reg);
    store_o(lds, o, l_reg, P.BR + (size_t)(qb * 256 + wid * 32) * D + 0 + h * 128, D);
}
__device__ __forceinline__ void unit_diff(Frame& F, const AttP& P, int h, int qb128) {
    using namespace att;
    const int tid_ = opq_tid(), lane = tid_ & 63, r32 = lane & 31, hi = lane >> 5, wid = __builtin_amdgcn_readfirstlane(tid_ >> 6);
    LAS char* lds = (LAS char*)F.lds;
    const int comp = wid >> 2, wq = wid & 3;
    const int row = qb128 * 128 + wq * 32 + r32;
    const bf16* Qw = P.Z + (size_t)row * ZP + Z_DQ + (2 * h + comp) * 64 + hi * 8;
    bf16x8 qr[4];
#pragma unroll
    for (int d0 = 0; d0 < 4; ++d0) qr[d0] = ld8(Qw + d0 * 16);
    f32x16 o[4] = {}; float m_reg = -1e30f, l_reg = 0.f;
    const float scale = 0.125f;
    attn_core<4, false, false>(lds, qr, P.Z + Z_DK + h * 128, P.Z + Z_DV + h * 128, ZP, nullptr, 0, S / KVBLK, scale * LOG2E, 8.f / scale, 4 * comp, 0, 0, o, m_reg, l_reg);
    const float la = wave_sum(P.lam_p[lane] * P.lam_p[64 + lane]), lb = wave_sum(P.lam_p[128 + lane] * P.lam_p[192 + lane]);
    const float lam = expf(la) - expf(lb) + P.lam_init;
    LAS float* li_l = (LAS float*)(lds + OFF_WS) + wid * 64;
    if (hi == 0) li_l[r32] = l_reg; asm volatile("s_waitcnt lgkmcnt(0)" ::: "memory");
#pragma unroll
    for (int r = 0; r < 16; ++r) { const float rl = __builtin_amdgcn_rcpf(li_l[crow(r, hi)]);
#pragma unroll
        for (int d = 0; d < 4; ++d) o[d][r] *= rl; }
    __syncthreads();
    LAS float* X = (LAS float*)lds + wq * 4096;
    if (comp == 1) {
#pragma unroll
        for (int d = 0; d < 4; ++d)
#pragma unroll
            for (int r = 0; r < 16; ++r) X[(d * 16 + r) * 64 + lane] = o[d][r];
    }
    __syncthreads();
    if (comp == 0) {
        float ss[16];
#pragma unroll
        for (int r = 0; r < 16; ++r) { float s = 0.f;
#pragma unroll
            for (int d = 0; d < 4; ++d) { const float v = o[d][r] - lam * X[(d * 16 + r) * 64 + lane]; o[d][r] = v; s += v * v; }
            ss[r] = s; }
#pragma unroll
        for (int r = 0; r < 16; ++r) { float s = ss[r]; s += __shfl_xor(s, 1); s += __shfl_xor(s, 2); s += __shfl_xor(s, 4); s += __shfl_xor(s, 8); s += __shfl_xor(s, 16);
            ss[r] = (1.0f - P.lam_init) / sqrtf(s * (1.0f / 128.0f) + RMS_EPS); }
        float gn[4];
#pragma unroll
        for (int d = 0; d < 4; ++d) gn[d] = P.subln[d * 32 + r32];
        bf16* Ow = P.BR + (size_t)(qb128 * 128 + wq * 32) * D + 512 + h * 128;
#pragma unroll
        for (int r = 0; r < 16; ++r) { const int orow = crow(r, hi);
#pragma unroll
            for (int d = 0; d < 4; ++d) Ow[(long)orow * D + d * 32 + r32] = (bf16)f2bf(o[d][r] * ss[r] * gn[d]); }
    }
    __syncthreads();
}
__device__ const float INVF128[64] = {
1.000000000e+00f, 8.659643531e-01f, 7.498942018e-01f, 6.493816376e-01f, 5.623413324e-01f, 4.869675338e-01f, 4.216965139e-01f, 3.651741147e-01f, 3.162277639e-01f, 2.738419771e-01f, 2.371373773e-01f, 2.053525001e-01f, 1.778279394e-01f, 1.539926529e-01f, 1.333521456e-01f, 1.154781953e-01f, 1.000000015e-01f, 8.659642935e-02f, 7.498942316e-02f, 6.493816525e-02f, 5.623413250e-02f, 4.869675264e-02f, 4.216964915e-02f, 3.651741147e-02f, 3.162277490e-02f, 2.738419548e-02f, 2.371373773e-02f, 2.053525113e-02f, 1.778279431e-02f, 1.539926510e-02f, 1.333521400e-02f, 1.154781971e-02f, 9.999999776e-03f, 8.659643121e-03f, 7.498942316e-03f, 6.493816152e-03f, 5.623413250e-03f, 4.869675264e-03f, 4.216964822e-03f, 3.651741194e-03f, 3.162277630e-03f, 2.738419687e-03f, 2.371373819e-03f, 2.053525066e-03f, 1.778279431e-03f, 1.539926510e-03f, 1.333521446e-03f, 1.154782018e-03f, 1.000000047e-03f, 8.659643354e-04f, 7.498941850e-04f, 6.493816036e-04f, 5.623413017e-04f, 4.869675322e-04f, 4.216965172e-04f, 3.651741135e-04f, 3.162277571e-04f, 2.738419571e-04f, 2.371373703e-04f, 2.053525095e-04f, 1.778279402e-04f, 1.539926598e-04f, 1.333521504e-04f, 1.154782003e-04f };
__device__ __forceinline__ void sincos_d(double a, float& sn, float& cs) {
    const double k = rint(a * 0.63661977236758134308);
    const double r = (a - k * 1.57079632673412561417e+00) - k * 6.07710050650619224932e-11;
    const double r2 = r * r;
    double ps = -1.0 / 6227020800.0; ps = ps * r2 + 1.0 / 39916800.0; ps = ps * r2 - 1.0 / 362880.0; ps = ps * r2 + 1.0 / 5040.0; ps = ps * r2 - 1.0 / 120.0; ps = ps * r2 + 1.0 / 6.0;
    const double s = r - r * r2 * ps;
    double pc = 1.0 / 87178291200.0; pc = pc * r2 - 1.0 / 479001600.0; pc = pc * r2 + 1.0 / 3628800.0; pc = pc * r2 - 1.0 / 40320.0; pc = pc * r2 + 1.0 / 720.0; pc = pc * r2 - 1.0 / 24.0; pc = pc * r2 + 0.5;
    const double c = 1.0 - r2 * pc;
    const int q = (int)((long long)k & 3);
    const double so = (q == 0) ? s : (q == 1) ? c : (q == 2) ? -s : -c;
    const double co = (q == 0) ? c : (q == 1) ? -s : (q == 2) ? -c : s;
    sn = (float)so; cs = (float)co;
}

#ifndef PHMASK
#define PHMASK 0xFFFFFF
#endif
#define PHEN(i) (((PHMASK) >> (i)) & 1)
#ifndef AMASK
#define AMASK 0xF
#endif
#define AEN(i) (((AMASK) >> (i)) & 1)
constexpr int NPH = 12;
constexpr int NPHASES = 1 + DEPTH * NPH;
struct Args { const float* in[24]; float* out; unsigned char* ws; int ph_lo, ph_hi, li, pad; float lam_init[4]; };

__global__ void __launch_bounds__(NWAVES * 64, 2) mk_fwd(Args args) {
    extern __shared__ __attribute__((aligned(16))) unsigned char lds[];
    Frame F;
    F.lds = (LAS unsigned char*)lds;
    F.MISC = (volatile LAS unsigned*)(F.lds + MISC_OFF);
    F.tid = threadIdx.x; F.lane = F.tid & 63; F.wave = __builtin_amdgcn_readfirstlane(F.tid >> 6);
    F.G = gridDim.x; { const int bx = blockIdx.x; F.vcu = (F.G % 8 == 0) ? (bx % 8) * (F.G / 8) + bx / 8 : bx; }
    unsigned char* ws = args.ws;
    F.ctl = (gu32*)(ws + WS_CTL);
    for (int u = F.tid; u < (LDS_BYTES - LDSCTL_OFF) / 4; u += NWAVES * 64) ((LAS unsigned*)(F.lds + LDSCTL_OFF))[u] = 0u;
    __syncthreads();
    XcdBarrier bar = xcd_barrier_post((unsigned*)(F.ctl + CW_BAR) + args.li * XCD_BAR_WORDS, F.MISC + 8);
    const int lo = args.ph_lo, hi = args.ph_hi;
#define IN(k) (lo <= (k) && (k) < hi)
#define SEAM(k) do { if (IN(k) && IN((k) + 1)) xcd_barrier(bar); } while (0)
    float* const X = args.out;
    float* const c64 = (float*)(ws + WS_TAB64); float* const s64 = c64 + (size_t)S * 32;
    float* const c128 = (float*)(ws + WS_TAB128); float* const s128 = c128 + (size_t)S * 64;
    bf16* const Hb = (bf16*)(ws + WS_H); bf16* const Zb = (bf16*)(ws + WS_Z); bf16* const GTb = (bf16*)(ws + WS_GT);
    bf16* const QMb = (bf16*)(ws + WS_QM); bf16* const KVMb = (bf16*)(ws + WS_KVM); bf16* const BRb = (bf16*)(ws + WS_BR);
    bf16* const Yb = (bf16*)(ws + WS_Z); float* const MFf = (float*)(ws + WS_Z); bf16* const MGb = Hb; bf16* const HIDb = GTb; bf16* const P2b = BRb;
    bf16* const PBb = (bf16*)(ws + WS_PB);

    if (PHEN(12) && IN(0)) {
        const int tid_ = opq_tid(), lane_ = tid_ & 63, wave_ = __builtin_amdgcn_readfirstlane(tid_ >> 6);
        const int gw = F.vcu * NWAVES + wave_, NGW = F.G * NWAVES;
        const int gt = F.vcu * (NWAVES * 64) + tid_, NGT = F.G * NWAVES * 64;
        {
            WSrc wsrc{args.in[7], args.in[9], args.in[11], args.in[17], args.in[18], args.in[19], args.in[20], args.in[21], args.in[22], args.in[23]};
            LAS float* scr = (LAS float*)(F.lds + RING_OFF + wave_ * 16384);
            for (int it = gw; it < DEPTH * IT_LAYER; it += NGW) { const int L = it / IT_LAYER, r = it - L * IT_LAYER;
                convert_item(wsrc, (bf16*)(ws + WS_W + (size_t)L * WL_BYTES), L, r, scr, lane_); }
            for (int i = gt; i < DEPTH * 49152; i += NGT) { const int L = i / 49152, q = i - L * 49152;
                *(v4u*)((bf16*)(ws + WS_W + (size_t)L * WL_BYTES) + WL_W1 + (size_t)ZC * D + (size_t)q * 8) = (v4u){0u, 0u, 0u, 0u}; }
        }
        for (int i = gt; i < S * 32; i += NGT) { const int pos = i >> 5, j = i & 31; const float ang = (float)pos * INVF128[2 * j]; float sn, cs; sincos_d((double)ang, sn, cs); c64[i] = cs; s64[i] = sn; }
        for (int i = gt; i < S * 64; i += NGT) { const int pos = i >> 6, j = i & 63; const float ang = (float)pos * INVF128[j]; float sn, cs; sincos_d((double)ang, sn, cs); c128[i] = cs; s128[i] = sn; }
        { const float* p = args.in[1];
          for (int i = gt; i < DEPTH * S * PLE / 8; i += NGT) { const f32x4 a = *(const f32x4*)(p + (size_t)i * 8), b = *(const f32x4*)(p + (size_t)i * 8 + 4);
              v4u o; o.x = pk2(a[0], a[1]); o.y = pk2(a[2], a[3]); o.z = pk2(b[0], b[1]); o.w = pk2(b[2], b[3]); *(v4u*)(PBb + (size_t)i * 8) = o; } }
        thin_phase<0>(F, args.in[0], nullptr, X, Hb, nullptr, args.in[2]);
    }
    SEAM(0);

    for (int L = 0; L < DEPTH; ++L) {
        const int pb = 1 + L * NPH;
        const bf16* WL = (const bf16*)(ws + WS_W + (size_t)L * WL_BYTES);
        if (PHEN(0) && IN(pb + 0)) {
            pg8::StaticOrder So; So.init(Hb, D, WL + WL_W1, D, S, N1, F.G, (int)blockIdx.x);
            pg8::EpiG1 E{Zb, GTb};
            pg8::gemm_phase<pg8::EpiG1, pg8::StaticOrder>(F.lds + RING_OFF, D, D, D, So, E);
        }
        SEAM(pb + 0);
        if (PHEN(1) && IN(pb + 1)) {
            PrepP P{Zb, c64, s64, c128, s128, args.in[8] + L * 512, args.in[10] + L * 512, args.in[15] + L * 128, args.in[16] + L * 128};
            prep_phase(F, P);
        }
        SEAM(pb + 1);
        if (PHEN(2) && IN(pb + 2)) {
            pg8::OrderG2 So{Zb, WL + WL_UQKV, F.G, (int)blockIdx.x};
            pg8::EpiG2 E{QMb, KVMb};
            pg8::gemm_phase<pg8::EpiG2, pg8::OrderG2>(F.lds + RING_OFF, 512, ZP, 512, So, E);
        }
        SEAM(pb + 2);
        if (PHEN(3) && IN(pb + 3)) {
            AttP P{Zb, QMb, KVMb, BRb, c64, s64, args.in[14] + L * 4, args.in[12] + L * 256, args.in[13] + L * 128, args.lam_init[L]};
            if (AEN(0)) for (int u = F.vcu; u < 256; u += F.G) unit_mla(F, P, u >> 6, u & 63);
            __syncthreads();
            if (AEN(1)) for (int u = F.vcu; u < 256; u += F.G) unit_axial(F, P, u >> 6, u & 63);
            __syncthreads();
            if (AEN(2)) for (int u = F.vcu; u < 256; u += F.G) {
_Pragma("unroll 1")
                for (int i2 = 0; i2 < 2; ++i2) { const int uu = 2 * u + i2; unit_diff(F, P, uu >> 7, uu & 127); } }
            if (AEN(3)) for (int u = F.vcu; u < 256; u += F.G) unit_swa(F, P, u >> 6, u & 63);
            __syncthreads();
        }
        SEAM(pb + 3);
        if (PHEN(4) && IN(pb + 4)) {
            pg8::OrderG3 So{BRb, WL + WL_BR, F.G, (int)blockIdx.x};
            pg8::EpiG3 E{GTb, MFf, MGb};
            pg8::gemm_phase<pg8::EpiG3, pg8::OrderG3>(F.lds + RING_OFF, 512, D, 512, So, E);
        }
        SEAM(pb + 4);
        if (PHEN(5) && IN(pb + 5)) {
            pg8::StaticOrder So; So.init(MGb, D, WL + WL_WO, D, S, D, F.G, (int)blockIdx.x);
            pg8::EpiPlain E{Yb, D};
            pg8::gemm_phase<pg8::EpiPlain, pg8::StaticOrder>(F.lds + RING_OFF, D, D, D, So, E);
        }
        SEAM(pb + 5);
        if (PHEN(6) && IN(pb + 6)) thin_phase<1>(F, nullptr, Yb, X, Hb, args.in[3] + L * D, args.in[4] + L * D);
        SEAM(pb + 6);
        if (PHEN(7) && IN(pb + 7)) {
            pg8::StaticOrder So; So.init(Hb, D, WL + WL_FI, D, S, 2 * FF, F.G, (int)blockIdx.x);
            pg8::EpiSwiGLU E{HIDb};
            pg8::gemm_phase<pg8::EpiSwiGLU, pg8::StaticOrder>(F.lds + RING_OFF, D, D, D, So, E);
        }
        SEAM(pb + 7);
        if (PHEN(8) && IN(pb + 8)) {
            { pg8::StaticOrder So; So.init(HIDb, FF, WL + WL_FO, FF, S, D, F.G, (int)blockIdx.x);
              pg8::EpiPlain E{Yb, D};
              pg8::gemm_phase<pg8::EpiPlain, pg8::StaticOrder>(F.lds + RING_OFF, FF, FF, FF, So, E); }
            { pg8::StaticOrder So; So.init(PBb + (size_t)L * S * PLE, PLE, WL + WL_PLE, PLE, S, D, F.G, (int)blockIdx.x);
              pg8::EpiPlain E{P2b, D};
              pg8::gemm_phase<pg8::EpiPlain, pg8::StaticOrder>(F.lds + RING_OFF, PLE, PLE, PLE, So, E); }
        }
        SEAM(pb + 8);
        if (PHEN(9) && IN(pb + 9)) thin_phase<2>(F, nullptr, Yb, X, Hb, args.in[5] + L * D, nullptr);
        SEAM(pb + 9);
        if (PHEN(10) && IN(pb + 10)) {
            pg8::StaticOrder So; So.init(Hb, D, WL + WL_PG, D, S, D, F.G, (int)blockIdx.x);
            pg8::EpiPle E{P2b, Yb};
            pg8::gemm_phase<pg8::EpiPle, pg8::StaticOrder>(F.lds + RING_OFF, D, D, D, So, E);
        }
        SEAM(pb + 10);
        if (PHEN(11) && IN(pb + 11)) {
            if (L + 1 < DEPTH) thin_phase<1>(F, nullptr, Yb, X, Hb, args.in[6] + L * D, args.in[2] + (L + 1) * D);
            else thin_phase<3>(F, nullptr, Yb, X, Hb, args.in[6] + L * D, nullptr);
        }
        SEAM(pb + 11);
    }
#undef IN
#undef SEAM
}
extern "C" void kernel_launch(void* const* d_in, const int* in_sizes, int n_in, void* d_out, int out_size, void* d_ws, size_t ws_size, hipStream_t stream) {
    static int grid = 0;
    if (grid == 0) {
        const size_t need = MK_DEBUG ? WS_DBG_END : WS_END;
        if (n_in != 24 || in_sizes[0] != S * D || out_size != S * D || ws_size < need) {
            fprintf(stderr, "kernel_launch: built for 24 inputs, x and out of %d floats, >= %zu bytes of workspace; got n_in %d, in0 %d, out %d, ws %zu; nothing launched\n", S * D, need, n_in, n_in > 0 ? in_sizes[0] : -1, out_size, ws_size);
            grid = -1; return; }
        int dev = 0, cus = 0, per_cu = 0;
        if (hipGetDevice(&dev) != hipSuccess || hipDeviceGetAttribute(&cus, hipDeviceAttributeMultiprocessorCount, dev) != hipSuccess) { fprintf(stderr, "kernel_launch: hipGetDevice / hipDeviceGetAttribute failed\n"); grid = -1; return; }
        if (hipFuncSetAttribute((const void*)mk_fwd, hipFuncAttributeMaxDynamicSharedMemorySize, LDS_BYTES) != hipSuccess) { fprintf(stderr, "kernel_launch: hipFuncSetAttribute failed\n"); grid = -1; return; }
        if (hipOccupancyMaxActiveBlocksPerMultiprocessor(&per_cu, (const void*)mk_fwd, NWAVES * 64, LDS_BYTES) != hipSuccess || per_cu < 1)
            fprintf(stderr, "kernel_launch: note: the occupancy query reports %d workgroups per CU\n", per_cu);
        (void)hipGetLastError();
        grid = cus;
    }
    if (grid < 0) return;
    if (hipMemsetAsync((char*)d_ws + WS_CTL, 0, CTL_ZERO_BYTES, stream) != hipSuccess) { fprintf(stderr, "kernel_launch: hipMemsetAsync failed\n"); return; }
    Args a{};
    for (int i = 0; i < 24; ++i) a.in[i] = (const float*)d_in[i];
    a.out = (float*)d_out; a.ws = (unsigned char*)d_ws;
    for (int i = 0; i < DEPTH; ++i) a.lam_init[i] = (float)(0.8 - 0.6 * exp(-0.3 * (double)i));
#if MK_DEBUG
    for (int ph = 0; ph < NPHASES; ++ph) {
        a.ph_lo = ph; a.ph_hi = ph + 1; a.li = ph;
        dbg_pre(ph, a, stream);
        hipLaunchKernelGGL(mk_fwd, dim3(grid), dim3(NWAVES * 64), LDS_BYTES, stream, a);
        dbg_post(ph, a, stream);
    }
    dbg_final(a, stream);
#else
    a.ph_lo = 0; a.ph_hi = NPHASES; a.li = 0;
    hipLaunchKernelGGL(mk_fwd, dim3(grid), dim3(NWAVES * 64), LDS_BYTES, stream, a);
#endif
    const hipError_t le = hipPeekAtLastError();
    if (le != hipSuccess) fprintf(stderr, "kernel_launch: launch failed: %s (grid %d)\n", hipGetErrorName(le), grid);
}
```

```cpp
#include <hip/hip_runtime.h>
#include <cstdio>
#include <cstdint>
#include <cmath>

#ifndef MK_DEBUG
#define MK_DEBUG 0
#endif

#ifndef ATT_NEGM
#define ATT_NEGM 1
#endif
#ifndef ATT_HS
#define ATT_HS 0
#endif
#ifndef GATES_I8
#define GATES_I8 1
#endif
#ifndef FFN_I8
#define FFN_I8 1
#endif
#ifndef GATES_FP8
#define GATES_FP8 0
#endif
#define GAS __attribute__((address_space(1)))
#define LAS __attribute__((address_space(3)))
typedef unsigned short bf16;
typedef unsigned v4u __attribute__((ext_vector_type(4)));
typedef unsigned v2u __attribute__((ext_vector_type(2)));
typedef float f32x4 __attribute__((ext_vector_type(4)));
typedef float f32x2 __attribute__((ext_vector_type(2)));
typedef short bf16x8 __attribute__((ext_vector_type(8)));
typedef short s16x4 __attribute__((ext_vector_type(4)));
typedef float f32x16 __attribute__((ext_vector_type(16)));
typedef GAS unsigned gu32;
#define RLX_AGENT __ATOMIC_RELAXED, __HIP_MEMORY_SCOPE_AGENT
#define LDS_WAIT() asm volatile("s_waitcnt lgkmcnt(0)" ::: "memory")
#define VM_WAIT() asm volatile("s_waitcnt vmcnt(0)" ::: "memory")

constexpr int S = 16384, D = 2048, DEPTH = 4, FF = 5632, PLE = 256;
constexpr int ZC = 4672, ZP = 4864, NG = 8192, N1 = ZP + NG;
constexpr int Z_CQ = 0, Z_CKV = 512, Z_KR = 1024, Z_DQ = 1088, Z_DK = 1600, Z_DV = 2112, Z_SQ = 2624, Z_SK = 3136, Z_SV = 3392, Z_AQ = 3648, Z_AK = 4160, Z_AV = 4416;
constexpr int QM_P = 768, KVM_P = 1024;
constexpr float RMS_EPS = 1e-6f;
constexpr float LOG2E = 1.4426950408889634f;

constexpr size_t MiB = 1u << 20;
constexpr size_t WS_CTL = 0, CTL_ZERO_BYTES = 1 * MiB;
constexpr size_t WS_TAB64 = 1 * MiB;
constexpr size_t WS_TAB128 = 5 * MiB;
constexpr size_t WS_W = 13 * MiB;
constexpr size_t WL_W1 = 0;
constexpr size_t WL_UQKV = WL_W1 + (size_t)N1 * D;
constexpr size_t WL_BR = WL_UQKV + (size_t)1792 * 512;
constexpr size_t WL_WO = WL_BR + (size_t)4 * D * 512;
constexpr size_t WL_FI = WL_WO + (size_t)D * D;
constexpr size_t WL_FO = WL_FI + (size_t)2 * FF * D;
constexpr size_t WL_PLE = WL_FO + (size_t)D * FF;
constexpr size_t WL_PG = WL_PLE + (size_t)D * PLE;
constexpr size_t WL_ELEMS = WL_PG + (size_t)D * D;
constexpr size_t WL_BYTES = WL_ELEMS * 2;
constexpr size_t WS_PB = WS_W + ((4 * WL_BYTES + MiB - 1) / MiB) * MiB;
constexpr size_t WS_H = WS_PB + 32 * MiB;
constexpr size_t WS_Z = WS_H + 64 * MiB;
constexpr size_t WS_GT = WS_Z + 152 * MiB;
constexpr size_t WS_QM = WS_GT + 256 * MiB;
constexpr size_t WS_KVM = WS_QM + 24 * MiB;
constexpr size_t WS_BR = WS_KVM + 32 * MiB;
constexpr size_t WS_END = WS_BR + 64 * MiB;
constexpr size_t WS_XCH = WS_END;
constexpr size_t WS_END2 = WS_XCH + 12 * MiB;
constexpr size_t WS_A8 = WS_END2;
constexpr size_t WS_END3 = WS_A8 + 32 * MiB;
constexpr size_t WS_SA = WS_END3;
constexpr size_t WS_END4 = WS_SA + 1 * MiB;
constexpr size_t WS_DBG_ZCOPY = WS_QM;
constexpr size_t WS_DBG_END = WS_END4;

constexpr int CW_TMO = 0, CW_CODE = 1;
constexpr int CW_ERR = 64;
constexpr int CW_CM = 131072;
constexpr int CW_CMF = CW_CM + DEPTH * 5 * 2048;
constexpr int CW_KN2 = 230400;
constexpr int CW_KN = 230000;
#ifndef ATT_FASTDUP
#define ATT_FASTDUP 1
#endif
#ifndef ATT_QKFIN
#define ATT_QKFIN 1
#endif
#ifndef QKFSEL
#define QKFSEL (!ROPEK)
#endif
#ifndef ATT_ILV
#define ATT_ILV 1
#endif
#ifndef DUPSEL
#define DUPSEL (!ROPEK)
#endif
#ifndef ATT_LMFMA
#define ATT_LMFMA 0
#endif
#ifndef LMSEL
#define LMSEL (NQ == 4)
#endif
#ifndef ATT_NOSWAP
#define ATT_NOSWAP 1
#endif
#ifndef ATT_LPART
#define ATT_LPART 0
#endif
#ifndef ATT_FASTREF
#define ATT_FASTREF 1
#endif
constexpr int CW_BAR = 4096;
constexpr int CW_SEAM = 16384, SEAM_BANK = 64 * 64;

constexpr int NWAVES = 8;
constexpr int RING_OFF = 0, RING_BYTES = 131072;
constexpr int LDSCTL_OFF = 143360, MISC_OFF = LDSCTL_OFF + 320;
constexpr int LDS_BYTES = 147456;

__device__ __forceinline__ unsigned f2bf(float f) { unsigned u = __builtin_bit_cast(unsigned, f); return (u + 0x7fffu + ((u >> 16) & 1u)) >> 16; }
__device__ __forceinline__ unsigned pk2(float lo, float hi) { return f2bf(lo) | (f2bf(hi) << 16); }
__device__ __forceinline__ float bf2f(unsigned b) { return __builtin_bit_cast(float, b << 16); }
__device__ __forceinline__ float bflo(unsigned w) { return __builtin_bit_cast(float, w << 16); }
__device__ __forceinline__ float bfhi(unsigned w) { return __builtin_bit_cast(float, w & 0xffff0000u); }
typedef __bf16 bf16x2_t __attribute__((ext_vector_type(2)));
__device__ __forceinline__ unsigned cvt_pk_bf16(float lo, float hi) { const f32x2 v = {lo, hi}; const bf16x2_t b = __builtin_convertvector(v, bf16x2_t); return __builtin_bit_cast(unsigned, b); }
template <int M> __device__ __forceinline__ float shx(float v) { static_assert(M >= 1 && M <= 16, "shx: xor mask 1..16");
    return __builtin_bit_cast(float, __builtin_amdgcn_ds_swizzle(__builtin_bit_cast(int, v), 0x1F | (M << 10))); }
__device__ __forceinline__ float add32(float v) { auto rr = __builtin_amdgcn_permlane32_swap(__float_as_uint(v), __float_as_uint(v), false, false);
    return __uint_as_float(rr[0]) + __uint_as_float(rr[1]); }
__device__ __forceinline__ float sum32(float v) { v += shx<1>(v); v += shx<2>(v); v += shx<4>(v); v += shx<8>(v); v += shx<16>(v); return v; }
__device__ __forceinline__ float wave_sum(float v) { return add32(sum32(v)); }
__device__ __forceinline__ float wave_max(float v) { v = fmaxf(v, shx<1>(v)); v = fmaxf(v, shx<2>(v)); v = fmaxf(v, shx<4>(v)); v = fmaxf(v, shx<8>(v)); v = fmaxf(v, shx<16>(v));
    auto rr = __builtin_amdgcn_permlane32_swap(__float_as_uint(v), __float_as_uint(v), false, false); return fmaxf(__uint_as_float(rr[0]), __uint_as_float(rr[1])); }
__device__ __forceinline__ unsigned pk4_i8(float a, float b, float c, float d) { const int ia = (int)rintf(a), ib = (int)rintf(b), ic = (int)rintf(c), id = (int)rintf(d);
    return ((unsigned)ia & 0xffu) | (((unsigned)ib & 0xffu) << 8) | (((unsigned)ic & 0xffu) << 16) | ((unsigned)id << 24); }
__device__ __forceinline__ int lane_id() { unsigned z = 0u; asm volatile("" : "+v"(z)); return (int)__builtin_amdgcn_mbcnt_hi(~0u, __builtin_amdgcn_mbcnt_lo(~0u, z)); }
__device__ __forceinline__ int opq_tid(int wave) { int t = wave * 64 + lane_id(); asm volatile("" : "+v"(t)); return t; }
__device__ __forceinline__ unsigned pk4_fp8(float a, float b, float c, float d) { unsigned w = 0u; w = __builtin_amdgcn_cvt_pk_fp8_f32(a, b, w, false); w = __builtin_amdgcn_cvt_pk_fp8_f32(c, d, w, true); return w; }
__device__ __forceinline__ float sigmoidf_(float v) { return __builtin_amdgcn_rcpf(1.0f + __builtin_amdgcn_exp2f(-v * LOG2E)); }

#define XB_TMO      128
#define XB_XCNT(j)  (256  + 64 * (j))
#define XB_XSUB(j)  (1280 + 64 * (j))
#define XB_XGEN(j)  (2304 + 64 * (j))
#define XB_TOP      3328
#define XB_TOPGEN   3392
#define XCD_BAR_WORDS 3456
#define XB_SPIN_CAP (1u << 18)

__device__ __forceinline__ unsigned xb_ld(unsigned* p)              { return __hip_atomic_load(p, __ATOMIC_RELAXED, __HIP_MEMORY_SCOPE_AGENT); }
__device__ __forceinline__ unsigned xb_add(unsigned* p, unsigned v) { return __hip_atomic_fetch_add(p, v, __ATOMIC_RELAXED, __HIP_MEMORY_SCOPE_AGENT); }
__device__ __forceinline__ unsigned xb_xcc_id() { return (unsigned)__builtin_amdgcn_s_getreg((3 << 11) | 20) & 0xFu; }
#define XB_SPIN(cond, bar) do { unsigned _sp = 0; while (cond) { __builtin_amdgcn_s_sleep(1); \
    if ((++_sp & 255u) == 0u) { if (xb_ld(&(bar)[XB_TMO])) break; if (_sp > XB_SPIN_CAP) { atomicAdd(&(bar)[XB_TMO], 1u); break; } } } } while (0)

struct XcdBarrier {
    unsigned* bar; unsigned x; int wave;
    volatile LAS unsigned* st;
};
__device__ __forceinline__ XcdBarrier xcd_barrier_post(unsigned* bar, volatile LAS unsigned* st, int wave) {
    XcdBarrier b; b.bar = bar; b.x = xb_xcc_id(); b.st = st; b.wave = wave;
    if (threadIdx.x == 0) (void)xb_add(&bar[XB_XCNT(b.x)], 1u);
    return b;
}
__device__ __forceinline__ void xcd_barrier_complete(unsigned* bar, unsigned x, unsigned& nloc, unsigned& nx) {
    const unsigned G = gridDim.x * gridDim.y * gridDim.z;
    unsigned sum, cnt, mine, sp = 0u;
    for (;;) {
        sum = 0u; cnt = 0u; mine = 0u;
#pragma unroll
        for (unsigned j = 0; j < 16; ++j) { const unsigned c = xb_ld(&bar[XB_XCNT(j)]); sum += c; cnt += (c > 0u) ? 1u : 0u; mine = (j == x) ? c : mine; }
        if (sum == G) break;
        __builtin_amdgcn_s_sleep(1);
        if ((++sp & 255u) == 0u) { if (xb_ld(&bar[XB_TMO])) break; if (sp > XB_SPIN_CAP) { atomicAdd(&bar[XB_TMO], 1u); break; } }
    }
    nloc = mine > 0u ? mine : 1u; nx = cnt > 0u ? cnt : 1u;
}
__device__ __forceinline__ void xcd_barrier(const XcdBarrier& b) {
    asm volatile("s_waitcnt vmcnt(0)" ::: "memory");
    __syncthreads();
    if (b.wave == 0 && lane_id() == 0) {
        unsigned* bar = b.bar;
        __builtin_amdgcn_s_waitcnt(0);
        unsigned nloc = b.st[0], nx = b.st[1];
        if (nloc == 0u) { xcd_barrier_complete(bar, b.x, nloc, nx); b.st[0] = nloc; b.st[1] = nx; }
        const unsigned old = xb_add(&bar[XB_XSUB(b.x)], 1u);
        const unsigned gen = old / nloc;
        if (old + 1u == (gen + 1u) * nloc) {
            __builtin_amdgcn_fence(__ATOMIC_RELEASE, "agent");
            asm volatile("s_waitcnt vmcnt(0)" ::: "memory");
            const unsigned og = xb_add(&bar[XB_TOP], 1u);
            const unsigned tg = og / nx;
            if (og + 1u == (tg + 1u) * nx) xb_add(&bar[XB_TOPGEN], 1u);
            else XB_SPIN(xb_ld(&bar[XB_TOPGEN]) == tg, bar);
            __builtin_amdgcn_fence(__ATOMIC_ACQUIRE, "agent");
            xb_add(&bar[XB_XGEN(b.x)], 1u);
            asm volatile("s_waitcnt vmcnt(0)" ::: "memory");
        } else {
            XB_SPIN(xb_ld(&bar[XB_XGEN(b.x)]) == gen, bar);
            __builtin_amdgcn_fence(__ATOMIC_ACQUIRE, "agent");
            asm volatile("s_waitcnt vmcnt(0)" ::: "memory");
        }
    }
    __syncthreads();
}
namespace pg8 {
#define PG8_LAS __attribute__((address_space(3)))
typedef unsigned short bf16_t;
constexpr int BM = 256, BK = 64, HALF = 128, HTB = HALF * BK * 2  , STAGE_BYTES = 8 * HTB, NXCD = 8, WGM = 8;

__host__ __device__ __forceinline__ int lds_byte(int r, int c) { const int st = (r >> 4) * 2 + (c >> 5), rr = r & 15, cc = c & 31, ob = rr * 64 + cc * 2; return st * 1024 + (ob ^ (((ob >> 9) & 1) << 5)); }
__host__ __device__ __forceinline__ void stage_rc(int b, int& R, int& C) { const int st = b / 1024, sb = b % 1024, swz = sb ^ (((sb >> 9) & 1) << 5); R = (st >> 1) * 16 + swz / 64; C = (st & 1) * 32 + (swz % 64) / 2; }
__host__ __device__ __forceinline__ int perm32(int rho) { const int n = rho >> 4, i = rho & 15; return 8 * (i >> 2) + 4 * n + (i & 3); }

typedef int v8i_t __attribute__((ext_vector_type(8)));
typedef int v4i_t __attribute__((ext_vector_type(4)));
__device__ __forceinline__ v8i_t cat8(bf16x8 lo, bf16x8 hi) { const v4i_t a = __builtin_bit_cast(v4i_t, lo), b = __builtin_bit_cast(v4i_t, hi); return __builtin_shufflevector(a, b, 0, 1, 2, 3, 4, 5, 6, 7); }
__device__ __forceinline__ const char* uptr(const char* p) { const unsigned long long v = (unsigned long long)p; const unsigned lo = (unsigned)__builtin_amdgcn_readfirstlane((int)(unsigned)v), hi = (unsigned)__builtin_amdgcn_readfirstlane((int)(unsigned)(v >> 32)); return (const char*)(((unsigned long long)hi << 32) | lo); }
__device__ __forceinline__ void mx_mfma(f32x4& acc, const v8i_t a, const v8i_t b, const int sa, const int sb) {
    asm volatile("v_mfma_scale_f32_16x16x128_f8f6f4 %0, %1, %2, %0, %3, %4 op_sel_hi:[0,0,0]" : "+v"(acc) : "v"(a), "v"(b), "v"(sa), "v"(sb)); }
__device__ __forceinline__ void i8_mfma(f32x4& acc, const bf16x8 a, const bf16x8 b) {
    asm volatile("v_mfma_i32_16x16x64_i8 %0, %1, %2, %0" : "+v"(acc) : "v"(a), "v"(b)); }
__device__ __forceinline__ f32x4 i2f4(const f32x4 a) { const v4i_t i = __builtin_bit_cast(v4i_t, a); return (f32x4){(float)i[0], (float)i[1], (float)i[2], (float)i[3]}; }
struct Unit { int pm, pn, j; };

__device__ __forceinline__ void tile_of(int L, int nM, int nN, int& pm, int& pn) {
    const int nwg = nM * nN; int wgid = L;
    { const int q = nwg / NXCD, r = nwg % NXCD, xcd = wgid % NXCD, off = wgid / NXCD; wgid = (xcd < r ? xcd * (q + 1) : r * (q + 1) + (xcd - r) * q) + off; }
    const int nig = WGM * nN, gid = wgid / nig, fm = gid * WGM, gsz = (nM - fm) < WGM ? (nM - fm) : WGM;
    pm = fm + ((wgid % nig) % gsz); pn = (wgid % nig) / gsz;
}
struct StaticOrder {
    static constexpr bool SINGLE = false;
    const bf16_t* A; const bf16_t* Bt; int lda, ldb; int nM, nN, nwg, G, c;
    __device__ void init(const bf16_t* A_, int lda_, const bf16_t* Bt_, int ldb_, int M, int N, int G_, int c_) { A = A_; Bt = Bt_; lda = lda_; ldb = ldb_; nM = M / BM; nN = N / BM; nwg = nM * nN; G = G_; c = c_; }
    __device__ __forceinline__ bool next(int i, Unit& u) const { const long L = (long)i * G + c; if (L >= nwg) return false; tile_of((int)L, nM, nN, u.pm, u.pn); u.j = 0; return true; }
    __device__ __forceinline__ const char* pa(const Unit& u) const { return (const char*)(A + (size_t)u.pm * BM * lda); }
    __device__ __forceinline__ const char* pb(const Unit& u) const { return (const char*)(Bt + (size_t)u.pn * BM * ldb); }
    __device__ __forceinline__ void a_ready(const Unit&) const {}
    __device__ __forceinline__ void done(const Unit&) const {}
};
struct OrderG2 {
    static constexpr bool SINGLE = false;
    const bf16_t* A; const bf16_t* Bt; int G, c;
    __device__ __forceinline__ bool next(int i, Unit& u) const { const long L = (long)i * G + c; if (L >= 64 * 7) return false; tile_of((int)L, 64, 7, u.pm, u.pn); u.j = 0; return true; }
    __device__ __forceinline__ const char* pa(const Unit& u) const { return (const char*)(A + (size_t)u.pm * BM * ZP + (u.pn < 3 ? 0 : 512)); }
    __device__ __forceinline__ const char* pb(const Unit& u) const { return (const char*)(Bt + (size_t)u.pn * BM * 512); }
    __device__ __forceinline__ void a_ready(const Unit&) const {}
    __device__ __forceinline__ void done(const Unit&) const {}
};
struct OrderG3 {
    static constexpr bool SINGLE = false;
    const bf16_t* A; const bf16_t* Bt; int G, c;
    __device__ __forceinline__ bool next(int i, Unit& u) const { const long t = (long)(i >> 2) * G + c; if (t >= 512) return false; tile_of((int)t, 64, 8, u.pm, u.pn); u.j = i & 3; return true; }
    __device__ __forceinline__ const char* pa(const Unit& u) const { return (const char*)(A + (size_t)u.pm * BM * D + u.j * 512); }
    __device__ __forceinline__ const char* pb(const Unit& u) const { return (const char*)(Bt + (size_t)u.j * D * 512 + (size_t)u.pn * BM * 512); }
    __device__ __forceinline__ void a_ready(const Unit&) const {}
    __device__ __forceinline__ void done(const Unit&) const {}
};

__device__ __forceinline__ v4u pack8(const f32x4 v0, const f32x4 v1) { v4u w; w.x = cvt_pk_bf16(v0[0], v0[1]); w.y = cvt_pk_bf16(v0[2], v0[3]); w.z = cvt_pk_bf16(v1[0], v1[1]); w.w = cvt_pk_bf16(v1[2], v1[3]); return w; }
__device__ __forceinline__ f32x4 sig4(const f32x4 v) { f32x4 r; r[0] = sigmoidf_(v[0]); r[1] = sigmoidf_(v[1]); r[2] = sigmoidf_(v[2]); r[3] = sigmoidf_(v[3]); return r; }
__device__ __forceinline__ void unpack8(const v4u w, f32x4& a, f32x4& b) { a[0] = bflo(w.x); a[1] = bfhi(w.x); a[2] = bflo(w.y); a[3] = bfhi(w.y); b[0] = bflo(w.z); b[1] = bfhi(w.z); b[2] = bflo(w.w); b[3] = bfhi(w.w); }

struct EpiG1 {
    static constexpr bool XCHG = false;
    bf16_t* Z; bf16_t* GT;
    __device__ __forceinline__ void operator()(const f32x4 (&acc)[2][2][4][2], const Unit& u, int wr, int wc, int fr, int fq) const {
        const int row0 = u.pm * BM + wr * 64 + fr, cw = wc * 32 + 8 * fq;
        if (u.pn < 19) {
            bf16_t* base = Z + u.pn * BM + cw;
#pragma unroll
            for (int ai = 0; ai < 2; ++ai)
#pragma unroll
                for (int m = 0; m < 4; ++m) { bf16_t* rowp = base + (size_t)(row0 + ai * HALF + m * 16) * ZP;
#pragma unroll
                    for (int bj = 0; bj < 2; ++bj) *(v4u*)(rowp + bj * HALF) = pack8(acc[ai][bj][m][0], acc[ai][bj][m][1]); }
        } else {
            bf16_t* base = GT + (u.pn - 19) * BM + cw;
#pragma unroll
            for (int ai = 0; ai < 2; ++ai)
#pragma unroll
                for (int m = 0; m < 4; ++m) { bf16_t* rowp = base + (size_t)(row0 + ai * HALF + m * 16) * NG;
#pragma unroll
                    for (int bj = 0; bj < 2; ++bj) *(v4u*)(rowp + bj * HALF) = pack8(sig4(acc[ai][bj][m][0]), sig4(acc[ai][bj][m][1])); }
        }
    }
};
struct EpiGate {
    static constexpr bool XCHG = false;
    bf16_t* GT;
    __device__ __forceinline__ void operator()(const f32x4 (&acc)[2][2][4][2], const Unit& u, int wr, int wc, int fr, int fq) const {
        const int row0 = u.pm * BM + wr * 64 + fr; bf16_t* base = GT + u.pn * BM + wc * 32 + 8 * fq;
#pragma unroll
        for (int ai = 0; ai < 2; ++ai)
#pragma unroll
            for (int m = 0; m < 4; ++m) { bf16_t* rowp = base + (size_t)(row0 + ai * HALF + m * 16) * NG;
#pragma unroll
                for (int bj = 0; bj < 2; ++bj) *(v4u*)(rowp + bj * HALF) = pack8(sig4(acc[ai][bj][m][0]), sig4(acc[ai][bj][m][1])); }
    }
};
struct EpiGateI8 {
    static constexpr bool XCHG = false;
    bf16_t* GT; const float* SA; const float* CM;
    __device__ __forceinline__ void operator()(const f32x4 (&acc)[2][2][4][2], const Unit& u, int wr, int wc, int fr, int fq) const {
        const int row0 = u.pm * BM + wr * 64 + fr, c0 = u.pn * BM + wc * 32 + 8 * fq; bf16_t* base = GT + c0;
        f32x4 sw[2][2];
#pragma unroll
        for (int bj = 0; bj < 2; ++bj) { sw[bj][0] = *(const f32x4*)(CM + c0 + bj * HALF) * (1.0f / 127.0f); sw[bj][1] = *(const f32x4*)(CM + c0 + bj * HALF + 4) * (1.0f / 127.0f); }
#pragma unroll
        for (int ai = 0; ai < 2; ++ai)
#pragma unroll
            for (int m = 0; m < 4; ++m) { const int row = row0 + ai * HALF + m * 16; const float sa = SA[row]; bf16_t* rowp = base + (size_t)row * NG;
#pragma unroll
                for (int bj = 0; bj < 2; ++bj) *(v4u*)(rowp + bj * HALF) = pack8(sig4(i2f4(acc[ai][bj][m][0]) * sw[bj][0] * sa), sig4(i2f4(acc[ai][bj][m][1]) * sw[bj][1] * sa)); }
    }
};
struct EpiPleI8 {
    static constexpr bool XCHG = false;
    const bf16_t* P2; bf16_t* O; const float* SA; const float* CM;
    __device__ __forceinline__ void operator()(const f32x4 (&acc)[2][2][4][2], const Unit& u, int wr, int wc, int fr, int fq) const {
        const int row0 = u.pm * BM + wr * 64 + fr; const int c0 = u.pn * BM + wc * 32 + 8 * fq;
        f32x4 sw[2][2];
#pragma unroll
        for (int bj = 0; bj < 2; ++bj) { sw[bj][0] = *(const f32x4*)(CM + c0 + bj * HALF) * (1.0f / 127.0f); sw[bj][1] = *(const f32x4*)(CM + c0 + bj * HALF + 4) * (1.0f / 127.0f); }
#pragma unroll
        for (int ai = 0; ai < 2; ++ai)
#pragma unroll
            for (int m = 0; m < 4; ++m) { const int row = row0 + ai * HALF + m * 16; const float sa = SA[row]; const size_t ro = (size_t)row * D + c0;
#pragma unroll
                for (int bj = 0; bj < 2; ++bj) { f32x4 p0, p1; unpack8(*(const v4u*)(P2 + ro + bj * HALF), p0, p1);
                    *(v4u*)(O + ro + bj * HALF) = pack8(sig4(i2f4(acc[ai][bj][m][0]) * sw[bj][0] * sa) * p0, sig4(i2f4(acc[ai][bj][m][1]) * sw[bj][1] * sa) * p1); }
                asm volatile("" ::: "memory"); }
    }
};
struct EpiSwiGLUI8 {
    static constexpr bool XCHG = false;
    bf16_t* Hd; const float* SA; const float* CM;
    __device__ __forceinline__ void operator()(const f32x4 (&acc)[2][2][4][2], const Unit& u, int wr, int wc, int fr, int fq) const {
        const int row0 = u.pm * BM + wr * 64 + fr; const int c0 = u.pn * HALF + wc * 32 + 8 * fq; bf16_t* base = Hd + c0;
        const f32x4 sg0 = *(const f32x4*)(CM + c0) * (1.0f / 127.0f), sg1 = *(const f32x4*)(CM + c0 + 4) * (1.0f / 127.0f);
        const f32x4 su0 = *(const f32x4*)(CM + FF + c0) * (1.0f / 127.0f), su1 = *(const f32x4*)(CM + FF + c0 + 4) * (1.0f / 127.0f);
#pragma unroll
        for (int ai = 0; ai < 2; ++ai)
#pragma unroll
            for (int m = 0; m < 4; ++m) { const int row = row0 + ai * HALF + m * 16; const float sa = SA[row]; bf16_t* rowp = base + (size_t)row * FF;
                const f32x4 g0 = i2f4(acc[ai][0][m][0]) * sg0 * sa, g1 = i2f4(acc[ai][0][m][1]) * sg1 * sa;
                const f32x4 v0 = g0 * sig4(g0) * (i2f4(acc[ai][1][m][0]) * su0 * sa), v1 = g1 * sig4(g1) * (i2f4(acc[ai][1][m][1]) * su1 * sa);
                *(v4u*)rowp = pack8(v0, v1); }
    }
};
struct EpiG2 {
    static constexpr bool XCHG = false;
    bf16_t* QM; bf16_t* KVM; unsigned* KN2;
    __device__ __forceinline__ void operator()(const f32x4 (&acc)[2][2][4][2], const Unit& u, int wr, int wc, int fr, int fq) const {
        const int row0 = u.pm * BM + wr * 64 + fr, cw = wc * 32 + 8 * fq;
        const int ldc = u.pn < 3 ? QM_P : KVM_P; bf16_t* base = (u.pn < 3 ? QM + u.pn * BM : KVM + (u.pn - 3) * BM) + cw;
        if (KN2 != nullptr && u.pn >= 3) {
            float mx = 0.f;
#pragma unroll
            for (int ai = 0; ai < 2; ++ai)
#pragma unroll
                for (int m = 0; m < 4; ++m) { const f32x4 a = acc[ai][0][m][0], b = acc[ai][0][m][1];
                    mx = fmaxf(mx, (a[0] * a[0] + a[1] * a[1]) + (a[2] * a[2] + a[3] * a[3]) + (b[0] * b[0] + b[1] * b[1]) + (b[2] * b[2] + b[3] * b[3])); }
            mx = fmaxf(mx, shx<1>(mx)); mx = fmaxf(mx, shx<2>(mx)); mx = fmaxf(mx, shx<4>(mx)); mx = fmaxf(mx, shx<8>(mx));
            if (fr == 0) atomicMax(KN2 + (u.pn - 3) * 16 + wc * 4 + fq, __float_as_uint(mx));
        }
#pragma unroll
        for (int ai = 0; ai < 2; ++ai)
#pragma unroll
            for (int m = 0; m < 4; ++m) { bf16_t* rowp = base + (size_t)(row0 + ai * HALF + m * 16) * ldc;
#pragma unroll
                for (int bj = 0; bj < 2; ++bj) *(v4u*)(rowp + bj * HALF) = pack8(acc[ai][bj][m][0], acc[ai][bj][m][1]); }
    }
};
struct EpiPlain {
    static constexpr bool XCHG = false;
    bf16_t* O; int ldc;
    __device__ __forceinline__ void operator()(const f32x4 (&acc)[2][2][4][2], const Unit& u, int wr, int wc, int fr, int fq) const {
        const int row0 = u.pm * BM + wr * 64 + fr; bf16_t* base = O + u.pn * BM + wc * 32 + 8 * fq;
#pragma unroll
        for (int ai = 0; ai < 2; ++ai)
#pragma unroll
            for (int m = 0; m < 4; ++m) { bf16_t* rowp = base + (size_t)(row0 + ai * HALF + m * 16) * ldc;
#pragma unroll
                for (int bj = 0; bj < 2; ++bj) *(v4u*)(rowp + bj * HALF) = pack8(acc[ai][bj][m][0], acc[ai][bj][m][1]); }
    }
};
struct EpiSwiGLU {
    static constexpr bool XCHG = false;
    bf16_t* Hd;
    __device__ __forceinline__ void operator()(const f32x4 (&acc)[2][2][4][2], const Unit& u, int wr, int wc, int fr, int fq) const {
        const int row0 = u.pm * BM + wr * 64 + fr; bf16_t* base = Hd + u.pn * HALF + wc * 32 + 8 * fq;
#pragma unroll
        for (int ai = 0; ai < 2; ++ai)
#pragma unroll
            for (int m = 0; m < 4; ++m) { bf16_t* rowp = base + (size_t)(row0 + ai * HALF + m * 16) * FF;
                const f32x4 g0 = acc[ai][0][m][0], g1 = acc[ai][0][m][1];
                const f32x4 v0 = g0 * sig4(g0) * acc[ai][1][m][0], v1 = g1 * sig4(g1) * acc[ai][1][m][1];
                *(v4u*)rowp = pack8(v0, v1); }
    }
};
struct EpiPle {
    static constexpr bool XCHG = false;
    const bf16_t* P2; bf16_t* O;
    __device__ __forceinline__ void operator()(const f32x4 (&acc)[2][2][4][2], const Unit& u, int wr, int wc, int fr, int fq) const {
        const int row0 = u.pm * BM + wr * 64 + fr; const int c0 = u.pn * BM + wc * 32 + 8 * fq;
#pragma unroll
        for (int ai = 0; ai < 2; ++ai)
#pragma unroll
            for (int m = 0; m < 4; ++m) { const size_t ro = (size_t)(row0 + ai * HALF + m * 16) * D + c0;
#pragma unroll
                for (int bj = 0; bj < 2; ++bj) { f32x4 p0, p1; unpack8(*(const v4u*)(P2 + ro + bj * HALF), p0, p1);
                    *(v4u*)(O + ro + bj * HALF) = pack8(sig4(acc[ai][bj][m][0]) * p0, sig4(acc[ai][bj][m][1]) * p1); }
                asm volatile("" ::: "memory"); }
    }
};
struct EpiG3 {
    static constexpr bool XCHG = false;
    const bf16_t* GT; bf16_t* MF; bf16_t* MG;
    __device__ __forceinline__ void operator()(const f32x4 (&acc)[2][2][4][2], const Unit& u, int wr, int wc, int fr, int fq) const {
        const int row0 = u.pm * BM + wr * 64 + fr; const int c0 = u.pn * BM + wc * 32 + 8 * fq; const int j = u.j;
        bf16_t* const dst = (j < 3) ? MF : MG;
#pragma unroll
        for (int ai = 0; ai < 2; ++ai)
#pragma unroll
            for (int m = 0; m < 4; ++m) { const size_t row = (size_t)(row0 + ai * HALF + m * 16);
#pragma unroll
                for (int bj = 0; bj < 2; ++bj) { const int c = c0 + bj * HALF;
                    f32x4 g0, g1; unpack8(*(const v4u*)(GT + row * NG + j * D + c), g0, g1);
                    f32x4 v0 = g0 * acc[ai][bj][m][0], v1 = g1 * acc[ai][bj][m][1];
                    if (j > 0) { f32x4 p0, p1; unpack8(*(const v4u*)(MF + row * D + c), p0, p1); v0 += p0; v1 += p1; }
                    *(v4u*)(dst + row * D + c) = pack8(v0, v1); }
                asm volatile("" ::: "memory"); }
    }
};


struct PanelOrder {
    static constexpr bool SINGLE = true;
    const bf16_t* A; const bf16_t* Bt; int lda, ldb, G, c, round;
    __device__ __forceinline__ bool next(int i, Unit& u) const { if (i >= 1 || G != 256) return false; const int k = c >> 3; u.pm = round * 32 + (c & 7) * 4 + (k >> 3); u.pn = k & 7; u.j = round; return true; }
    __device__ __forceinline__ const char* pa(const Unit& u) const { return (const char*)(A + (size_t)u.pm * BM * lda); }
    __device__ __forceinline__ const char* pb(const Unit& u) const { return (const char*)(Bt + (size_t)u.pn * BM * ldb); }
    __device__ __forceinline__ void a_ready(const Unit&) const {}
    __device__ __forceinline__ void done(const Unit&) const {}
};
constexpr int XCH_LDS_OFF = 131072 + 1024;
struct RmsXchg {
    float* xbuf;
    unsigned* cnt;
    unsigned* tmo;
    __device__ __forceinline__ void run(const f32x4 (&v)[2][2][4][2], const Unit& u, int wr, int wc, int fr, int fq, PG8_LAS unsigned char* lds, int wid, int lane) const {
        PG8_LAS float* P = (PG8_LAS float*)(lds + XCH_LDS_OFF);
        PG8_LAS float* Sx = (PG8_LAS float*)(lds + XCH_LDS_OFF + 4096);
        PG8_LAS unsigned* flag = (PG8_LAS unsigned*)(lds + XCH_LDS_OFF + 4096 + 1024);
#pragma unroll
        for (int ai = 0; ai < 2; ++ai)
#pragma unroll
            for (int m = 0; m < 4; ++m) { float s = 0.f;
#pragma unroll
                for (int bj = 0; bj < 2; ++bj)
#pragma unroll
                    for (int n = 0; n < 2; ++n) { const f32x4 x = v[ai][bj][m][n]; s += (x[0] * x[0] + x[1] * x[1]) + (x[2] * x[2] + x[3] * x[3]); }
                s += shx<16>(s); s = add32(s);
                if (fq == 0) P[(ai * HALF + wr * 64 + m * 16 + fr) * 4 + wc] = s; }
        asm volatile("s_waitcnt lgkmcnt(0)" ::: "memory"); __builtin_amdgcn_s_barrier(); asm volatile("" ::: "memory");
        const int row = wid * 32 + (lane & 31);
        if (lane < 32) { const float t = (P[row * 4 + 0] + P[row * 4 + 1]) + (P[row * 4 + 2] + P[row * 4 + 3]);
            __hip_atomic_store(xbuf + ((size_t)u.pm * BM + row) * 8 + u.pn, t, __ATOMIC_RELAXED, __HIP_MEMORY_SCOPE_AGENT); }
        asm volatile("s_waitcnt vmcnt(0)" ::: "memory");
        if (lane == 0) __hip_atomic_fetch_add(cnt + 64 * u.pm, 1u, __ATOMIC_RELAXED, __HIP_MEMORY_SCOPE_AGENT);
        if (wid == 0) {
            const unsigned long long t0 = __builtin_amdgcn_s_memrealtime(); unsigned polls = 0;
            for (;;) {
                if ((unsigned)__builtin_amdgcn_readfirstlane(__hip_atomic_load(cnt + 64 * u.pm, __ATOMIC_RELAXED, __HIP_MEMORY_SCOPE_AGENT)) >= 64u) break;
                if ((++polls & 63u) == 0u) { if (__builtin_amdgcn_readfirstlane(__hip_atomic_load(tmo, __ATOMIC_RELAXED, __HIP_MEMORY_SCOPE_AGENT)) != 0u) break;
                    if (__builtin_amdgcn_s_memrealtime() - t0 > 2000000ull) { if (lane == 0) __hip_atomic_store(tmo, 1u, __ATOMIC_RELAXED, __HIP_MEMORY_SCOPE_AGENT); break; } }
                __builtin_amdgcn_s_sleep(2);
            }
            __builtin_amdgcn_fence(__ATOMIC_ACQUIRE, "agent");
            if (lane == 0) flag[0] = 0u;
        }
        asm volatile("s_waitcnt vmcnt(0) lgkmcnt(0)" ::: "memory"); __builtin_amdgcn_s_barrier(); asm volatile("" ::: "memory");
        if (lane < 32) { const float* slot = xbuf + ((size_t)u.pm * BM + row) * 8; float t = 0.f;
#pragma unroll
            for (int q = 0; q < 8; ++q) t += __hip_atomic_load(slot + q, __ATOMIC_RELAXED, __HIP_MEMORY_SCOPE_AGENT);
            Sx[row] = 1.0f / sqrtf(t * (1.0f / 2048.0f) + 1e-6f); }
        asm volatile("s_waitcnt lgkmcnt(0)" ::: "memory"); __builtin_amdgcn_s_barrier(); asm volatile("" ::: "memory");
    }
};
template <int PRE, int POST> struct EpiNorm {
    static constexpr bool XCHG = true;
    float* X; bf16_t* Hout; const bf16_t* P2; const float* gpost; const float* gpre; RmsXchg st1, st2;
    __device__ __forceinline__ void fused(f32x4 (&acc)[2][2][4][2], const Unit& u, int wr, int wc, int fr, int fq, PG8_LAS unsigned char* lds, int wid, int lane) const {
        const PG8_LAS float* Sx = (const PG8_LAS float*)(lds + XCH_LDS_OFF + 4096);
        const int row0 = u.pm * BM + wr * 64 + fr, c0 = u.pn * BM + wc * 32 + 8 * fq;
        if constexpr (PRE == 1) {
#pragma unroll
            for (int ai = 0; ai < 2; ++ai)
#pragma unroll
                for (int m = 0; m < 4; ++m) { const size_t ro = (size_t)(row0 + ai * HALF + m * 16) * D + c0;
#pragma unroll
                    for (int bj = 0; bj < 2; ++bj) { f32x4 p0, p1; unpack8(*(const v4u*)(P2 + ro + bj * HALF), p0, p1);
                        acc[ai][bj][m][0] = sig4(acc[ai][bj][m][0]) * p0; acc[ai][bj][m][1] = sig4(acc[ai][bj][m][1]) * p1;
                        asm volatile("" : "+v"(acc[ai][bj][m][0]), "+v"(acc[ai][bj][m][1])); asm volatile("" ::: "memory"); }
                    asm volatile("" : "+v"(acc[ai][0][m][0]), "+v"(acc[ai][0][m][1]), "+v"(acc[ai][1][m][0]), "+v"(acc[ai][1][m][1])); asm volatile("" ::: "memory"); }
        }
        st1.run(acc, u, wr, wc, fr, fq, lds, wid, lane);
#pragma unroll
        for (int ai = 0; ai < 2; ++ai)
#pragma unroll
            for (int m = 0; m < 4; ++m) { const int r = ai * HALF + wr * 64 + m * 16 + fr; const float rs = Sx[r]; const size_t ro = (size_t)(u.pm * BM + r) * D + c0;
#pragma unroll
                for (int bj = 0; bj < 2; ++bj) { float* xp = X + ro + bj * HALF; const float* gp = gpost + c0 + bj * HALF;
                    const f32x4 x0 = *(const f32x4*)xp, x1 = *(const f32x4*)(xp + 4), g0 = *(const f32x4*)gp, g1 = *(const f32x4*)(gp + 4);
                    const f32x4 n0 = x0 + acc[ai][bj][m][0] * rs * g0, n1 = x1 + acc[ai][bj][m][1] * rs * g1;
                    *(f32x4*)xp = n0; *(f32x4*)(xp + 4) = n1; acc[ai][bj][m][0] = n0; acc[ai][bj][m][1] = n1;
                    if constexpr (POST == 2) *(v4u*)(Hout + ro + bj * HALF) = pack8(n0, n1);
                    asm volatile("" : "+v"(acc[ai][bj][m][0]), "+v"(acc[ai][bj][m][1])); asm volatile("" ::: "memory"); }
                asm volatile("" : "+v"(acc[ai][0][m][0]), "+v"(acc[ai][0][m][1]), "+v"(acc[ai][1][m][0]), "+v"(acc[ai][1][m][1])); asm volatile("" ::: "memory"); }
        if constexpr (POST == 1) {
            st2.run(acc, u, wr, wc, fr, fq, lds, wid, lane);
#pragma unroll
            for (int ai = 0; ai < 2; ++ai)
#pragma unroll
                for (int m = 0; m < 4; ++m) { const int r = ai * HALF + wr * 64 + m * 16 + fr; const float rs = Sx[r]; const size_t ro = (size_t)(u.pm * BM + r) * D + c0;
#pragma unroll
                    for (int bj = 0; bj < 2; ++bj) { const float* gp = gpre + c0 + bj * HALF; const f32x4 g0 = *(const f32x4*)gp, g1 = *(const f32x4*)(gp + 4);
                        *(v4u*)(Hout + ro + bj * HALF) = pack8(acc[ai][bj][m][0] * rs * g0, acc[ai][bj][m][1] * rs * g1); asm volatile("" ::: "memory"); }
                    }
        }
    }
};

template <class Epi, class Sched, bool ALIGN_EPI = true, bool FP8 = false, bool I8 = false>
__device__ __forceinline__ void gemm_phase(PG8_LAS unsigned char* lds, const int wv, const int K, const int lda, const int ldb, const Sched& S, const Epi& E) {
    const int tid = opq_tid(wv), wid = __builtin_amdgcn_readfirstlane(tid >> 6), lane = tid & 63, wr = wid >> 2, wc = wid & 3, fr = lane & 15, fq = lane >> 4;
    const int nt = FP8 ? K / 128 : K / BK;
    unsigned voffA[2], voffB[2];
#pragma unroll
    for (int i = 0; i < 2; ++i) { int R, C; stage_rc(tid * 16 + i * 8192, R, C); const int Rb = (R & ~31) + perm32(R & 31);
        if constexpr (FP8) { const int p_ = C >> 3, g_ = (p_ < 4) ? 2 * p_ : 2 * (p_ - 4) + 1; voffA[i] = (unsigned)(R * lda + g_ * 16); voffB[i] = (unsigned)(Rb * ldb + g_ * 16); }
        else { voffA[i] = (unsigned)(R * lda + C) * 2u; voffB[i] = (unsigned)(Rb * ldb + C) * 2u; } }
    const size_t kstep = (size_t)(BK * 2);
    const size_t hstepA = (size_t)HALF * lda * (FP8 ? 1 : 2), hstepB = (size_t)HALF * ldb * (FP8 ? 1 : 2);
    const unsigned ldsw = (unsigned)wid * 1024u;
    const int aoff = lds_byte(wr * 64 + fr, fq * 8), boff = lds_byte(wc * 32 + fr, fq * 8);
#define PG8_SA(b, h) (((b) * 2 + (h)) * HTB)
#define PG8_SB(b, h) ((4 + (b) * 2 + (h)) * HTB)
#define PG8_STAGE(bufoff, gbase, voff) do { const char* gb_ = uptr((const char*)(gbase)); _Pragma("unroll") for (int _i = 0; _i < 2; ++_i) \
        __builtin_amdgcn_global_load_lds((const unsigned*)(gb_ + (voff)[_i]), (PG8_LAS unsigned*)(lds + (bufoff) + ldsw + _i * 8192), 16, 0, 0); } while (0)
#define PG8_LDA(dst, b, h) do { _Pragma("unroll") for (int m = 0; m < 4; ++m) _Pragma("unroll") for (int k = 0; k < 2; ++k) dst[m][k] = *(const PG8_LAS bf16x8*)(lds + PG8_SA(b, h) + aoff + m * 2048 + k * 1024); } while (0)
#define PG8_LDB(dst, b, h) do { _Pragma("unroll") for (int n = 0; n < 2; ++n) _Pragma("unroll") for (int k = 0; k < 2; ++k) dst[n][k] = *(const PG8_LAS bf16x8*)(lds + PG8_SB(b, h) + boff + n * 2048 + k * 1024); } while (0)
#define PG8_MMA(ai, bj, At, Bt) do { __builtin_amdgcn_s_setprio(1); \
        if constexpr (FP8) { _Pragma("unroll") for (int m = 0; m < 4; ++m) _Pragma("unroll") for (int n = 0; n < 2; ++n) \
            mx_mfma(acc[ai][bj][m][n], cat8(Bt[n][0], Bt[n][1]), cat8(At[m][0], At[m][1]), sc_w, sc_a); } \
        else if constexpr (I8) { _Pragma("unroll") for (int m = 0; m < 4; ++m) _Pragma("unroll") for (int n = 0; n < 2; ++n) _Pragma("unroll") for (int k = 0; k < 2; ++k) \
            i8_mfma(acc[ai][bj][m][n], Bt[n][k], At[m][k]); } \
        else { _Pragma("unroll") for (int m = 0; m < 4; ++m) _Pragma("unroll") for (int n = 0; n < 2; ++n) _Pragma("unroll") for (int k = 0; k < 2; ++k) \
            acc[ai][bj][m][n] = __builtin_amdgcn_mfma_f32_16x16x32_bf16(Bt[n][k], At[m][k], acc[ai][bj][m][n], 0, 0, 0); } \
        __builtin_amdgcn_s_setprio(0); } while (0)
#define PG8_WAIT_V(n) asm volatile("s_waitcnt vmcnt(" #n ")" ::: "memory")
#define PG8_WAIT_L(n) asm volatile("s_waitcnt lgkmcnt(" #n ")" ::: "memory")
#define PG8_BAR __builtin_amdgcn_s_barrier()
#define PG8_SCHED __builtin_amdgcn_sched_barrier(0)
    Unit cur, nxt; int ui = 0;
    if (!S.next(0, cur)) return;
    f32x4 acc[2][2][4][2];
#pragma unroll
    for (int a = 0; a < 2; ++a)
#pragma unroll
        for (int b = 0; b < 2; ++b)
#pragma unroll
            for (int m = 0; m < 4; ++m)
#pragma unroll
                for (int n = 0; n < 2; ++n) acc[a][b][m][n] = (f32x4){0.f, 0.f, 0.f, 0.f};
    bf16x8 At[4][2], B0[2][2], B1[2][2];
    int sc_w = 0x79797979, sc_a = 0x7f7f7f7f; if constexpr (FP8) asm volatile("" : "+v"(sc_w), "+v"(sc_a));
    const char* cA = S.pa(cur); const char* cB = S.pb(cur);
    S.a_ready(cur);
    PG8_STAGE(PG8_SB(0, 0), cB, voffB); PG8_STAGE(PG8_SB(0, 1), cB + hstepB, voffB); PG8_STAGE(PG8_SA(0, 0), cA, voffA); PG8_STAGE(PG8_SA(0, 1), cA + hstepA, voffA);
    if (wr == 1) PG8_BAR;
    PG8_WAIT_V(2); PG8_BAR;
    PG8_STAGE(PG8_SB(1, 0), cB + kstep, voffB); PG8_STAGE(PG8_SA(1, 0), cA + kstep, voffA); PG8_STAGE(PG8_SB(1, 1), cB + hstepB + kstep, voffB);
    PG8_WAIT_V(6); PG8_BAR;
    for (;;) {
        const bool has_next = Sched::SINGLE ? false : S.next(ui + 1, nxt);
        const char* nA = has_next ? S.pa(nxt) : cA; const char* nB = has_next ? S.pb(nxt) : cB;
#pragma unroll 1
        for (int t = 0; t < nt; t += 2) {
            const bool last = (t == nt - 2);
            const char* a1 = cA + (size_t)(t + 1) * kstep;
            const char* a2 = last ? nA : cA + (size_t)(t + 2) * kstep; const char* b2 = last ? nB : cB + (size_t)(t + 2) * kstep;
            const char* a3 = a2 + kstep; const char* b3 = b2 + kstep;
            if (last && has_next) S.a_ready(nxt);
            PG8_LDB(B0, 0, 0); PG8_LDB(B1, 0, 1); PG8_SCHED; PG8_LDA(At, 0, 0); PG8_STAGE(PG8_SA(1, 1), a1 + hstepA, voffA);
            PG8_WAIT_V(8); PG8_WAIT_L(0); PG8_BAR; PG8_MMA(0, 0, At, B0); PG8_MMA(0, 1, At, B1); PG8_BAR; PG8_SCHED;
            PG8_LDA(At, 0, 1); PG8_STAGE(PG8_SB(0, 0), b2, voffB); PG8_STAGE(PG8_SB(0, 1), b2 + hstepB, voffB); PG8_STAGE(PG8_SA(0, 0), a2, voffA);
            PG8_WAIT_V(8); PG8_WAIT_L(0); PG8_BAR; PG8_MMA(1, 0, At, B0); PG8_MMA(1, 1, At, B1); PG8_BAR; PG8_SCHED;
            PG8_LDB(B0, 1, 0); PG8_LDB(B1, 1, 1); PG8_SCHED; PG8_LDA(At, 1, 0); PG8_STAGE(PG8_SA(0, 1), a2 + hstepA, voffA);
            PG8_WAIT_V(8); PG8_WAIT_L(0); PG8_BAR; PG8_MMA(0, 0, At, B0); PG8_MMA(0, 1, At, B1); PG8_BAR; PG8_SCHED;
            PG8_LDA(At, 1, 1); PG8_STAGE(PG8_SB(1, 0), b3, voffB); PG8_STAGE(PG8_SB(1, 1), b3 + hstepB, voffB); PG8_STAGE(PG8_SA(1, 0), a3, voffA);
            PG8_WAIT_V(8); PG8_WAIT_L(0); PG8_BAR; PG8_MMA(1, 0, At, B0); PG8_MMA(1, 1, At, B1); PG8_BAR; PG8_SCHED;
        }
        if constexpr (FP8 || I8) asm volatile("s_nop 15\n\ts_nop 15" ::: "memory");
        if constexpr (ALIGN_EPI) { if (wr == 0) PG8_BAR; }
        if constexpr (Epi::XCHG) E.fused(acc, cur, wr, wc, fr, fq, lds, wid, lane); else E(acc, cur, wr, wc, fr, fq);
        S.done(cur);
        if (!has_next) break;
#pragma unroll
        for (int a = 0; a < 2; ++a)
#pragma unroll
            for (int b = 0; b < 2; ++b)
#pragma unroll
                for (int m = 0; m < 4; ++m)
#pragma unroll
                    for (int n = 0; n < 2; ++n) acc[a][b][m][n] = (f32x4){0.f, 0.f, 0.f, 0.f};
        cur = nxt; cA = nA; cB = nB; ++ui;
        if constexpr (ALIGN_EPI) { if (wr == 1) PG8_BAR; }
    }
    PG8_WAIT_V(0);
    if constexpr (!ALIGN_EPI) { if (wr == 0) PG8_BAR; }
    PG8_BAR;
#undef PG8_SA
#undef PG8_SB
#undef PG8_STAGE
#undef PG8_LDA
#undef PG8_LDB
#undef PG8_MMA
#undef PG8_WAIT_V
#undef PG8_WAIT_L
#undef PG8_BAR
#undef PG8_SCHED
}

struct OrderG3h {
    static constexpr bool SINGLE = false;
    const bf16_t* A; const bf16_t* Bt; int G, c;
    __device__ __forceinline__ bool next(int i, Unit& u) const { const long t = (long)(i >> 2) * G + c; if (t >= 1024) return false; tile_of((int)t, 64, 16, u.pm, u.pn); u.j = i & 3; return true; }
    __device__ __forceinline__ const char* pa(const Unit& u) const { return (const char*)(A + (size_t)u.pm * BM * D + u.j * 512); }
    __device__ __forceinline__ const char* pb(const Unit& u) const { return (const char*)(Bt + (size_t)u.j * D * 512 + (size_t)u.pn * HALF * 512); }
};
struct EpiG3h {
    const bf16_t* GT; bf16_t* MG;
    __device__ __forceinline__ void operator()(const f32x4 (&acc)[2][4][2], f32x4 (&mg)[2][4][2], const Unit& u, int wr, int wc, int fr, int fq) const {
        const int row0 = u.pm * BM + wr * 64 + fr; const int c0 = u.pn * HALF + wc * 32 + 8 * fq; const int j = u.j;
#pragma unroll
        for (int ai = 0; ai < 2; ++ai)
#pragma unroll
            for (int m = 0; m < 4; ++m) { const size_t row = (size_t)(row0 + ai * HALF + m * 16);
                f32x4 g0, g1; unpack8(*(const v4u*)(GT + row * NG + j * D + c0), g0, g1);
                f32x4 v0 = g0 * acc[ai][m][0], v1 = g1 * acc[ai][m][1];
                if (j > 0) { v0 += mg[ai][m][0]; v1 += mg[ai][m][1]; }
                mg[ai][m][0] = v0; mg[ai][m][1] = v1;
                if (j == 3) *(v4u*)(MG + row * D + c0) = pack8(v0, v1); }
    }
};
template <class Epi, class Sched>
__device__ __forceinline__ void gemm_phase_h(PG8_LAS unsigned char* lds, const int wv, const int K, const int lda, const int ldb, const Sched& S, const Epi& E) {
    const int tid = opq_tid(wv), wid = __builtin_amdgcn_readfirstlane(tid >> 6), lane = tid & 63, wr = wid >> 2, wc = wid & 3, fr = lane & 15, fq = lane >> 4;
    const int nt = K / BK;
    unsigned voffA[2], voffB[2];
#pragma unroll
    for (int i = 0; i < 2; ++i) { int R, C; stage_rc(tid * 16 + i * 8192, R, C); const int Rb = (R & ~31) + perm32(R & 31);
        voffA[i] = (unsigned)(R * lda + C) * 2u; voffB[i] = (unsigned)(Rb * ldb + C) * 2u; }
    const size_t kstep = (size_t)(BK * 2);
    const size_t hstepA = (size_t)HALF * lda * 2;
    const unsigned ldsw = (unsigned)wid * 1024u;
    const int aoff = lds_byte(wr * 64 + fr, fq * 8), boff = lds_byte(wc * 32 + fr, fq * 8);
#define PG8_SA(b, h) (((b) * 2 + (h)) * HTB)
#define PG8_SB(b) ((4 + (b) * 2) * HTB)
#define PG8_STAGE(bufoff, gbase, voff) do { const char* gb_ = uptr((const char*)(gbase)); _Pragma("unroll") for (int _i = 0; _i < 2; ++_i) \
        __builtin_amdgcn_global_load_lds((const unsigned*)(gb_ + (voff)[_i]), (PG8_LAS unsigned*)(lds + (bufoff) + ldsw + _i * 8192), 16, 0, 0); } while (0)
#define PG8_LDA(dst, b, h) do { _Pragma("unroll") for (int m = 0; m < 4; ++m) _Pragma("unroll") for (int k = 0; k < 2; ++k) dst[m][k] = *(const PG8_LAS bf16x8*)(lds + PG8_SA(b, h) + aoff + m * 2048 + k * 1024); } while (0)
#define PG8_LDB(dst, b) do { _Pragma("unroll") for (int n = 0; n < 2; ++n) _Pragma("unroll") for (int k = 0; k < 2; ++k) dst[n][k] = *(const PG8_LAS bf16x8*)(lds + PG8_SB(b) + boff + n * 2048 + k * 1024); } while (0)
#define PG8_MMA(ai, At, Bt) do { __builtin_amdgcn_s_setprio(1); _Pragma("unroll") for (int m = 0; m < 4; ++m) _Pragma("unroll") for (int n = 0; n < 2; ++n) _Pragma("unroll") for (int k = 0; k < 2; ++k) \
        acc[ai][m][n] = __builtin_amdgcn_mfma_f32_16x16x32_bf16(Bt[n][k], At[m][k], acc[ai][m][n], 0, 0, 0); __builtin_amdgcn_s_setprio(0); } while (0)
#define PG8_WAIT_V(n) asm volatile("s_waitcnt vmcnt(" #n ")" ::: "memory")
#define PG8_WAIT_L(n) asm volatile("s_waitcnt lgkmcnt(" #n ")" ::: "memory")
#define PG8_BAR __builtin_amdgcn_s_barrier()
#define PG8_SCHED __builtin_amdgcn_sched_barrier(0)
    Unit cur, nxt; int ui = 0;
    if (!S.next(0, cur)) return;
    f32x4 acc[2][4][2], mg[2][4][2];
#pragma unroll
    for (int a = 0; a < 2; ++a)
#pragma unroll
        for (int m = 0; m < 4; ++m)
#pragma unroll
            for (int n = 0; n < 2; ++n) { acc[a][m][n] = (f32x4){0.f, 0.f, 0.f, 0.f}; mg[a][m][n] = (f32x4){0.f, 0.f, 0.f, 0.f}; }
    bf16x8 At[4][2], B0[2][2];
    const char* cA = S.pa(cur); const char* cB = S.pb(cur);
    PG8_STAGE(PG8_SB(0), cB, voffB); PG8_STAGE(PG8_SA(0, 0), cA, voffA); PG8_STAGE(PG8_SA(0, 1), cA + hstepA, voffA);
    if (wr == 1) PG8_BAR;
    PG8_WAIT_V(2); PG8_BAR;
    PG8_STAGE(PG8_SB(1), cB + kstep, voffB); PG8_STAGE(PG8_SA(1, 0), cA + kstep, voffA);
    PG8_WAIT_V(4); PG8_BAR;
    for (;;) {
        const bool has_next = S.next(ui + 1, nxt);
        const char* nA = has_next ? S.pa(nxt) : cA; const char* nB = has_next ? S.pb(nxt) : cB;
#pragma unroll 1
        for (int t = 0; t < nt; t += 2) {
            const bool last = (t == nt - 2);
            const char* a1 = cA + (size_t)(t + 1) * kstep;
            const char* a2 = last ? nA : cA + (size_t)(t + 2) * kstep; const char* b2 = last ? nB : cB + (size_t)(t + 2) * kstep;
            const char* a3 = a2 + kstep; const char* b3 = b2 + kstep;
            PG8_LDB(B0, 0); PG8_SCHED; PG8_LDA(At, 0, 0); PG8_STAGE(PG8_SA(1, 1), a1 + hstepA, voffA);
            PG8_WAIT_V(6); PG8_WAIT_L(0); PG8_BAR; PG8_MMA(0, At, B0); PG8_BAR; PG8_SCHED;
            PG8_LDA(At, 0, 1); PG8_STAGE(PG8_SB(0), b2, voffB); PG8_STAGE(PG8_SA(0, 0), a2, voffA);
            PG8_WAIT_V(6); PG8_WAIT_L(0); PG8_BAR; PG8_MMA(1, At, B0); PG8_BAR; PG8_SCHED;
            PG8_LDB(B0, 1); PG8_SCHED; PG8_LDA(At, 1, 0); PG8_STAGE(PG8_SA(0, 1), a2 + hstepA, voffA);
            PG8_WAIT_V(6); PG8_WAIT_L(0); PG8_BAR; PG8_MMA(0, At, B0); PG8_BAR; PG8_SCHED;
            PG8_LDA(At, 1, 1); PG8_STAGE(PG8_SB(1), b3, voffB); PG8_STAGE(PG8_SA(1, 0), a3, voffA);
            PG8_WAIT_V(6); PG8_WAIT_L(0); PG8_BAR; PG8_MMA(1, At, B0); PG8_BAR; PG8_SCHED;
        }
        if (wr == 0) PG8_BAR;
        E(acc, mg, cur, wr, wc, fr, fq);
        if (!has_next) break;
#pragma unroll
        for (int a = 0; a < 2; ++a)
#pragma unroll
            for (int m = 0; m < 4; ++m)
#pragma unroll
                for (int n = 0; n < 2; ++n) acc[a][m][n] = (f32x4){0.f, 0.f, 0.f, 0.f};
        cur = nxt; cA = nA; cB = nB; ++ui;
        if (wr == 1) PG8_BAR;
    }
    PG8_WAIT_V(0);
    PG8_BAR;
#undef PG8_SA
#undef PG8_SB
#undef PG8_STAGE
#undef PG8_LDA
#undef PG8_LDB
#undef PG8_MMA
#undef PG8_WAIT_V
#undef PG8_WAIT_L
#undef PG8_BAR
#undef PG8_SCHED
}
}
namespace att {
constexpr int KVBLK = 64;
constexpr int SHM_V = 16384, SHM_K = 16384, SHM_KR = 8192;
constexpr int NVB = ATT_HS ? 3 : 2;
constexpr int OFF_V = 0, OFF_K = NVB * SHM_V, OFF_KR = OFF_K + 2 * SHM_K, OFF_WS = OFF_KR + 2 * SHM_KR, OFF_QR = OFF_WS + 8 * 64 * 4, LDS_ATT = OFF_QR + 8 * 4096;
#define RFLU(x) ((unsigned)__builtin_amdgcn_readfirstlane((int)(x)))
#ifndef KSW_MASK
#define KSW_MASK 7
#endif
#define KSWZ(row, colB) ((row) * 256 + ((colB) ^ (((row) & KSW_MASK) << 4)))
#define KRSWZ(row, chunk) ((row) * 128 + ((((chunk) ^ (((row) >> 1) & 7))) << 4))
#define SBAR() __builtin_amdgcn_sched_barrier(0)
__device__ __forceinline__ int crow(int r, int hi) { return (r & 3) + 8 * (r >> 2) + 4 * hi; }
__device__ __forceinline__ unsigned cvtpk(float lo, float hi) { return cvt_pk_bf16(lo, hi); }

__device__ __forceinline__ void partialSM(f32x16& p0, f32x16& p1, float& m_reg, float& mn, float& alpha, const float C, const float thr) {
  float pmax = p0[0];
#pragma unroll
  for (int r = 1; r < 16; ++r) pmax = fmaxf(pmax, p0[r]);
#pragma unroll
  for (int r = 0; r < 16; ++r) pmax = fmaxf(pmax, p1[r]);
  { auto rr = __builtin_amdgcn_permlane32_swap(__float_as_uint(pmax), __float_as_uint(pmax), false, false);
    pmax = fmaxf(__uint_as_float(rr[0]), __uint_as_float(rr[1])); }
  if (__builtin_expect(__all(pmax - m_reg <= thr), 1)) { mn = m_reg; alpha = 1.f; }
  else { mn = fmaxf(m_reg, pmax); alpha = __builtin_amdgcn_exp2f((m_reg - mn) * C); m_reg = mn; }
  const float mnC = -mn * C;
#ifdef PROBE_VALU
  { float dz = mnC; _Pragma("unroll") for (int r = 0; r < PROBE_VALU; ++r) asm volatile("v_fma_f32 %0, %1, %2, %0" : "+v"(dz) : "v"(C), "v"(mn)); asm volatile("" :: "v"(dz)); }
#endif
#pragma unroll
  for (int r = 0; r < 16; ++r) p0[r] = fmaf(p0[r], C, mnC);
#pragma unroll
  for (int r = 0; r < 16; ++r) p1[r] = fmaf(p1[r], C, mnC);
#pragma unroll
  for (int r = 0; r < 16; ++r) p0[r] = __builtin_amdgcn_exp2f(p0[r]);
}
template <bool LPART = false, bool NOSUM = false>
__device__ __forceinline__ void finishSM(f32x16& p0, f32x16& p1, float alpha, float& l_reg, bf16x8& pa0, bf16x8& pa1, bf16x8& pa2, bf16x8& pa3) {
#pragma unroll
  for (int r = 0; r < 16; ++r) p1[r] = __builtin_amdgcn_exp2f(p1[r]);
  if constexpr (!NOSUM) {
  float ps = 0;
#pragma unroll
  for (int r = 0; r < 16; ++r) ps += p0[r];
#pragma unroll
  for (int r = 0; r < 16; ++r) ps += p1[r];
  if constexpr (!LPART) { auto rr = __builtin_amdgcn_permlane32_swap(__float_as_uint(ps), __float_as_uint(ps), false, false);
    ps = __uint_as_float(rr[0]) + __uint_as_float(rr[1]); }
  l_reg = l_reg * alpha + ps; }
#define PK4(P, BASE, OUT) do { unsigned a0 = cvtpk(P[BASE + 0], P[BASE + 1]), a1 = cvtpk(P[BASE + 2], P[BASE + 3]);   \
    unsigned b0 = cvtpk(P[BASE + 4], P[BASE + 5]), b1 = cvtpk(P[BASE + 6], P[BASE + 7]);                              \
    if (ATT_NOSWAP) { v4u w = {a0, a1, b0, b1}; OUT = __builtin_bit_cast(bf16x8, w); } else { \
    auto r0 = __builtin_amdgcn_permlane32_swap(a0, b0, false, false); auto r1 = __builtin_amdgcn_permlane32_swap(a1, b1, false, false); \
    v4u w = {r0[0], r1[0], r0[1], r1[1]}; OUT = __builtin_bit_cast(bf16x8, w); } } while (0)
  PK4(p0, 0, pa0); PK4(p0, 8, pa1); PK4(p1, 0, pa2); PK4(p1, 8, pa3);
#undef PK4
}
template <int NQ, bool ROPEK>
__device__ __forceinline__ void qkt(f32x16& p0, f32x16& p1, const LAS char* Ks, const LAS char* KRs, const LAS char* QRs, const bf16x8 (&qr)[NQ], int r32, int hi, int kd0) {
  p0 = f32x16{}; p1 = f32x16{};
#pragma unroll
  for (int d0 = 0; d0 < NQ; ++d0) { const int cb = ((kd0 + d0) * 16 + hi * 8) * 2;
    const bf16x8 b0 = *(const LAS bf16x8*)(Ks + KSWZ(r32, cb));
    const bf16x8 b1 = *(const LAS bf16x8*)(Ks + KSWZ(32 + r32, cb));
    p0 = __builtin_amdgcn_mfma_f32_32x32x16_bf16(b0, qr[d0], p0, 0, 0, 0);
    p1 = __builtin_amdgcn_mfma_f32_32x32x16_bf16(b1, qr[d0], p1, 0, 0, 0); }
  if constexpr (ROPEK) {
#pragma unroll
    for (int d0 = 0; d0 < 4; ++d0) { const int ch = d0 * 2 + hi;
      const bf16x8 b0 = *(const LAS bf16x8*)(KRs + KRSWZ(r32, ch));
      const bf16x8 b1 = *(const LAS bf16x8*)(KRs + KRSWZ(32 + r32, ch));
      const bf16x8 qq = *(const LAS bf16x8*)(QRs + d0 * 1024);
      p0 = __builtin_amdgcn_mfma_f32_32x32x16_bf16(b0, qq, p0, 0, 0, 0);
      p1 = __builtin_amdgcn_mfma_f32_32x32x16_bf16(b1, qq, p1, 0, 0, 0); }
  }
}
constexpr float THRL = 11.5415603f;
__device__ __forceinline__ void partialSM_nn(f32x16& p0, f32x16& p1, f32x16& negm, float& alpha, const float l_reg, const bool fast = false) {
  alpha = 1.f;
  if (!fast) {
  float pmax = p0[0]; asm volatile("" : "+v"(pmax));
#pragma unroll
  for (int r = 1; r < 16; ++r) pmax = fmaxf(pmax, p0[r]);
#pragma unroll
  for (int r = 0; r < 16; ++r) pmax = fmaxf(pmax, p1[r]);
  { auto rr = __builtin_amdgcn_permlane32_swap(__float_as_uint(pmax), __float_as_uint(pmax), false, false);
    pmax = fmaxf(__uint_as_float(rr[0]), __uint_as_float(rr[1])); }
  if (__builtin_expect(!__all(pmax <= THRL && pmax >= -64.f), 0)) {
    float lc = l_reg;
    if (ATT_LPART) { auto rr = __builtin_amdgcn_permlane32_swap(__float_as_uint(lc), __float_as_uint(lc), false, false); lc = __uint_as_float(rr[0]) + __uint_as_float(rr[1]); }
    const float dl = (pmax > THRL) ? pmax : ((lc == 0.f && pmax < -64.f && pmax > -1e30f) ? pmax : 0.f);
#pragma unroll
    for (int r = 0; r < 16; ++r) { p0[r] -= dl; p1[r] -= dl; }
#pragma unroll
    for (int r = 0; r < 16; ++r) negm[r] -= dl;
    alpha = (dl > 0.f) ? __builtin_amdgcn_exp2f(-dl) : 1.f;
  }
  }
#pragma unroll
  for (int r = 0; r < 16; ++r) p0[r] = __builtin_amdgcn_exp2f(p0[r]);
}
__device__ __forceinline__ void partialSM_n(f32x16& p0, f32x16& p1, float& mref, f32x16& negm, float& alpha, const float l_reg, const bool fast = false) {
  partialSM_nn(p0, p1, negm, alpha, l_reg, fast); mref = -negm[0];
}
template <int NQ, bool ROPEK, bool ZC = false>
__device__ __forceinline__ void qkt_n(f32x16& p0, f32x16& p1, const f32x16& negm, const LAS char* Ks, const LAS char* KRs, const LAS char* QRs, const bf16x8 (&qr)[NQ], int r32, int hi, int kd0) {
#pragma unroll
  for (int d0 = 0; d0 < NQ; ++d0) { const int cb = ((kd0 + d0) * 16 + hi * 8) * 2;
    const bf16x8 b0 = *(const LAS bf16x8*)(Ks + KSWZ(r32, cb));
    const bf16x8 b1 = *(const LAS bf16x8*)(Ks + KSWZ(32 + r32, cb));
    if (d0 == 0 && ZC) { p0 = __builtin_amdgcn_mfma_f32_32x32x16_bf16(b0, qr[0], f32x16{}, 0, 0, 0); p1 = __builtin_amdgcn_mfma_f32_32x32x16_bf16(b1, qr[0], f32x16{}, 0, 0, 0); }
    else if (d0 == 0) { p0 = __builtin_amdgcn_mfma_f32_32x32x16_bf16(b0, qr[0], negm, 0, 0, 0); p1 = __builtin_amdgcn_mfma_f32_32x32x16_bf16(b1, qr[0], negm, 0, 0, 0); }
    else { p0 = __builtin_amdgcn_mfma_f32_32x32x16_bf16(b0, qr[d0], p0, 0, 0, 0); p1 = __builtin_amdgcn_mfma_f32_32x32x16_bf16(b1, qr[d0], p1, 0, 0, 0); } }
  if constexpr (ROPEK) {
#pragma unroll
    for (int d0 = 0; d0 < 4; ++d0) { const int ch = d0 * 2 + hi;
      const bf16x8 b0 = *(const LAS bf16x8*)(KRs + KRSWZ(r32, ch));
      const bf16x8 b1 = *(const LAS bf16x8*)(KRs + KRSWZ(32 + r32, ch));
      const bf16x8 qq = *(const LAS bf16x8*)(QRs + d0 * 1024);
      p0 = __builtin_amdgcn_mfma_f32_32x32x16_bf16(b0, qq, p0, 0, 0, 0);
      p1 = __builtin_amdgcn_mfma_f32_32x32x16_bf16(b1, qq, p1, 0, 0, 0); }
  }
}
template <int BASE> __device__ __forceinline__ bf16x8 pk4f(const f32x16& P) {
  const unsigned a0 = cvtpk(P[BASE + 0], P[BASE + 1]), a1 = cvtpk(P[BASE + 2], P[BASE + 3]), b0 = cvtpk(P[BASE + 4], P[BASE + 5]), b1 = cvtpk(P[BASE + 6], P[BASE + 7]);
  if (ATT_NOSWAP) { const v4u w = {a0, a1, b0, b1}; return __builtin_bit_cast(bf16x8, w); }
  auto r0 = __builtin_amdgcn_permlane32_swap(a0, b0, false, false); auto r1 = __builtin_amdgcn_permlane32_swap(a1, b1, false, false);
  const v4u w = {r0[0], r1[0], r0[1], r1[1]}; return __builtin_bit_cast(bf16x8, w); }
template <int NQ, bool ROPEK, bool NOSUM = false>
__device__ __forceinline__ void qkt_fin(f32x16& n0, f32x16& n1, const LAS char* Ks, const LAS char* KRs, const LAS char* QRs, const bf16x8 (&qr)[NQ], int r32, int hi, int kd0,
                                        f32x16& p0, f32x16& p1, float& l_reg, bf16x8& pa0, bf16x8& pa1, bf16x8& pa2, bf16x8& pa3) {
  constexpr int NS = NQ + (ROPEK ? 4 : 0), CPS = (NQ >= 8) ? 1 : 8 / NQ;
  bf16x8 b0, b1, c0, c1, qq = qr[0], qn = qr[0];
  { const int cb = (kd0 * 16 + hi * 8) * 2; b0 = *(const LAS bf16x8*)(Ks + KSWZ(r32, cb)); b1 = *(const LAS bf16x8*)(Ks + KSWZ(32 + r32, cb)); }
  float ps = 0.f;
#pragma unroll
  for (int s_ = 0; s_ < NS; ++s_) {
    if (s_ + 1 < NS) {
      if (s_ + 1 < NQ) { const int cb = ((kd0 + s_ + 1) * 16 + hi * 8) * 2; c0 = *(const LAS bf16x8*)(Ks + KSWZ(r32, cb)); c1 = *(const LAS bf16x8*)(Ks + KSWZ(32 + r32, cb)); qn = qr[(s_ + 1 < NQ) ? s_ + 1 : 0]; }
      else { const int d0 = s_ + 1 - NQ, ch = d0 * 2 + hi; c0 = *(const LAS bf16x8*)(KRs + KRSWZ(r32, ch)); c1 = *(const LAS bf16x8*)(KRs + KRSWZ(32 + r32, ch)); qn = *(const LAS bf16x8*)(QRs + d0 * 1024); }
    }
    if (s_ == 0) { n0 = __builtin_amdgcn_mfma_f32_32x32x16_bf16(b0, qq, f32x16{}, 0, 0, 0); n1 = __builtin_amdgcn_mfma_f32_32x32x16_bf16(b1, qq, f32x16{}, 0, 0, 0); }
    else { n0 = __builtin_amdgcn_mfma_f32_32x32x16_bf16(b0, qq, n0, 0, 0, 0); n1 = __builtin_amdgcn_mfma_f32_32x32x16_bf16(b1, qq, n1, 0, 0, 0); }
#pragma unroll
    for (int c_ = 0; c_ < CPS; ++c_) { const int i = s_ * CPS + c_;
      if (i < 8) { p1[2 * i] = __builtin_amdgcn_exp2f(p1[2 * i]); p1[2 * i + 1] = __builtin_amdgcn_exp2f(p1[2 * i + 1]);
        if constexpr (!NOSUM) { ps += p0[2 * i]; ps += p0[2 * i + 1];
          if (i >= 1) { ps += p1[2 * i - 2]; ps += p1[2 * i - 1]; } }
        if (i == 1) pa0 = pk4f<0>(p0);
        if (i == 3) pa1 = pk4f<8>(p0);
        if (i == 5) pa2 = pk4f<0>(p1); } }
    __builtin_amdgcn_sched_barrier(0);
    b0 = c0; b1 = c1; qq = qn;
  }
  pa3 = pk4f<8>(p1);
  if constexpr (!NOSUM) { ps += p1[14]; ps += p1[15];
    { auto rr = __builtin_amdgcn_permlane32_swap(__float_as_uint(ps), __float_as_uint(ps), false, false); ps = __uint_as_float(rr[0]) + __uint_as_float(rr[1]); }
    l_reg += ps; }
}
__device__ __forceinline__ void band_mask(f32x16& p0, f32x16& p1, int kb, int qpos, int hi) {
  const float NEG = -INFINITY;
#pragma unroll
  for (int r = 0; r < 16; ++r) { const int d = kb + crow(r, hi) - qpos; if (d > 128 || d < -128) p0[r] = NEG; if (d + 32 > 128 || d + 32 < -128) p1[r] = NEG; }
}
__device__ __forceinline__ int v_st(int k, int c) { const int kk = (k & ~0xC) | ((k & 4) << 1) | ((k & 8) >> 1); return ((kk >> 3) * 4 + (c >> 5)) * 512 + ((kk & 7) * 32 + (c & 31)) * 2; }
__device__ __forceinline__ int v_rd_base(int lane) { return ((lane & 3) << 3) | (((lane >> 2) & 3) << 6) | (((lane >> 4) & 1) << 5) | (((lane >> 5) & 1) << 8); }
constexpr int v_rd_off(int d0, int ks, int half) { return d0 * 512 + ks * 4096 + half * 2048; }
template <int OFF> __device__ __forceinline__ s16x4 tr_read(int vb) {
  s16x4 r; asm volatile("ds_read_b64_tr_b16 %0, %1 offset:%2" : "=&v"(r) : "v"(vb), "i"(OFF) : "memory"); return r;
}
template <int D0, int BO = 0> __device__ __forceinline__ void pv_one(f32x16& od, int vb, bf16x8 pa0, bf16x8 pa1, bf16x8 pa2, bf16x8 pa3) {
  const s16x4 l0 = tr_read<BO + v_rd_off(D0, 0, 0)>(vb), h0 = tr_read<BO + v_rd_off(D0, 0, 1)>(vb), l1 = tr_read<BO + v_rd_off(D0, 1, 0)>(vb), h1 = tr_read<BO + v_rd_off(D0, 1, 1)>(vb);
  const s16x4 l2 = tr_read<BO + v_rd_off(D0, 2, 0)>(vb), h2 = tr_read<BO + v_rd_off(D0, 2, 1)>(vb), l3 = tr_read<BO + v_rd_off(D0, 3, 0)>(vb), h3 = tr_read<BO + v_rd_off(D0, 3, 1)>(vb);
  asm volatile("s_waitcnt lgkmcnt(0)" ::: "memory"); SBAR();
#define PK(L, H) (bf16x8){L[0], L[1], L[2], L[3], H[0], H[1], H[2], H[3]}
#ifdef ATT_PRIO
  __builtin_amdgcn_s_setprio(1);
#endif
  od = __builtin_amdgcn_mfma_f32_32x32x16_bf16(pa0, PK(l0, h0), od, 0, 0, 0);
  od = __builtin_amdgcn_mfma_f32_32x32x16_bf16(pa1, PK(l1, h1), od, 0, 0, 0);
  od = __builtin_amdgcn_mfma_f32_32x32x16_bf16(pa2, PK(l2, h2), od, 0, 0, 0);
  od = __builtin_amdgcn_mfma_f32_32x32x16_bf16(pa3, PK(l3, h3), od, 0, 0, 0);
#ifdef ATT_PRIO
  __builtin_amdgcn_s_setprio(0);
#endif
#undef PK
}
template <int BO = 0>
__device__ __forceinline__ void pv_d0(f32x16 (&o)[4], int vb, bf16x8 pa0, bf16x8 pa1, bf16x8 pa2, bf16x8 pa3) {
  pv_one<0, BO>(o[0], vb, pa0, pa1, pa2, pa3); pv_one<1, BO>(o[1], vb, pa0, pa1, pa2, pa3); pv_one<2, BO>(o[2], vb, pa0, pa1, pa2, pa3); pv_one<3, BO>(o[3], vb, pa0, pa1, pa2, pa3);
}
__device__ __forceinline__ bf16x8 ones8() { const v4u w = {0x3F803F80u, 0x3F803F80u, 0x3F803F80u, 0x3F803F80u}; return __builtin_bit_cast(bf16x8, w); }
template <int BO, bool LM = false>
__device__ __forceinline__ void pv_d0_exp(f32x16 (&o)[4], int vb, bf16x8 pa0, bf16x8 pa1, bf16x8 pa2, bf16x8 pa3, f32x16& pn, f32x16& L) {
  pv_one<0, BO>(o[0], vb, pa0, pa1, pa2, pa3);
  if constexpr (LM) L = __builtin_amdgcn_mfma_f32_32x32x16_bf16(pa0, ones8(), L, 0, 0, 0);
#pragma unroll
  for (int r = 0; r < 4; ++r) pn[r] = __builtin_amdgcn_exp2f(pn[r]);
  pv_one<1, BO>(o[1], vb, pa0, pa1, pa2, pa3);
  if constexpr (LM) L = __builtin_amdgcn_mfma_f32_32x32x16_bf16(pa1, ones8(), L, 0, 0, 0);
#pragma unroll
  for (int r = 4; r < 8; ++r) pn[r] = __builtin_amdgcn_exp2f(pn[r]);
  pv_one<2, BO>(o[2], vb, pa0, pa1, pa2, pa3);
  if constexpr (LM) L = __builtin_amdgcn_mfma_f32_32x32x16_bf16(pa2, ones8(), L, 0, 0, 0);
#pragma unroll
  for (int r = 8; r < 12; ++r) pn[r] = __builtin_amdgcn_exp2f(pn[r]);
  pv_one<3, BO>(o[3], vb, pa0, pa1, pa2, pa3);
  if constexpr (LM) L = __builtin_amdgcn_mfma_f32_32x32x16_bf16(pa3, ones8(), L, 0, 0, 0);
#pragma unroll
  for (int r = 12; r < 16; ++r) pn[r] = __builtin_amdgcn_exp2f(pn[r]);
}
template <int BO>
__device__ __forceinline__ void pv_d0_L(f32x16 (&o)[4], int vb, bf16x8 pa0, bf16x8 pa1, bf16x8 pa2, bf16x8 pa3, f32x16& L) {
  pv_one<0, BO>(o[0], vb, pa0, pa1, pa2, pa3); L = __builtin_amdgcn_mfma_f32_32x32x16_bf16(pa0, ones8(), L, 0, 0, 0);
  pv_one<1, BO>(o[1], vb, pa0, pa1, pa2, pa3); L = __builtin_amdgcn_mfma_f32_32x32x16_bf16(pa1, ones8(), L, 0, 0, 0);
  pv_one<2, BO>(o[2], vb, pa0, pa1, pa2, pa3); L = __builtin_amdgcn_mfma_f32_32x32x16_bf16(pa2, ones8(), L, 0, 0, 0);
  pv_one<3, BO>(o[3], vb, pa0, pa1, pa2, pa3); L = __builtin_amdgcn_mfma_f32_32x32x16_bf16(pa3, ones8(), L, 0, 0, 0);
}
__device__ __forceinline__ bf16x8 ld8(const bf16* p) { return *reinterpret_cast<const bf16x8*>(p); }

template <int D0> __device__ __forceinline__ void trd8(s16x4 (&v)[8], int vb) {
  v[0] = tr_read<v_rd_off(D0, 0, 0)>(vb); v[1] = tr_read<v_rd_off(D0, 0, 1)>(vb); v[2] = tr_read<v_rd_off(D0, 1, 0)>(vb); v[3] = tr_read<v_rd_off(D0, 1, 1)>(vb);
  v[4] = tr_read<v_rd_off(D0, 2, 0)>(vb); v[5] = tr_read<v_rd_off(D0, 2, 1)>(vb); v[6] = tr_read<v_rd_off(D0, 3, 0)>(vb); v[7] = tr_read<v_rd_off(D0, 3, 1)>(vb);
}
__device__ __forceinline__ void pv4(f32x16& od, const s16x4 (&v)[8], bf16x8 pa0, bf16x8 pa1, bf16x8 pa2, bf16x8 pa3) {
#define PK(L, H) (bf16x8){L[0], L[1], L[2], L[3], H[0], H[1], H[2], H[3]}
  od = __builtin_amdgcn_mfma_f32_32x32x16_bf16(pa0, PK(v[0], v[1]), od, 0, 0, 0);
  od = __builtin_amdgcn_mfma_f32_32x32x16_bf16(pa1, PK(v[2], v[3]), od, 0, 0, 0);
  od = __builtin_amdgcn_mfma_f32_32x32x16_bf16(pa2, PK(v[4], v[5]), od, 0, 0, 0);
  od = __builtin_amdgcn_mfma_f32_32x32x16_bf16(pa3, PK(v[6], v[7]), od, 0, 0, 0);
#undef PK
}
#define LGKM_WAIT(N) do { asm volatile("s_waitcnt lgkmcnt(" #N ")" ::: "memory"); SBAR(); } while (0)
__device__ __forceinline__ void pv_pipe(f32x16 (&o)[4], int vbk, bf16x8 pa0, bf16x8 pa1, bf16x8 pa2, bf16x8 pa3) {
  s16x4 va[8], vc[8];
  SBAR(); asm volatile("s_waitcnt lgkmcnt(0)" ::: "memory");
  trd8<0>(va, vbk);
  trd8<1>(vc, vbk); LGKM_WAIT(8); pv4(o[0], va, pa0, pa1, pa2, pa3); SBAR();
  trd8<2>(va, vbk); LGKM_WAIT(8); pv4(o[1], vc, pa0, pa1, pa2, pa3); SBAR();
  trd8<3>(vc, vbk); LGKM_WAIT(8); pv4(o[2], va, pa0, pa1, pa2, pa3); SBAR();
  LGKM_WAIT(0); pv4(o[3], vc, pa0, pa1, pa2, pa3); SBAR();
}
#ifdef ATT_PVPIPE
#define PV_D0 pv_pipe
#else
#define PV_D0 pv_d0<0>
#endif
__device__ __forceinline__ void glds16(const void* gsrc, unsigned lds_dst) { unsigned keep;
  asm volatile("s_mov_b32 %0, m0\n\ts_mov_b32 m0, %2\n\ts_nop 0\n\tglobal_load_lds_dwordx4 %1, off\n\ts_mov_b32 m0, %0" : "=&s"(keep) : "v"(gsrc), "s"(lds_dst) : "memory"); }
__device__ __forceinline__ void glds16x2(const void* sbase, unsigned off0, unsigned off1, unsigned lds_dst0, unsigned lds_dst1) { unsigned keep;
  asm volatile("s_nop 4\n\ts_mov_b32 %0, m0\n\ts_mov_b32 m0, %3\n\ts_nop 0\n\tglobal_load_lds_dwordx4 %1, %5\n\ts_mov_b32 m0, %4\n\ts_nop 0\n\tglobal_load_lds_dwordx4 %2, %5\n\ts_mov_b32 m0, %0"
               : "=&s"(keep) : "v"(off0), "v"(off1), "s"(lds_dst0), "s"(lds_dst1), "s"(sbase) : "memory"); }
template <int IMM>
__device__ __forceinline__ void glds16x2i(const void* sbase, unsigned off0, unsigned lds_dst0, unsigned lds_dst1) { unsigned keep;
  asm volatile("s_nop 4\n\ts_mov_b32 %0, m0\n\ts_mov_b32 m0, %2\n\ts_nop 0\n\tglobal_load_lds_dwordx4 %1, %4\n\ts_mov_b32 m0, %3\n\ts_nop 0\n\tglobal_load_lds_dwordx4 %1, %4 offset:%5\n\ts_mov_b32 m0, %0"
               : "=&s"(keep) : "v"(off0), "s"(lds_dst0), "s"(lds_dst1 - (unsigned)IMM), "s"(sbase), "i"(IMM) : "memory"); }
__device__ __forceinline__ void glds16s(const void* sbase, unsigned off0, unsigned lds_dst0) { unsigned keep;
  asm volatile("s_nop 4\n\ts_mov_b32 %0, m0\n\ts_mov_b32 m0, %2\n\ts_nop 0\n\tglobal_load_lds_dwordx4 %1, %3\n\ts_mov_b32 m0, %0" : "=&s"(keep) : "v"(off0), "s"(lds_dst0), "s"(sbase) : "memory"); }
__device__ __forceinline__ const char* uptr_(const char* p) { const unsigned long long v = (unsigned long long)p; const unsigned lo = (unsigned)__builtin_amdgcn_readfirstlane((int)(unsigned)v), hi = (unsigned)__builtin_amdgcn_readfirstlane((int)(unsigned)(v >> 32)); return (const char*)(((unsigned long long)hi << 32) | lo); }
#define WAIT_BAR() asm volatile("s_waitcnt vmcnt(0) lgkmcnt(0)\n\ts_barrier" ::: "memory")

template <int NQ, bool ROPEK, bool SWA>
__device__ __forceinline__ void attn_core(LAS char* lds, const bf16x8 (&qr)[NQ],
                                          const bf16* __restrict__ Kh, const bf16* __restrict__ Vh, const int ldk, const bf16* __restrict__ KRh, const int ldkr,
                                          const int NT, const float C, const float thr, const int kd0, const int qpos, const int kpos0,
                                          f32x16 (&o)[4], float& m_reg, float& l_reg, const int wv, const float kmax2 = -1.f, const float qx2 = 0.f) {
  const int tid = opq_tid(wv), lane = tid & 63, r32 = lane & 31, hi = lane >> 5;
  const int wid = __builtin_amdgcn_readfirstlane(tid >> 6);
  LAS char* V_lds = lds + OFF_V; LAS char* K_lds = lds + OFF_K; LAS char* KR_lds = lds + OFF_KR;
  LAS float* al_l = (LAS float*)(lds + OFF_WS) + wid * 64 + 32;
  const LAS char* QR_lds = lds + OFF_QR + wid * 4096 + lane * 16;
  const unsigned lds0 = (unsigned)(uintptr_t)lds;
  const int vb0 = (int)lds0 + OFF_V + v_rd_base(lane);
  unsigned kofs[2], vofs[2], krofs = 0u;
#pragma unroll
  for (int i = 0; i < 2; ++i) { const int p = wid * 2 + i;
    { const int row = p * 4 + (lane >> 4), ch = (lane & 15) ^ (row & KSW_MASK); kofs[i] = (unsigned)(row * ldk + ch * 8) * 2u; }
    { const int sub = 2 * p + (lane >> 5), kk = (sub >> 2) * 8 + ((lane & 31) >> 2), k = ATT_NOSWAP ? kk : ((kk & ~0xC) | ((kk & 4) << 1) | ((kk & 8) >> 1)), c = (sub & 3) * 32 + (lane & 3) * 8;
      vofs[i] = (unsigned)(k * ldk + c) * 2u; } }
  if constexpr (ROPEK) { const int row = wid * 8 + (lane >> 3), ch = (lane & 7) ^ ((row >> 1) & 7); krofs = (unsigned)(row * ldkr + ch * 8) * 2u; }
  const size_t tstepK = (size_t)KVBLK * ldk * 2, tstepKR = (size_t)KVBLK * ldkr * 2;
  const unsigned ldsK = RFLU(lds0 + OFF_K + (wid * 2) * 1024), ldsV = RFLU(lds0 + OFF_V + (wid * 2) * 1024), ldsKR = RFLU(lds0 + OFF_KR + wid * 1024);
#define RFL(x) ((unsigned)__builtin_amdgcn_readfirstlane((int)(x)))
#define DMA_K(t, b) do { const char* g_ = (const char*)Kh + (size_t)(t) * tstepK; \
    glds16x2(g_, kofs[0], kofs[1], ldsK + (b) * SHM_K, ldsK + (b) * SHM_K + 1024); \
    if constexpr (ROPEK) glds16s((const char*)KRh + (size_t)(t) * tstepKR, krofs, ldsKR + (b) * SHM_KR); } while (0)
#define DMA_V(t, b) do { const char* g_ = (const char*)Vh + (size_t)(t) * tstepK; \
    glds16x2i<128>(g_, vofs[0], ldsV + (b) * SHM_V, ldsV + (b) * SHM_V + 1024); } while (0)
#define RESC(a) do { if (__any((a) < 1.f)) { const int l_ = lane_id(), h_ = l_ >> 5; LAS float* alp = (LAS float*)(lds + OFF_WS) + wid * 64 + 32;     \
    if (h_ == 0) alp[l_ & 31] = (a); asm volatile("s_waitcnt lgkmcnt(0)" ::: "memory"); \
    _Pragma("unroll") for (int d = 0; d < 4; ++d) _Pragma("unroll") for (int r = 0; r < 16; ++r) o[d][r] *= alp[crow(r, h_)]; } } while (0)
#if ATT_NEGM
  f32x16 negm; _Pragma("unroll") for (int r = 0; r < 16; ++r) negm[r] = -m_reg;
#define QKT(P0, P1, b, tile) do { qkt_n<NQ, ROPEK>(P0, P1, negm, K_lds + (b) * SHM_K, KR_lds + (b) * SHM_KR, QR_lds, qr, r32, hi, kd0); \
    if constexpr (SWA) band_mask(P0, P1, kpos0 + (tile) * KVBLK, qpos, hi); } while (0)
#define PSM(P0, P1, MN, AL) partialSM_nn(P0, P1, negm, AL, l_reg, fast)
#else
#define QKT(P0, P1, b, tile) do { qkt<NQ, ROPEK>(P0, P1, K_lds + (b) * SHM_K, KR_lds + (b) * SHM_KR, QR_lds, qr, r32, hi, kd0); \
    if constexpr (SWA) band_mask(P0, P1, kpos0 + (tile) * KVBLK, qpos, hi); } while (0)
#define PSM(P0, P1, MN, AL) partialSM(P0, P1, m_reg, MN, AL, C, thr)
#endif
  f32x16 pA0, pA1, pB0, pB1; float mnA, mnB, alA, alB; bf16x8 pa0, pa1, pa2, pa3;
  DMA_K(0, 0); DMA_V(0, 0); DMA_K(1, 1);
  WAIT_BAR();
  bool fast = false;
  constexpr bool LMF = ATT_LMFMA && !SWA && (LMSEL) && (QKFSEL) && ATT_QKFIN && ATT_ILV;
  f32x16 Lacc = {};
#if ATT_NEGM && ATT_FASTREF
  if (!SWA && kmax2 >= 0.f) {
    float qn2 = qx2;
#pragma unroll
    for (int d0 = 0; d0 < NQ; ++d0) { f32x4 a, b; pg8::unpack8(__builtin_bit_cast(v4u, qr[d0]), a, b); qn2 += (a[0] * a[0] + a[1] * a[1]) + (a[2] * a[2] + a[3] * a[3]) + (b[0] * b[0] + b[1] * b[1]) + (b[2] * b[2] + b[3] * b[3]); }
    { auto rr = __builtin_amdgcn_permlane32_swap(__float_as_uint(qn2), __float_as_uint(qn2), false, false); qn2 = __uint_as_float(rr[0]) + __uint_as_float(rr[1]); }
    const float bnd = sqrtf(qn2 * kmax2) * 1.02f + 0.25f;
    fast = __all(bnd - m_reg <= 60.f && bnd + m_reg <= 100.f && (!(DUPSEL) || m_reg == 0.f)) != 0;
  }
#endif
#if ATT_NEGM && ATT_FASTREF && ATT_FASTDUP
  if constexpr (!SWA && (DUPSEL)) {
    if (fast) { qkt_n<NQ, ROPEK, true>(pA0, pA1, pA0, K_lds, KR_lds, QR_lds, qr, r32, hi, kd0); _Pragma("unroll") for (int r_ = 0; r_ < 16; ++r_) pA0[r_] = __builtin_amdgcn_exp2f(pA0[r_]); alA = 1.f; }
    else { QKT(pA0, pA1, 0, 0); PSM(pA0, pA1, mnA, alA); }
  } else { QKT(pA0, pA1, 0, 0); PSM(pA0, pA1, mnA, alA); }
#else
  QKT(pA0, pA1, 0, 0); PSM(pA0, pA1, mnA, alA);
#endif
  WAIT_BAR();
  if (2 < NT) DMA_K(2, 0);
  DMA_V(1, 1);
#if ATT_NEGM
#define PSMF(FAST, P0, P1, AL) partialSM_nn(P0, P1, negm, AL, l_reg, FAST)
#else
#define PSMF(FAST, P0, P1, AL) PSM(P0, P1, mnA, AL)
#endif
#define RESCF(FAST, a) do { if (!(FAST)) RESC(a); } while (0)
#define PVPSM(ILV, BO, PN0, PN1, AL, FAST) do { if constexpr ((ILV) && ATT_ILV) { pv_d0_exp<BO, LMF>(o, vb0, pa0, pa1, pa2, pa3, PN0, Lacc); AL = 1.f; } \
    else if constexpr (ILV) { pv_d0<BO>(o, vb0, pa0, pa1, pa2, pa3); _Pragma("unroll") for (int r_ = 0; r_ < 16; ++r_) PN0[r_] = __builtin_amdgcn_exp2f(PN0[r_]); AL = 1.f; } \
    else { pv_d0<BO>(o, vb0, pa0, pa1, pa2, pa3); PSMF(FAST, PN0, PN1, AL); } } while (0)
#define QKFIN(ILV, FAST, N0, N1, b, tile, P0, P1, AL) do { if constexpr ((ILV) && ATT_QKFIN && !SWA && (QKFSEL)) { \
      qkt_fin<NQ, ROPEK, LMF>(N0, N1, K_lds + (b) * SHM_K, KR_lds + (b) * SHM_KR, QR_lds, qr, r32, hi, kd0, P0, P1, l_reg, pa0, pa1, pa2, pa3); } \
    else { if constexpr (ILV) { qkt_n<NQ, ROPEK, true>(N0, N1, pA0, K_lds + (b) * SHM_K, KR_lds + (b) * SHM_KR, QR_lds, qr, r32, hi, kd0); } else { QKT(N0, N1, b, tile); } \
      finishSM<ATT_LPART != 0>(P0, P1, (FAST) ? 1.f : AL, l_reg, pa0, pa1, pa2, pa3); } } while (0)
#define TILE_LOOP(FAST, ILV) do { \
  for (int j = 1; j + 1 < NT; j += 2) { \
      \
    SBAR(); QKFIN(ILV, FAST, pB0, pB1, 1, j, pA0, pA1, alA); SBAR(); \
    PVPSM(ILV, 0, pB0, pB1, alB, FAST); \
    WAIT_BAR(); \
    if (j + 2 < NT) DMA_K(j + 2, 1); \
    DMA_V(j + 1, 0);                                                \
    RESCF(FAST, alB); \
      \
    SBAR(); QKFIN(ILV, FAST, pA0, pA1, 0, j + 1, pB0, pB1, alB); SBAR(); \
    PVPSM(ILV, SHM_V, pA0, pA1, alA, FAST); \
    WAIT_BAR(); \
    if (j + 3 < NT) DMA_K(j + 3, 0); \
    if (j + 2 < NT) DMA_V(j + 2, 1); \
    RESCF(FAST, alA); \
  } \
    \
  SBAR(); QKFIN(ILV, FAST, pB0, pB1, 1, NT - 1, pA0, pA1, alA); SBAR(); \
  PVPSM(ILV, 0, pB0, pB1, alB, FAST); \
  WAIT_BAR(); RESCF(FAST, alB); \
  if constexpr ((ILV) && LMF) { finishSM<false, true>(pB0, pB1, 1.f, l_reg, pa0, pa1, pa2, pa3); SBAR(); pv_d0_L<SHM_V>(o, vb0, pa0, pa1, pa2, pa3, Lacc); } \
  else { finishSM<ATT_LPART != 0>(pB0, pB1, (FAST) ? 1.f : alB, l_reg, pa0, pa1, pa2, pa3); SBAR(); \
  pv_d0<SHM_V>(o, vb0, pa0, pa1, pa2, pa3); } } while (0)
#if ATT_NEGM && ATT_FASTREF && ATT_FASTDUP
  if constexpr (!SWA && (DUPSEL)) {
    if (fast) { TILE_LOOP(true, true);
      if constexpr (LMF) {
        LAS float* ll = (LAS float*)(lds + OFF_WS) + wid * 64 + 32;
        if (r32 == 0) { _Pragma("unroll") for (int r = 0; r < 16; ++r) ll[crow(r, hi)] = Lacc[r]; }
        asm volatile("s_waitcnt lgkmcnt(0)" ::: "memory");
        l_reg = ll[r32]; asm volatile("s_waitcnt lgkmcnt(0)" ::: "memory"); } }
    else { TILE_LOOP(false, false); m_reg = -negm[0]; } }
#ifdef PROBE_MLA_FASTONLY
  else { if constexpr (ROPEK) { TILE_LOOP(true, false); } else { TILE_LOOP(fast, false); } m_reg = -negm[0]; }
#else
  else { TILE_LOOP(fast, false); m_reg = -negm[0]; }
#endif
#else
  TILE_LOOP(fast, false); if (ATT_NEGM) m_reg = -negm[0];
#endif
#undef TILE_LOOP
#undef PVPSM
#undef QKFIN
#undef PSMF
#undef RESCF
  if (ATT_LPART) { auto rr = __builtin_amdgcn_permlane32_swap(__float_as_uint(l_reg), __float_as_uint(l_reg), false, false); l_reg = __uint_as_float(rr[0]) + __uint_as_float(rr[1]); }
#undef RFL
#undef DMA_K
#undef DMA_V
#undef RESC
#undef QKT
#undef PSM
}

template <int NQ, bool ROPEK, bool SWA>
__device__ __forceinline__ void attn_core_stag(LAS char* lds, const bf16x8 (&qr)[NQ],
                                               const bf16* __restrict__ Kh, const bf16* __restrict__ Vh, const int ldk, const bf16* __restrict__ KRh, const int ldkr,
                                               const int NT, const float C, const float thr, const int kd0, const int qpos, const int kpos0,
                                               f32x16 (&o)[4], float& m_reg, float& l_reg, const int wv, unsigned* stamp = nullptr) {
  const int tid = opq_tid(wv), lane = tid & 63, r32 = lane & 31, hi = lane >> 5;
  const int wid = __builtin_amdgcn_readfirstlane(tid >> 6);
  const int half = wid >> 2;
#ifdef PROBE_STAMP
  unsigned long long tM = 0, tMb = 0, tV = 0, tVb = 0, t0_, t1_;
#define STAMP0() (t0_ = __builtin_amdgcn_s_memtime())
#define STAMP1(acc) do { t1_ = __builtin_amdgcn_s_memtime(); acc += t1_ - t0_; t0_ = t1_; } while (0)
#else
#define STAMP0() do {} while (0)
#define STAMP1(acc) do {} while (0)
#endif
  LAS char* K_lds = lds + OFF_K; LAS char* KR_lds = lds + OFF_KR;
  LAS float* al_l = (LAS float*)(lds + OFF_WS) + wid * 64 + 32;
  const LAS char* QR_lds = lds + OFF_QR + wid * 4096 + lane * 16;
  const unsigned lds0 = (unsigned)(uintptr_t)lds;
  const int vb0 = (int)lds0 + OFF_V + v_rd_base(lane);
  unsigned kofs[2], vofs[2], krofs = 0u;
#pragma unroll
  for (int i = 0; i < 2; ++i) { const int p = wid * 2 + i;
    { const int row = p * 4 + (lane >> 4), ch = (lane & 15) ^ (row & KSW_MASK); kofs[i] = (unsigned)(row * ldk + ch * 8) * 2u; }
    { const int sub = 2 * p + (lane >> 5), kk = (sub >> 2) * 8 + ((lane & 31) >> 2), k = ATT_NOSWAP ? kk : ((kk & ~0xC) | ((kk & 4) << 1) | ((kk & 8) >> 1)), c = (sub & 3) * 32 + (lane & 3) * 8;
      vofs[i] = (unsigned)(k * ldk + c) * 2u; } }
  if constexpr (ROPEK) { const int row = wid * 8 + (lane >> 3), ch = (lane & 7) ^ ((row >> 1) & 7); krofs = (unsigned)(row * ldkr + ch * 8) * 2u; }
  const size_t tstepK = (size_t)KVBLK * ldk * 2, tstepKR = (size_t)KVBLK * ldkr * 2;
  const unsigned ldsK = RFLU(lds0 + OFF_K + (wid * 2) * 1024), ldsV = RFLU(lds0 + OFF_V + (wid * 2) * 1024), ldsKR = RFLU(lds0 + OFF_KR + wid * 1024);
#define RFL(x) ((unsigned)__builtin_amdgcn_readfirstlane((int)(x)))
#define DMA_K(t, b) do { const char* g_ = (const char*)Kh + (size_t)(t) * tstepK; \
    glds16x2(g_, kofs[0], kofs[1], ldsK + (b) * SHM_K, ldsK + (b) * SHM_K + 1024); \
    if constexpr (ROPEK) glds16s((const char*)KRh + (size_t)(t) * tstepKR, krofs, ldsKR + (b) * SHM_KR); } while (0)
#define DMA_V(t, b) do { const char* g_ = (const char*)Vh + (size_t)(t) * tstepK; \
    glds16x2(g_, vofs[0], vofs[1], ldsV + (b) * SHM_V, ldsV + (b) * SHM_V + 1024); } while (0)
#define DMA_EVEN(j) do { if ((j) + 1 < NT) DMA_K((j) + 1, ((j) + 1) & 1); if ((j) < NT) DMA_V((j), (j) & 1); } while (0)
#define SEG_BAR() do { SBAR(); asm volatile("s_waitcnt lgkmcnt(0)\n\ts_barrier" ::: "memory"); SBAR(); } while (0)
#define SEG_WBAR() do { SBAR(); asm volatile("s_waitcnt vmcnt(0) lgkmcnt(0)\n\ts_barrier" ::: "memory"); SBAR(); } while (0)
  f32x16 s0, s1; float mn, al; bf16x8 pa0, pa1, pa2, pa3;
  DMA_K(0, 0); DMA_V(0, 0); if (1 < NT) DMA_K(1, 1);
  SEG_WBAR();
  if (half == 1) SEG_BAR();
  for (int k = 0; k < NT; ++k) {
    STAMP0();
    if (half == 0 && k >= 1) DMA_EVEN(k);
    { const int vbk = vb0 + ((k - 1) & 1) * SHM_V; s16x4 va[8], vc[8];
      if (k >= 1) trd8<0>(va, vbk);
      SBAR(); qkt<NQ, ROPEK>(s0, s1, K_lds + (k & 1) * SHM_K, KR_lds + (k & 1) * SHM_KR, QR_lds, qr, r32, hi, kd0); SBAR();
      if (k >= 1) { trd8<1>(vc, vbk); LGKM_WAIT(8); pv4(o[0], va, pa0, pa1, pa2, pa3); SBAR();
                    trd8<2>(va, vbk); LGKM_WAIT(8); pv4(o[1], vc, pa0, pa1, pa2, pa3); SBAR();
                    trd8<3>(vc, vbk); LGKM_WAIT(8); pv4(o[2], va, pa0, pa1, pa2, pa3); SBAR();
                    LGKM_WAIT(0); pv4(o[3], vc, pa0, pa1, pa2, pa3); } }
    asm volatile("s_nop 15\n\ts_nop 15" ::: "memory"); STAMP1(tM);
    if (half == 1) SEG_WBAR(); else SEG_BAR();
    STAMP1(tMb);
    if (half == 1) DMA_EVEN(k + 1);
    if constexpr (SWA) band_mask(s0, s1, kpos0 + k * KVBLK, qpos, hi);
    partialSM(s0, s1, m_reg, mn, al, C, thr);
    if (__any(al < 1.f)) { if (hi == 0) al_l[r32] = al; asm volatile("s_waitcnt lgkmcnt(0)" ::: "memory");
#pragma unroll
      for (int d = 0; d < 4; ++d)
#pragma unroll
        for (int r = 0; r < 16; ++r) o[d][r] *= al_l[crow(r, hi)]; }
    finishSM(s0, s1, al, l_reg, pa0, pa1, pa2, pa3);
    asm volatile("" : "+v"(pa0), "+v"(pa1), "+v"(pa2), "+v"(pa3)); STAMP1(tV);
    if (half == 0) SEG_WBAR(); else SEG_BAR();
    STAMP1(tVb);
  }
#ifdef PROBE_STAMP
  if (stamp && blockIdx.x == 0 && (wid == 0 || wid == 4) && lane == 0) { unsigned* q = stamp + (wid == 0 ? 0 : 4);
    atomicAdd(q + 0, (unsigned)(tM / NT)); atomicAdd(q + 1, (unsigned)(tMb / NT)); atomicAdd(q + 2, (unsigned)(tV / NT)); atomicAdd(q + 3, (unsigned)(tVb / NT)); }
#endif
  pv_d0(o, vb0 + ((NT - 1) & 1) * SHM_V, pa0, pa1, pa2, pa3);
  SEG_BAR();
  if (half == 0) SEG_BAR();
#undef RFL
#undef DMA_K
#undef DMA_V
#undef DMA_EVEN
#undef SEG_BAR
#undef SEG_WBAR
}

template <int NQ, bool ROPEK, bool SWA>
__device__ __forceinline__ void attn_core_hs(LAS char* lds, const bf16x8 (&qr)[NQ],
                                             const bf16* __restrict__ Kh, const bf16* __restrict__ Vh, const int ldk, const bf16* __restrict__ KRh, const int ldkr,
                                             const int NT, const float C, const float thr, const int kd0, const int qpos, const int kpos0,
                                             f32x16 (&o)[4], float& m_reg, float& l_reg, const int wv) {
  const int tid = opq_tid(wv), lane = tid & 63, r32 = lane & 31, hi = lane >> 5;
  const int wid = __builtin_amdgcn_readfirstlane(tid >> 6);
  const int half = wid >> 2;
  LAS char* K_lds = lds + OFF_K; LAS char* KR_lds = lds + OFF_KR;
  LAS float* al_l = (LAS float*)(lds + OFF_WS) + wid * 64 + 32;
  const LAS char* QR_lds = lds + OFF_QR + wid * 4096 + lane * 16;
  const unsigned lds0 = (unsigned)(uintptr_t)lds;
  const int vb0 = (int)lds0 + OFF_V + v_rd_base(lane);
  unsigned kofs[2], vofs[2], krofs = 0u;
#pragma unroll
  for (int i = 0; i < 2; ++i) { const int p = wid * 2 + i;
    { const int row = p * 4 + (lane >> 4), ch = (lane & 15) ^ (row & KSW_MASK); kofs[i] = (unsigned)(row * ldk + ch * 8) * 2u; }
    { const int sub = 2 * p + (lane >> 5), kk = (sub >> 2) * 8 + ((lane & 31) >> 2), k = ATT_NOSWAP ? kk : ((kk & ~0xC) | ((kk & 4) << 1) | ((kk & 8) >> 1)), c = (sub & 3) * 32 + (lane & 3) * 8;
      vofs[i] = (unsigned)(k * ldk + c) * 2u; } }
  if constexpr (ROPEK) { const int row = wid * 8 + (lane >> 3), ch = (lane & 7) ^ ((row >> 1) & 7); krofs = (unsigned)(row * ldkr + ch * 8) * 2u; }
  const size_t tstepK = (size_t)KVBLK * ldk * 2, tstepKR = (size_t)KVBLK * ldkr * 2;
  const unsigned ldsK = RFLU(lds0 + OFF_K + (wid * 2) * 1024), ldsV = RFLU(lds0 + OFF_V + (wid * 2) * 1024), ldsKR = RFLU(lds0 + OFF_KR + wid * 1024);
#define DMA_K(t, b) do { const char* g_ = (const char*)Kh + (size_t)(t) * tstepK; \
    glds16x2(g_, kofs[0], kofs[1], ldsK + (b) * SHM_K, ldsK + (b) * SHM_K + 1024); \
    if constexpr (ROPEK) glds16s((const char*)KRh + (size_t)(t) * tstepKR, krofs, ldsKR + (b) * SHM_KR); } while (0)
#define DMA_V(t, b) do { const char* g_ = (const char*)Vh + (size_t)(t) * tstepK; \
    glds16x2(g_, vofs[0], vofs[1], ldsV + (b) * SHM_V, ldsV + (b) * SHM_V + 1024); } while (0)
#define RESC(a) do { if (__any((a) < 1.f)) { if (hi == 0) al_l[r32] = (a); asm volatile("s_waitcnt lgkmcnt(0)" ::: "memory"); \
    _Pragma("unroll") for (int d = 0; d < 4; ++d) _Pragma("unroll") for (int r = 0; r < 16; ++r) o[d][r] *= al_l[crow(r, hi)]; } } while (0)
#define QKT(P0, P1, b, tile) do { qkt<NQ, ROPEK>(P0, P1, K_lds + (b) * SHM_K, KR_lds + (b) * SHM_KR, QR_lds, qr, r32, hi, kd0); \
    if constexpr (SWA) band_mask(P0, P1, kpos0 + (tile) * KVBLK, qpos, hi); } while (0)
#define BAR_ISSUE(j, vw) do { SBAR(); WAIT_BAR(); if ((j) + 2 < NT) DMA_K((j) + 2, (j) & 1); if ((j) + 1 < NT) DMA_V((j) + 1, (vw)); SBAR(); } while (0)
  f32x16 pA0, pA1, pB0, pB1; float mnA, mnB, alA, alB; bf16x8 pa0, pa1, pa2, pa3;
  DMA_K(0, 0); DMA_V(0, 0); DMA_K(1, 1);
  WAIT_BAR();
  QKT(pA0, pA1, 0, 0);
  if (half == 1) BAR_ISSUE(0, 1);
  partialSM(pA0, pA1, m_reg, mnA, alA, C, thr);
  if (half == 0) BAR_ISSUE(0, 1);
  int vr = 0;
  for (int j = 1; j + 1 < NT; j += 2) {
    { const int vw = vr == 0 ? 2 : vr - 1;
      SBAR(); QKT(pB0, pB1, 1, j);
      finishSM(pA0, pA1, alA, l_reg, pa0, pa1, pa2, pa3);
      if (half == 1) BAR_ISSUE(j, vw);
      SBAR(); pv_d0(o, vb0 + vr * SHM_V, pa0, pa1, pa2, pa3); partialSM(pB0, pB1, m_reg, mnB, alB, C, thr);
      if (half == 0) BAR_ISSUE(j, vw);
      RESC(alB); vr = vr == 2 ? 0 : vr + 1; }
    { const int vw = vr == 0 ? 2 : vr - 1;
      SBAR(); QKT(pA0, pA1, 0, j + 1);
      finishSM(pB0, pB1, alB, l_reg, pa0, pa1, pa2, pa3);
      if (half == 1) BAR_ISSUE(j + 1, vw);
      SBAR(); pv_d0(o, vb0 + vr * SHM_V, pa0, pa1, pa2, pa3); partialSM(pA0, pA1, m_reg, mnA, alA, C, thr);
      if (half == 0) BAR_ISSUE(j + 1, vw);
      RESC(alA); vr = vr == 2 ? 0 : vr + 1; }
  }
  { const int vw = vr == 0 ? 2 : vr - 1;
    SBAR(); QKT(pB0, pB1, 1, NT - 1);
    finishSM(pA0, pA1, alA, l_reg, pa0, pa1, pa2, pa3);
    if (half == 1) BAR_ISSUE(NT - 1, vw);
    SBAR(); pv_d0(o, vb0 + vr * SHM_V, pa0, pa1, pa2, pa3); partialSM(pB0, pB1, m_reg, mnB, alB, C, thr);
    if (half == 0) BAR_ISSUE(NT - 1, vw);
    RESC(alB); vr = vr == 2 ? 0 : vr + 1; }
  finishSM(pB0, pB1, alB, l_reg, pa0, pa1, pa2, pa3); SBAR();
  pv_d0(o, vb0 + vr * SHM_V, pa0, pa1, pa2, pa3);
  SBAR(); asm volatile("s_waitcnt lgkmcnt(0)\n\ts_barrier" ::: "memory"); SBAR();
#undef DMA_K
#undef DMA_V
#undef RESC
#undef QKT
#undef BAR_ISSUE
}

__device__ __forceinline__ void store_o(LAS char* lds, const f32x16 (&o)[4], float l_reg, bf16* Ow, const int ldo, const int wv) {
  const int tid = opq_tid(wv), lane = tid & 63, r32 = lane & 31, hi = lane >> 5; const int wid = __builtin_amdgcn_readfirstlane(tid >> 6);
  LAS float* li_l = (LAS float*)(lds + OFF_WS) + wid * 64;
  if (hi == 0) li_l[r32] = l_reg; asm volatile("s_waitcnt lgkmcnt(0)" ::: "memory");
  float rli[16];
#pragma unroll
  for (int r = 0; r < 16; ++r) rli[r] = __builtin_amdgcn_rcpf(li_l[crow(r, hi)]);
#pragma unroll
  for (int r = 0; r < 16; ++r) { const int orow = crow(r, hi);
#pragma unroll
    for (int d0 = 0; d0 < 4; ++d0) Ow[(long)orow * ldo + d0 * 32 + r32] = (bf16)f2bf(o[d0][r] * rli[r]); }
}
}
struct Frame {
    LAS unsigned char* lds;
    volatile LAS unsigned* MISC;
    gu32* ctl;
    int tid, lane, wave;
    int vcu, G;
};

struct WItem { const float* W; bf16* WT; int N, K, k0, n0, drow0; float* cm; };
struct WSrc { const float *w_in, *w_uq, *w_ukv, *w_br, *w_bg, *w_o, *w_fi, *w_fo, *w_ple, *w_pg; float* cm; };
constexpr int IT_IN = 146 * 32, IT_BG = 4 * 64 * 32, IT_UQ = 24 * 8, IT_UKV = 32 * 8, IT_BR = 4 * 64 * 8, IT_WO = 64 * 32, IT_FI = 352 * 32, IT_FO = 64 * 88, IT_PLE = 64 * 4, IT_PG = 64 * 32;
constexpr int IT_LAYER = IT_IN + IT_BG + IT_UQ + IT_UKV + IT_BR + IT_WO + IT_FI + IT_FO + IT_PLE + IT_PG;
__device__ __forceinline__ WItem witem(const WSrc& ws, bf16* WL, int L, int r) {
    if (r < IT_IN) { const int kb = r / 146, nb = r % 146; return WItem{ws.w_in + (size_t)L * D * ZC, WL + WL_W1, ZC, D, 64 * kb, 32 * nb, 32 * nb, nullptr}; } r -= IT_IN;
    if (r < IT_BG) { const int j = r / (64 * 32), q = r % (64 * 32), kb = q / 64, nb = q % 64; if (GATES_I8) return WItem{ws.w_bg + ((size_t)L * 4 + j) * D * D, WL + WL_W1 + (size_t)ZP * D, D, D, 64 * kb, 32 * nb, j * D + 32 * nb, ws.cm + (L * 5 + j) * D};
        return WItem{ws.w_bg + ((size_t)L * 4 + j) * D * D, WL + WL_W1, D, D, 64 * kb, 32 * nb, ZP + j * D + 32 * nb, nullptr}; } r -= IT_BG;
    if (r < IT_UQ) { const int kb = r / 24, nb = r % 24; return WItem{ws.w_uq + (size_t)L * 512 * 768, WL + WL_UQKV, 768, 512, 64 * kb, 32 * nb, 32 * nb, nullptr}; } r -= IT_UQ;
    if (r < IT_UKV) { const int kb = r / 32, nb = r % 32; return WItem{ws.w_ukv + (size_t)L * 512 * 1024, WL + WL_UQKV, 1024, 512, 64 * kb, 32 * nb, 768 + 32 * nb, nullptr}; } r -= IT_UKV;
    if (r < IT_BR) { const int j = r / (64 * 8), q = r % (64 * 8), kb = q / 64, nb = q % 64; return WItem{ws.w_br + ((size_t)L * 4 + j) * 512 * D, WL + WL_BR + (size_t)j * D * 512, D, 512, 64 * kb, 32 * nb, 32 * nb, nullptr}; } r -= IT_BR;
    if (r < IT_WO) { const int kb = r / 64, nb = r % 64; return WItem{ws.w_o + (size_t)L * D * D, WL + WL_WO, D, D, 64 * kb, 32 * nb, 32 * nb, nullptr}; } r -= IT_WO;
    if (r < IT_FI) { const int kb = r / 352, nb = r % 352; const int c0 = 32 * nb; const int up = c0 >= FF ? 1 : 0, cc = c0 - up * FF;
        return WItem{ws.w_fi + (size_t)L * D * 2 * FF, WL + WL_FI, 2 * FF, D, 64 * kb, c0, (cc >> 7) * 256 + up * 128 + (cc & 127), (GATES_I8 && FFN_I8) ? ws.cm + (CW_CMF - CW_CM) + L * 2 * FF : nullptr}; } r -= IT_FI;
    if (r < IT_FO) { const int kb = r / 64, nb = r % 64; return WItem{ws.w_fo + (size_t)L * FF * D, WL + WL_FO, D, FF, 64 * kb, 32 * nb, 32 * nb, nullptr}; } r -= IT_FO;
    if (r < IT_PLE) { const int kb = r / 64, nb = r % 64; return WItem{ws.w_ple + (size_t)L * PLE * D, WL + WL_PLE, D, PLE, 64 * kb, 32 * nb, 32 * nb, nullptr}; } r -= IT_PLE;
    { const int kb = r / 64, nb = r % 64; return WItem{ws.w_pg + (size_t)L * D * D, WL + WL_PG, D, D, 64 * kb, 32 * nb, 32 * nb, GATES_I8 ? ws.cm + (L * 5 + 4) * D : nullptr}; }
}
struct WRegs { f32x4 v[8]; };
__device__ __forceinline__ WRegs witem_load(const WItem& it, int lane) { WRegs r; const int lr = lane >> 3, lc = (lane & 7) * 4;
#pragma unroll
    for (int i = 0; i < 8; ++i) r.v[i] = *(const f32x4*)(it.W + (size_t)(it.k0 + 8 * i + lr) * it.N + it.n0 + lc);
    return r; }
__device__ __forceinline__ void witem_store(const WItem& it, const WRegs& r, LAS float* scr, int lane) {
    const int lr = lane >> 3, lc = (lane & 7) * 4;
#pragma unroll
    for (int i = 0; i < 8; ++i) { LAS float* s = scr + (8 * i + lr) * 33 + lc; s[0] = r.v[i][0]; s[1] = r.v[i][1]; s[2] = r.v[i][2]; s[3] = r.v[i][3]; }
    LDS_WAIT(); asm volatile("" ::: "memory");
    const int c = lane & 7;
    if (it.cm) {
        unsigned char* W8 = (unsigned char*)it.WT;
#pragma unroll
        for (int j = 0; j < 4; ++j) { const int n = (lane >> 3) + 8 * j; const LAS float* s = scr + (8 * c) * 33 + n; const float cmx = it.cm[it.n0 + n]; const float q = cmx > 0.f ? 127.0f / cmx : 0.f;
            v2u o; o.x = pk4_i8(q * s[0 * 33], q * s[1 * 33], q * s[2 * 33], q * s[3 * 33]); o.y = pk4_i8(q * s[4 * 33], q * s[5 * 33], q * s[6 * 33], q * s[7 * 33]);
            *(v2u*)(W8 + (size_t)(it.drow0 + n) * it.K + it.k0 + 8 * c) = o; }
    } else {
#pragma unroll
        for (int j = 0; j < 4; ++j) { const int n = (lane >> 3) + 8 * j; const LAS float* s = scr + (8 * c) * 33 + n;
            v4u o; o.x = pk2(s[0 * 33], s[1 * 33]); o.y = pk2(s[2 * 33], s[3 * 33]); o.z = pk2(s[4 * 33], s[5 * 33]); o.w = pk2(s[6 * 33], s[7 * 33]);
            *(v4u*)(it.WT + (size_t)(it.drow0 + n) * it.K + it.k0 + 8 * c) = o; }
    }
    LDS_WAIT(); asm volatile("" ::: "memory");
}
__device__ __forceinline__ void witem_colmax(const WItem& it, const WRegs& r, int lane) {
    f32x4 m = (f32x4){0.f, 0.f, 0.f, 0.f};
#pragma unroll
    for (int i = 0; i < 8; ++i) { m[0] = fmaxf(m[0], fabsf(r.v[i][0])); m[1] = fmaxf(m[1], fabsf(r.v[i][1])); m[2] = fmaxf(m[2], fabsf(r.v[i][2])); m[3] = fmaxf(m[3], fabsf(r.v[i][3])); }
#pragma unroll
    for (int e = 0; e < 4; ++e) { float v = m[e]; v = fmaxf(v, shx<8>(v)); v = fmaxf(v, shx<16>(v));
        auto rr = __builtin_amdgcn_permlane32_swap(__float_as_uint(v), __float_as_uint(v), false, false); m[e] = fmaxf(__uint_as_float(rr[0]), __uint_as_float(rr[1])); }
    if (lane < 8) {
#pragma unroll
        for (int e = 0; e < 4; ++e) atomicMax((unsigned*)it.cm + it.n0 + 4 * lane + e, __float_as_uint(m[e])); }
}

#ifndef THIN_XAL
#define THIN_XAL 1
#endif
#ifndef THIN_NT
#define THIN_NT 1
#endif
#if THIN_NT
#define XLD(p) __builtin_nontemporal_load(p)
#define XST(p, v) __builtin_nontemporal_store(v, p)
#else
#define XLD(p) (*(p))
#define XST(p, v) (*(p) = (v))
#endif
#ifndef THIN_NTH
#define THIN_NTH 0
#endif
#if THIN_NTH
#define HST(p, v) __builtin_nontemporal_store(v, p)
#else
#define HST(p, v) (*(p) = (v))
#endif
template <int MODE, bool Y2 = false>
__device__ __forceinline__ void thin_phase(Frame& F, const float* __restrict__ xin, const bf16* __restrict__ y, float* __restrict__ x, bf16* __restrict__ h,
                                           const float* __restrict__ gpost, const float* __restrict__ gpre, unsigned char* __restrict__ h8 = nullptr, float* __restrict__ sa8 = nullptr,
                                           const bool wx = true, const bf16* __restrict__ y2 = nullptr, const float* __restrict__ gpost2 = nullptr) {
    const int tid_ = opq_tid(F.wave), lane = tid_ & 63, wave_ = __builtin_amdgcn_readfirstlane(tid_ >> 6);
    const int gw = F.vcu * NWAVES + wave_, NGW = F.G * NWAVES;
    const bool xal = THIN_XAL && NGW == 2048 && S == 16384;
    const int rw0 = xal ? (gw >> 8) * 2048 + (gw & 255) : gw, rstep = xal ? 256 : NGW, rend = xal ? (gw >> 8) * 2048 + 2048 : S;
    f32x4 gp[8], gq[8];
#pragma unroll
    for (int j = 0; j < 8; ++j) { gp[j] = (MODE >= 1) ? *(const f32x4*)(gpost + 256 * j + 4 * lane) : (f32x4){0.f, 0.f, 0.f, 0.f};
                                  gq[j] = (MODE <= 1 || MODE == 4) ? *(const f32x4*)(gpre + 256 * j + 4 * lane) : (f32x4){0.f, 0.f, 0.f, 0.f}; }
    const float* const xsrc = (MODE == 0 || MODE == 4 || xin != nullptr) ? xin : x;
    f32x4 v[8]; v2u yw[8], yw2[8];
    if (rw0 < rend) {
#pragma unroll
        for (int j = 0; j < 8; ++j) v[j] = XLD((const f32x4*)(xsrc + (size_t)rw0 * D + 4 * lane + 256 * j));
        if constexpr (MODE >= 1) {
#pragma unroll
            for (int j = 0; j < 8; ++j) yw[j] = *(const v2u*)(y + (size_t)rw0 * D + 4 * lane + 256 * j); }
        if constexpr (Y2) {
#pragma unroll
            for (int j = 0; j < 8; ++j) yw2[j] = *(const v2u*)(y2 + (size_t)rw0 * D + 4 * lane + 256 * j); }
    }
    for (int row = rw0; row < rend; row += rstep) {
        const int nrow = row + rstep; const bool more = nrow < rend;
        f32x4 vn[8]; v2u ywn[8];
        if constexpr (!Y2) {
#pragma unroll
            for (int j = 0; j < 8; ++j) { vn[j] = v[j]; ywn[j] = (MODE >= 1) ? yw[j] : (v2u){0u, 0u}; }
            if (more) {
#pragma unroll
                for (int j = 0; j < 8; ++j) vn[j] = XLD((const f32x4*)(xsrc + (size_t)nrow * D + 4 * lane + 256 * j));
                if constexpr (MODE >= 1) {
#pragma unroll
                    for (int j = 0; j < 8; ++j) ywn[j] = *(const v2u*)(y + (size_t)nrow * D + 4 * lane + 256 * j); }
            }
        } else if (row != rw0) {
#pragma unroll
            for (int j = 0; j < 8; ++j) v[j] = XLD((const f32x4*)(xsrc + (size_t)row * D + 4 * lane + 256 * j));
#pragma unroll
            for (int j = 0; j < 8; ++j) yw[j] = *(const v2u*)(y + (size_t)row * D + 4 * lane + 256 * j);
#pragma unroll
            for (int j = 0; j < 8; ++j) yw2[j] = *(const v2u*)(y2 + (size_t)row * D + 4 * lane + 256 * j);
        }
        if constexpr (MODE >= 1) {
            f32x4 yv[8]; float s = 0.f;
#pragma unroll
            for (int j = 0; j < 8; ++j) { const v2u w = yw[j]; yv[j] = (f32x4){bflo(w.x), bfhi(w.x), bflo(w.y), bfhi(w.y)};
                s += (yv[j][0] * yv[j][0] + yv[j][1] * yv[j][1]) + (yv[j][2] * yv[j][2] + yv[j][3] * yv[j][3]); }
            const float rstd = 1.0f / sqrtf(wave_sum(s) * (1.0f / D) + RMS_EPS);
#pragma unroll
            for (int j = 0; j < 8; ++j) v[j] += yv[j] * rstd * gp[j];
        }
        if constexpr (Y2) {
            f32x4 yv[8]; float s = 0.f;
#pragma unroll
            for (int j = 0; j < 8; ++j) { const v2u w = yw2[j]; yv[j] = (f32x4){bflo(w.x), bfhi(w.x), bflo(w.y), bfhi(w.y)};
                s += (yv[j][0] * yv[j][0] + yv[j][1] * yv[j][1]) + (yv[j][2] * yv[j][2] + yv[j][3] * yv[j][3]); }
            const float rstd = 1.0f / sqrtf(wave_sum(s) * (1.0f / D) + RMS_EPS);
#pragma unroll
            for (int j = 0; j < 8; ++j) v[j] += yv[j] * rstd * *(const f32x4*)(gpost2 + 256 * j + 4 * lane);
        }
        if (wx) { float* xo = x + (size_t)row * D + 4 * lane;
#pragma unroll
            for (int j = 0; j < 8; ++j) XST((f32x4*)(xo + 256 * j), v[j]); }
        if constexpr (MODE <= 1 || MODE == 4) {
            float s = 0.f;
#pragma unroll
            for (int j = 0; j < 8; ++j) s += (v[j][0] * v[j][0] + v[j][1] * v[j][1]) + (v[j][2] * v[j][2] + v[j][3] * v[j][3]);
            const float rstd = 1.0f / sqrtf(wave_sum(s) * (1.0f / D) + RMS_EPS);
            bf16* hr = h + (size_t)row * D + 4 * lane;
            float amax = 0.f;
#pragma unroll
            for (int j = 0; j < 8; ++j) { const f32x4 t = v[j] * rstd * gq[j]; v[j] = t; if (h) { v2u w; w.x = pk2(t[0], t[1]); w.y = pk2(t[2], t[3]); HST((v2u*)(hr + 256 * j), w); }
                amax = fmaxf(fmaxf(amax, fmaxf(fabsf(t[0]), fabsf(t[1]))), fmaxf(fabsf(t[2]), fabsf(t[3]))); }
            if (h8) { amax = wave_max(amax); const float q = amax > 0.f ? 127.0f / amax : 0.f; if (lane == 0) sa8[row] = amax * (1.0f / 127.0f);
#pragma unroll
                for (int j = 0; j < 8; ++j) HST((unsigned*)(h8 + (size_t)row * D + 4 * lane + 256 * j), pk4_i8(q * v[j][0], q * v[j][1], q * v[j][2], q * v[j][3])); }
        }
        if constexpr (MODE == 2) {
            if (h8) { float amax = 0.f;
#pragma unroll
                for (int j = 0; j < 8; ++j) amax = fmaxf(fmaxf(amax, fmaxf(fabsf(v[j][0]), fabsf(v[j][1]))), fmaxf(fabsf(v[j][2]), fabsf(v[j][3])));
                amax = wave_max(amax); const float q = amax > 0.f ? 127.0f / amax : 0.f; if (lane == 0) sa8[row] = amax * (1.0f / 127.0f);
#pragma unroll
                for (int j = 0; j < 8; ++j) HST((unsigned*)(h8 + (size_t)row * D + 4 * lane + 256 * j), pk4_i8(q * v[j][0], q * v[j][1], q * v[j][2], q * v[j][3]));
            } else { bf16* hr = h + (size_t)row * D + 4 * lane;
#pragma unroll
                for (int j = 0; j < 8; ++j) { v2u w; w.x = pk2(v[j][0], v[j][1]); w.y = pk2(v[j][2], v[j][3]); *(v2u*)(hr + 256 * j) = w; } }
        }
#pragma unroll
        for (int j = 0; j < 8; ++j) { if constexpr (!Y2) { v[j] = vn[j]; if constexpr (MODE >= 1) yw[j] = ywn[j]; } }
    }
}

struct PrepP { bf16* Z; const float *c64, *s64, *c128, *s128; const float *qa, *kva, *axq, *axk; };
struct Sp2 { unsigned w1, w2; };
__device__ __forceinline__ Sp2 span64_load(const bf16* zr, int base, int lane, bool active) {
    const int col = base + (lane >> 4) * 64 + 2 * (lane & 15); Sp2 r{0u, 0u};
    if (active) { r.w1 = *(const unsigned*)(zr + col); r.w2 = *(const unsigned*)(zr + col + 32); } return r; }
template <bool NORM>
__device__ __forceinline__ void span64_apply(bf16* zr, int base, const Sp2 in, const float* c64, const float* s64, int pos_e, int pos_o, const float* g, int lane, bool active) {
    const int chunk = lane >> 4, jp = lane & 15, col = base + chunk * 64 + 2 * jp;
    float a0 = bflo(in.w1), a1 = bfhi(in.w1), b0 = bflo(in.w2), b1 = bfhi(in.w2);
    if constexpr (NORM) {
        const float s = sum32((a0 * a0 + a1 * a1) + (b0 * b0 + b1 * b1));
        const float rstd = 1.0f / sqrtf(s * (1.0f / 128.0f) + RMS_EPS);
        const int gi = (chunk & 1) * 64 + 2 * jp;
        a0 *= rstd * g[gi]; a1 *= rstd * g[gi + 1]; b0 *= rstd * g[gi + 32]; b1 *= rstd * g[gi + 33];
    }
    const int pos = (chunk & 1) ? pos_o : pos_e;
    const f32x2 c = *(const f32x2*)(c64 + (size_t)pos * 32 + 2 * jp), s = *(const f32x2*)(s64 + (size_t)pos * 32 + 2 * jp);
    const float n0 = a0 * c[0] - b0 * s[0], n1 = a1 * c[1] - b1 * s[1], m0 = b0 * c[0] + a0 * s[0], m1 = b1 * c[1] + a1 * s[1];
    if (active) { *(unsigned*)(zr + col) = pk2(n0, n1); *(unsigned*)(zr + col + 32) = pk2(m0, m1); }
}
__device__ __forceinline__ Sp2 span128_load(const bf16* zr, int base, int lane) { const int col = base + (lane >> 5) * 128 + 2 * (lane & 31); return Sp2{*(const unsigned*)(zr + col), *(const unsigned*)(zr + col + 64)}; }
__device__ __forceinline__ void span128_apply(bf16* zr, int base, const Sp2 in, const float* c128, const float* s128, int pos, int lane) {
    const int head = lane >> 5, jp = lane & 31, col = base + head * 128 + 2 * jp;
    const float a0 = bflo(in.w1), a1 = bfhi(in.w1), b0 = bflo(in.w2), b1 = bfhi(in.w2);
    const f32x2 c = *(const f32x2*)(c128 + (size_t)pos * 64 + 2 * jp), s = *(const f32x2*)(s128 + (size_t)pos * 64 + 2 * jp);
    *(unsigned*)(zr + col) = pk2(a0 * c[0] - b0 * s[0], a1 * c[1] - b1 * s[1]);
    *(unsigned*)(zr + col + 64) = pk2(b0 * c[0] + a0 * s[0], b1 * c[1] + a1 * s[1]);
}
__device__ __forceinline__ void latent_apply(bf16* zr, int base, const v4u w, const float* g, int lane) {
    f32x4 a, b; pg8::unpack8(w, a, b);
    float s = (a[0] * a[0] + a[1] * a[1]) + (a[2] * a[2] + a[3] * a[3]) + (b[0] * b[0] + b[1] * b[1]) + (b[2] * b[2] + b[3] * b[3]);
    const float rstd = 1.0f / sqrtf(wave_sum(s) * (1.0f / 512.0f) + RMS_EPS);
    const f32x4 g0 = *(const f32x4*)(g + 8 * lane), g1 = *(const f32x4*)(g + 8 * lane + 4);
    a = a * rstd * g0; b = b * rstd * g1;
    v4u o; o.x = pk2(a[0], a[1]); o.y = pk2(a[2], a[3]); o.z = pk2(b[0], b[1]); o.w = pk2(b[2], b[3]);
    *(v4u*)(zr + base + 8 * lane) = o;
}
__device__ __forceinline__ void prep_phase(Frame& F, const PrepP& P) {
    const int tid_ = opq_tid(F.wave), lane = tid_ & 63, wave_ = __builtin_amdgcn_readfirstlane(tid_ >> 6);
    const int gw = F.vcu * NWAVES + wave_, NGW = F.G * NWAVES;
    for (int t = gw; t < S; t += NGW) {
        bf16* zr = P.Z + (size_t)t * ZP;
        const v4u lq = *(const v4u*)(zr + Z_CQ + 8 * lane), lkv = *(const v4u*)(zr + Z_CKV + 8 * lane);
        const Sp2 kr = span64_load(zr, Z_KR, lane, lane < 16);
        const Sp2 dq0 = span64_load(zr, Z_DQ, lane, true), dq1 = span64_load(zr, Z_DQ + 256, lane, true), dk0 = span64_load(zr, Z_DK, lane, true), dk1 = span64_load(zr, Z_DK + 256, lane, true);
        const Sp2 sq0 = span128_load(zr, Z_SQ, lane), sq1 = span128_load(zr, Z_SQ + 256, lane), sk0 = span128_load(zr, Z_SK, lane);
        const Sp2 aq0 = span64_load(zr, Z_AQ, lane, true), aq1 = span64_load(zr, Z_AQ + 256, lane, true), ak0 = span64_load(zr, Z_AK, lane, true);
        asm volatile("" ::: "memory");
        latent_apply(zr, Z_CQ, lq, P.qa, lane);
        latent_apply(zr, Z_CKV, lkv, P.kva, lane);
        span64_apply<false>(zr, Z_KR, kr, P.c64, P.s64, t, t, nullptr, lane, lane < 16);
        span64_apply<false>(zr, Z_DQ, dq0, P.c64, P.s64, t, t, nullptr, lane, true);
        span64_apply<false>(zr, Z_DQ + 256, dq1, P.c64, P.s64, t, t, nullptr, lane, true);
        span64_apply<false>(zr, Z_DK, dk0, P.c64, P.s64, t, t, nullptr, lane, true);
        span64_apply<false>(zr, Z_DK + 256, dk1, P.c64, P.s64, t, t, nullptr, lane, true);
        span128_apply(zr, Z_SQ, sq0, P.c128, P.s128, t, lane);
        span128_apply(zr, Z_SQ + 256, sq1, P.c128, P.s128, t, lane);
        span128_apply(zr, Z_SK, sk0, P.c128, P.s128, t, lane);
        span64_apply<true>(zr, Z_AQ, aq0, P.c64, P.s64, t >> 6, t & 63, P.axq, lane, true);
        span64_apply<true>(zr, Z_AQ + 256, aq1, P.c64, P.s64, t >> 6, t & 63, P.axq, lane, true);
        span64_apply<true>(zr, Z_AK, ak0, P.c64, P.s64, t >> 6, t & 63, P.axk, lane, true);
        asm volatile("" ::: "memory");
    }
}

__device__ __forceinline__ void knorm_pass(Frame& F, const bf16* __restrict__ Z, unsigned* __restrict__ slot) {
    const int tid_ = opq_tid(F.wave), lane = tid_ & 63, wave_ = __builtin_amdgcn_readfirstlane(tid_ >> 6);
    const int gw = F.vcu * NWAVES + wave_, NGW = F.G * NWAVES;
    float md = 0.f, ma = 0.f, mr = 0.f;
    for (int t = gw; t < S; t += NGW) {
        const bf16* zr = Z + (size_t)t * ZP;
        const v4u dk = *(const v4u*)(zr + Z_DK + 8 * lane);
        const v4u ak = *(const v4u*)(zr + Z_AK + 8 * (lane & 31));
        const v4u kr = *(const v4u*)(zr + Z_KR + 8 * (lane & 7));
        f32x4 a, b; pg8::unpack8(dk, a, b);
        float sd = (a[0] * a[0] + a[1] * a[1]) + (a[2] * a[2] + a[3] * a[3]) + (b[0] * b[0] + b[1] * b[1]) + (b[2] * b[2] + b[3] * b[3]);
        pg8::unpack8(ak, a, b);
        float sa = (a[0] * a[0] + a[1] * a[1]) + (a[2] * a[2] + a[3] * a[3]) + (b[0] * b[0] + b[1] * b[1]) + (b[2] * b[2] + b[3] * b[3]);
        sd += shx<1>(sd); sd += shx<2>(sd); sd += shx<4>(sd);
        sa += shx<1>(sa); sa += shx<2>(sa); sa += shx<4>(sa); sa += shx<8>(sa);
        pg8::unpack8(kr, a, b);
        float sr = (a[0] * a[0] + a[1] * a[1]) + (a[2] * a[2] + a[3] * a[3]) + (b[0] * b[0] + b[1] * b[1]) + (b[2] * b[2] + b[3] * b[3]);
        sr += shx<1>(sr); sr += shx<2>(sr); sr += shx<4>(sr);
        md = fmaxf(md, sd); ma = fmaxf(ma, sa); mr = fmaxf(mr, sr);
    }
    md = wave_max(md); ma = wave_max(ma); mr = wave_max(mr);
    if (lane == 0) { atomicMax(slot + 0, __float_as_uint(md)); atomicMax(slot + 1, __float_as_uint(ma)); atomicMax(slot + 2, __float_as_uint(mr)); }
}

__device__ __forceinline__ bf16x8 qscale(const bf16x8 q, const float c) { if (!ATT_NEGM) return q; f32x4 a, b; pg8::unpack8(__builtin_bit_cast(v4u, q), a, b); return __builtin_bit_cast(bf16x8, pg8::pack8(a * c, b * c)); }
constexpr float M0 = ATT_NEGM ? 0.f : -1e30f;
#ifndef ATT_STAG
#define ATT_STAG 0
#endif
#if ATT_STAG
#define ATTN_CORE att::attn_core_stag
#elif ATT_HS
#define ATTN_CORE att::attn_core_hs
#else
#define ATTN_CORE att::attn_core
#endif
#ifndef SD_AX
#define SD_AX 2
#endif
#ifndef SD_SWA
#define SD_SWA 1
#endif
#ifndef SD_MLA
#define SD_MLA 1
#endif
#ifndef SD_DIFF
#define SD_DIFF 1
#endif
struct AttP { unsigned* stamp; const bf16* Z; const bf16* QM; const bf16* KVM; bf16* BR; const float *c64, *s64; const float* sink; const float* lam_p; const float* subln; float lam_init; const unsigned* kn; const unsigned* kn2; };
__device__ __forceinline__ float kn_load(const unsigned* p) { return ATT_FASTREF ? __uint_as_float(*p) : -1.f; }

__device__ __forceinline__ void unit_axial(Frame& F, const AttP& P, int h, int qb) {
    using namespace att;
    const int tid_ = opq_tid(F.wave), lane = tid_ & 63, r32 = lane & 31, hi = lane >> 5, wid = __builtin_amdgcn_readfirstlane(tid_ >> 6);
    LAS char* lds = (LAS char*)F.lds;
    const int row = qb * 256 + wid * 32 + r32;
    const bf16* Qw = P.Z + (size_t)row * ZP + Z_AQ + h * 128 + hi * 8;
    bf16x8 qr[8];
#pragma unroll
    for (int d0 = 0; d0 < 8; ++d0) qr[d0] = qscale(ld8(Qw + d0 * 16), 0.088388347648318440f * LOG2E);
    f32x16 o[4] = {}; float m_reg = M0, l_reg = 0.f;
    const float scale = 0.088388347648318440f;
#ifdef PROBE_STAMP
    ATTN_CORE<8, false, false>(lds, qr, P.Z + Z_AK + (h >> 1) * 128, P.Z + Z_AV + (h >> 1) * 128, ZP, nullptr, 0, S / KVBLK, scale * LOG2E, 8.f / scale, 0, 0, 0, o, m_reg, l_reg, F.wave, P.stamp);
#else
    ATTN_CORE<8, false, false>(lds, qr, P.Z + Z_AK + (h >> 1) * 128, P.Z + Z_AV + (h >> 1) * 128, ZP, nullptr, 0, S / KVBLK, scale * LOG2E, 8.f / scale, 0, 0, 0, o, m_reg, l_reg, F.wave, kn_load(P.kn + 1));
#endif
    store_o(lds, o, l_reg, P.BR + (size_t)(qb * 256 + wid * 32) * D + 1536 + h * 128, D, F.wave);
}
__device__ __forceinline__ void unit_swa(Frame& F, const AttP& P, int h, int qb) {
    using namespace att;
    const int tid_ = opq_tid(F.wave), lane = tid_ & 63, r32 = lane & 31, hi = lane >> 5, wid = __builtin_amdgcn_readfirstlane(tid_ >> 6);
    LAS char* lds = (LAS char*)F.lds;
    const int row = qb * 256 + wid * 32 + r32;
    const bf16* Qw = P.Z + (size_t)row * ZP + Z_SQ + h * 128 + hi * 8;
    bf16x8 qr[8];
#pragma unroll
    for (int d0 = 0; d0 < 8; ++d0) qr[d0] = qscale(ld8(Qw + d0 * 16), 0.088388347648318440f * LOG2E);
    f32x16 o[4] = {}; float m_reg = M0, l_reg = 0.f;
    const float scale = 0.088388347648318440f, C = scale * LOG2E;
    int k_lo = qb * 256 - 128; if (k_lo < 0) k_lo = 0; int k_hi = qb * 256 + 384; if (k_hi > S) k_hi = S;
    const int NT = (k_hi - k_lo) / KVBLK;
    ATTN_CORE<8, false, true>(lds, qr, P.Z + (size_t)k_lo * ZP + Z_SK + (h >> 1) * 128, P.Z + (size_t)k_lo * ZP + Z_SV + (h >> 1) * 128, ZP, nullptr, 0, NT, C, 8.f / scale, 0, row, k_lo, o, m_reg, l_reg, F.wave);
    l_reg += __builtin_amdgcn_exp2f(P.sink[h] * LOG2E - (ATT_NEGM ? m_reg : m_reg * C));
    store_o(lds, o, l_reg, P.BR + (size_t)(qb * 256 + wid * 32) * D + 1024 + h * 128, D, F.wave);
}
__device__ __forceinline__ void unit_mla(Frame& F, const AttP& P, int h, int qb) {
    using namespace att;
    const int tid_ = opq_tid(F.wave), lane = tid_ & 63, r32 = lane & 31, hi = lane >> 5, wid = __builtin_amdgcn_readfirstlane(tid_ >> 6);
    LAS char* lds = (LAS char*)F.lds;
    const int row = qb * 256 + wid * 32 + r32;
    const bf16* Qw = P.QM + (size_t)row * QM_P + h * 192 + hi * 8;
    bf16x8 qr[8];
    LAS char* QRw = lds + OFF_QR + wid * 4096 + lane * 16;
#pragma unroll
    for (int d0 = 0; d0 < 8; ++d0) qr[d0] = qscale(ld8(Qw + d0 * 16), 0.072168783648703220f * LOG2E);
    float qx2 = 0.f;
#pragma unroll
    for (int d = 0; d < 2; ++d) {
        const v4u wa = __builtin_bit_cast(v4u, ld8(Qw + 128 + d * 16)), wb = __builtin_bit_cast(v4u, ld8(Qw + 160 + d * 16));
        f32x4 a0, a1, b0, b1; pg8::unpack8(wa, a0, a1); pg8::unpack8(wb, b0, b1);
        const float* cp = P.c64 + (size_t)row * 32 + d * 16 + hi * 8; const float* sp = P.s64 + (size_t)row * 32 + d * 16 + hi * 8;
        const f32x4 c0 = *(const f32x4*)cp, c1 = *(const f32x4*)(cp + 4), s0 = *(const f32x4*)sp, s1 = *(const f32x4*)(sp + 4);
        const float qs_ = ATT_NEGM ? 0.072168783648703220f * LOG2E : 1.f;
        const f32x4 n0 = (a0 * c0 - b0 * s0) * qs_, n1 = (a1 * c1 - b1 * s1) * qs_, m0 = (b0 * c0 + a0 * s0) * qs_, m1 = (b1 * c1 + a1 * s1) * qs_;
        qx2 += (n0[0] * n0[0] + n0[1] * n0[1]) + (n0[2] * n0[2] + n0[3] * n0[3]) + (n1[0] * n1[0] + n1[1] * n1[1]) + (n1[2] * n1[2] + n1[3] * n1[3])
             + (m0[0] * m0[0] + m0[1] * m0[1]) + (m0[2] * m0[2] + m0[3] * m0[3]) + (m1[0] * m1[0] + m1[1] * m1[1]) + (m1[2] * m1[2] + m1[3] * m1[3]);
        v4u o1, o2; o1.x = pk2(n0[0], n0[1]); o1.y = pk2(n0[2], n0[3]); o1.z = pk2(n1[0], n1[1]); o1.w = pk2(n1[2], n1[3]);
        o2.x = pk2(m0[0], m0[1]); o2.y = pk2(m0[2], m0[3]); o2.z = pk2(m1[0], m1[1]); o2.w = pk2(m1[2], m1[3]);
        *(LAS v4u*)(QRw + d * 1024) = o1; *(LAS v4u*)(QRw + (2 + d) * 1024) = o2;
    }
    f32x16 o[4] = {}; float m_reg = M0, l_reg = 0.f;
    const float scale = 0.072168783648703220f;
    float kmax2 = -1.f;
    if (ATT_FASTREF) {
        const v4u* g4 = (const v4u*)(P.kn2 + h * 16); const v4u g0 = g4[0], g1 = g4[1], g2 = g4[2], g3 = g4[3];
        kmax2 = __uint_as_float(P.kn[2]) + ((__uint_as_float(g0.x) + __uint_as_float(g0.y)) + (__uint_as_float(g0.z) + __uint_as_float(g0.w))) + ((__uint_as_float(g1.x) + __uint_as_float(g1.y)) + (__uint_as_float(g1.z) + __uint_as_float(g1.w)))
              + ((__uint_as_float(g2.x) + __uint_as_float(g2.y)) + (__uint_as_float(g2.z) + __uint_as_float(g2.w))) + ((__uint_as_float(g3.x) + __uint_as_float(g3.y)) + (__uint_as_float(g3.z) + __uint_as_float(g3.w))); }
    ATTN_CORE<8, true, false>(lds, qr, P.KVM + h * 256, P.KVM + h * 256 + 128, KVM_P, P.Z + Z_KR, ZP, S / KVBLK, scale * LOG2E, 8.f / scale, 0, 0, 0, o, m_reg, l_reg, F.wave, kmax2, qx2);
    store_o(lds, o, l_reg, P.BR + (size_t)(qb * 256 + wid * 32) * D + 0 + h * 128, D, F.wave);
}
__device__ __forceinline__ void unit_diff(Frame& F, const AttP& P, int h, int qb128) {
    using namespace att;
    const int tid_ = opq_tid(F.wave), lane = tid_ & 63, r32 = lane & 31, hi = lane >> 5, wid = __builtin_amdgcn_readfirstlane(tid_ >> 6);
    LAS char* lds = (LAS char*)F.lds;
    const int comp = wid >> 2, wq = wid & 3;
    const int row = qb128 * 128 + wq * 32 + r32;
    const bf16* Qw = P.Z + (size_t)row * ZP + Z_DQ + (2 * h + comp) * 64 + hi * 8;
    bf16x8 qr[4];
#pragma unroll
    for (int d0 = 0; d0 < 4; ++d0) qr[d0] = qscale(ld8(Qw + d0 * 16), 0.125f * LOG2E);
    f32x16 o[4] = {}; float m_reg = M0, l_reg = 0.f;
    const float scale = 0.125f;
    ATTN_CORE<4, false, false>(lds, qr, P.Z + Z_DK + h * 128, P.Z + Z_DV + h * 128, ZP, nullptr, 0, S / KVBLK, scale * LOG2E, 8.f / scale, 4 * comp, 0, 0, o, m_reg, l_reg, F.wave, kn_load(P.kn + 0));
    const float la = wave_sum(P.lam_p[lane] * P.lam_p[64 + lane]), lb = wave_sum(P.lam_p[128 + lane] * P.lam_p[192 + lane]);
    const float lam = expf(la) - expf(lb) + P.lam_init;
    LAS float* li_l = (LAS float*)(lds + OFF_WS) + wid * 64;
    if (hi == 0) li_l[r32] = l_reg; asm volatile("s_waitcnt lgkmcnt(0)" ::: "memory");
#pragma unroll
    for (int r = 0; r < 16; ++r) { const float rl = __builtin_amdgcn_rcpf(li_l[crow(r, hi)]);
#pragma unroll
        for (int d = 0; d < 4; ++d) o[d][r] *= rl; }
    __syncthreads();
    LAS float* X = (LAS float*)lds + wq * 4096;
    if (comp == 1) {
#pragma unroll
        for (int d = 0; d < 4; ++d)
#pragma unroll
            for (int r = 0; r < 16; ++r) X[(d * 16 + r) * 64 + lane] = o[d][r];
    }
    __syncthreads();
    if (comp == 0) {
        float ss[16];
#pragma unroll
        for (int r = 0; r < 16; ++r) { float s = 0.f;
#pragma unroll
            for (int d = 0; d < 4; ++d) { const float v = o[d][r] - lam * X[(d * 16 + r) * 64 + lane]; o[d][r] = v; s += v * v; }
            ss[r] = s; }
#pragma unroll
        for (int r = 0; r < 16; ++r) { float s = sum32(ss[r]);
            ss[r] = (1.0f - P.lam_init) / sqrtf(s * (1.0f / 128.0f) + RMS_EPS); }
        float gn[4];
#pragma unroll
        for (int d = 0; d < 4; ++d) gn[d] = P.subln[d * 32 + r32];
        bf16* Ow = P.BR + (size_t)(qb128 * 128 + wq * 32) * D + 512 + h * 128;
#pragma unroll
        for (int r = 0; r < 16; ++r) { const int orow = crow(r, hi);
#pragma unroll
            for (int d = 0; d < 4; ++d) Ow[(long)orow * D + d * 32 + r32] = (bf16)f2bf(o[d][r] * ss[r] * gn[d]); }
    }
    __syncthreads();
}
__device__ const float INVF128[64] = {
1.000000000e+00f, 8.659643531e-01f, 7.498942018e-01f, 6.493816376e-01f, 5.623413324e-01f, 4.869675338e-01f, 4.216965139e-01f, 3.651741147e-01f, 3.162277639e-01f, 2.738419771e-01f, 2.371373773e-01f, 2.053525001e-01f, 1.778279394e-01f, 1.539926529e-01f, 1.333521456e-01f, 1.154781953e-01f, 1.000000015e-01f, 8.659642935e-02f, 7.498942316e-02f, 6.493816525e-02f, 5.623413250e-02f, 4.869675264e-02f, 4.216964915e-02f, 3.651741147e-02f, 3.162277490e-02f, 2.738419548e-02f, 2.371373773e-02f, 2.053525113e-02f, 1.778279431e-02f, 1.539926510e-02f, 1.333521400e-02f, 1.154781971e-02f, 9.999999776e-03f, 8.659643121e-03f, 7.498942316e-03f, 6.493816152e-03f, 5.623413250e-03f, 4.869675264e-03f, 4.216964822e-03f, 3.651741194e-03f, 3.162277630e-03f, 2.738419687e-03f, 2.371373819e-03f, 2.053525066e-03f, 1.778279431e-03f, 1.539926510e-03f, 1.333521446e-03f, 1.154782018e-03f, 1.000000047e-03f, 8.659643354e-04f, 7.498941850e-04f, 6.493816036e-04f, 5.623413017e-04f, 4.869675322e-04f, 4.216965172e-04f, 3.651741135e-04f, 3.162277571e-04f, 2.738419571e-04f, 2.371373703e-04f, 2.053525095e-04f, 1.778279402e-04f, 1.539926598e-04f, 1.333521504e-04f, 1.154782003e-04f };
__device__ __forceinline__ void sincos_d(double a, float& sn, float& cs) {
    const double k = rint(a * 0.63661977236758134308);
    const double r = (a - k * 1.57079632673412561417e+00) - k * 6.07710050650619224932e-11;
    const double r2 = r * r;
    double ps = -1.0 / 6227020800.0; ps = ps * r2 + 1.0 / 39916800.0; ps = ps * r2 - 1.0 / 362880.0; ps = ps * r2 + 1.0 / 5040.0; ps = ps * r2 - 1.0 / 120.0; ps = ps * r2 + 1.0 / 6.0;
    const double s = r - r * r2 * ps;
    double pc = 1.0 / 87178291200.0; pc = pc * r2 - 1.0 / 479001600.0; pc = pc * r2 + 1.0 / 3628800.0; pc = pc * r2 - 1.0 / 40320.0; pc = pc * r2 + 1.0 / 720.0; pc = pc * r2 - 1.0 / 24.0; pc = pc * r2 + 0.5;
    const double c = 1.0 - r2 * pc;
    const int q = (int)((long long)k & 3);
    const double so = (q == 0) ? s : (q == 1) ? c : (q == 2) ? -s : -c;
    const double co = (q == 0) ? c : (q == 1) ? -s : (q == 2) ? -c : s;
    sn = (float)so; cs = (float)co;
}

#ifndef PHMASK
#define PHMASK 0xFFFFFF
#endif
#define PHEN(i) (((PHMASK) >> (i)) & 1)
#ifndef FUSE_NORM
#define FUSE_NORM 0
#endif
#ifndef G3_HALF
#define G3_HALF 1
#endif
#ifndef I8_ALIGN
#define I8_ALIGN true
#endif
#ifndef GATE_ALIGN
#define GATE_ALIGN true
#endif
#ifndef G1_ALIGN
#define G1_ALIGN true
#endif
#ifndef G3_ALIGN
#define G3_ALIGN true
#endif
#ifndef LEAN_X
#define LEAN_X (GATES_I8 && !MK_DEBUG && !FUSE_NORM)
#endif
#ifndef REP_MASK
#define REP_MASK 0
#endif
#define REPN(i) (1 + (((REP_MASK) >> (i)) & 1))
#ifndef AMASK
#define AMASK 0xF
#endif
#define AEN(i) (((AMASK) >> (i)) & 1)
constexpr int NPH = 12;
constexpr int NPHASES = 1 + DEPTH * NPH;
struct Args { const float* in[24]; float* out; unsigned char* ws; int ph_lo, ph_hi, li, pad; float lam_init[4]; };

__global__ void __launch_bounds__(NWAVES * 64, 2) mk_fwd(Args args) {
    extern __shared__ __attribute__((aligned(16))) unsigned char lds[];
    Frame F;
    F.lds = (LAS unsigned char*)lds;
    F.MISC = (volatile LAS unsigned*)(F.lds + MISC_OFF);
    F.tid = threadIdx.x; F.lane = F.tid & 63; F.wave = __builtin_amdgcn_readfirstlane(F.tid >> 6);
    F.G = gridDim.x; { const int bx = blockIdx.x; F.vcu = (F.G % 8 == 0) ? (bx % 8) * (F.G / 8) + bx / 8 : bx; }
    unsigned char* ws = args.ws;
    F.ctl = (gu32*)(ws + WS_CTL);
    for (int u = F.tid; u < (LDS_BYTES - LDSCTL_OFF) / 4; u += NWAVES * 64) ((LAS unsigned*)(F.lds + LDSCTL_OFF))[u] = 0u;
    __syncthreads();
    XcdBarrier bar = xcd_barrier_post((unsigned*)(F.ctl + CW_BAR) + args.li * XCD_BAR_WORDS, F.MISC + 8, F.wave);
    const int lo = args.ph_lo, hi = args.ph_hi;
#define IN(k) (lo <= (k) && (k) < hi)
#ifdef PROBE_SEAM2
#define SEAM(k) do { if (IN(k) && (k) + 1 < hi && (k) + 1 < NPHASES) { xcd_barrier(bar); xcd_barrier(bar); } } while (0)
#else
#define SEAM(k) do { if (IN(k) && (k) + 1 < hi && (k) + 1 < NPHASES) xcd_barrier(bar); } while (0)
#endif
    float* const X = args.out;
    float* const c64 = (float*)(ws + WS_TAB64); float* const s64 = c64 + (size_t)S * 32;
    float* const c128 = (float*)(ws + WS_TAB128); float* const s128 = c128 + (size_t)S * 64;
    bf16* const Hb = (bf16*)(ws + WS_H); bf16* const Zb = (bf16*)(ws + WS_Z); bf16* const GTb = (bf16*)(ws + WS_GT);
    bf16* const QMb = (bf16*)(ws + WS_QM); bf16* const KVMb = (bf16*)(ws + WS_KVM); bf16* const BRb = (bf16*)(ws + WS_BR);
    bf16* const Yb = (bf16*)(ws + WS_Z); float* const MFf = (float*)(ws + WS_Z); bf16* const MGb = FUSE_NORM ? (bf16*)(ws + WS_Z + 64 * MiB) : Hb; bf16* const XBb = FUSE_NORM ? (bf16*)(ws + WS_Z) : Hb; bf16* const HIDb = GTb; bf16* const P2b = BRb;
    bf16* const PBb = (bf16*)(ws + WS_PB);
    unsigned char* const A8 = (GATES_FP8 || GATES_I8) ? (unsigned char*)(ws + WS_A8) : nullptr;
    float* const SA8 = (float*)(ws + WS_SA); float* const CMf = (float*)(F.ctl + CW_CM);

    if (PHEN(12) && IN(0)) for (int rep_ = 0; rep_ < REPN(12); ++rep_) {
        const int tid_ = opq_tid(F.wave), lane_ = tid_ & 63, wave_ = __builtin_amdgcn_readfirstlane(tid_ >> 6);
        const int gw = F.vcu * NWAVES + wave_, NGW = F.G * NWAVES;
        const int gt = F.vcu * (NWAVES * 64) + tid_, NGT = F.G * NWAVES * 64;
        {
            WSrc wsrc{args.in[7], args.in[9], args.in[11], args.in[17], args.in[18], args.in[19], args.in[20], args.in[21], args.in[22], args.in[23], CMf};
#if GATES_I8
            constexpr int IT_Q = IT_BG + IT_PG + (FFN_I8 ? IT_FI : 0);
            for (int it2 = gw; it2 < DEPTH * IT_Q; it2 += NGW) { const int L2 = DEPTH - 1 - it2 / IT_Q, q2 = it2 % IT_Q;
                const int r2 = q2 < IT_BG ? IT_IN + q2 : (q2 < IT_BG + IT_PG ? IT_LAYER - IT_PG + (q2 - IT_BG) : IT_IN + IT_BG + IT_UQ + IT_UKV + IT_BR + IT_WO + (q2 - IT_BG - IT_PG));
                const WItem wi = witem(wsrc, (bf16*)(ws + WS_W + (size_t)L2 * WL_BYTES), L2, r2); const WRegs rr2 = witem_load(wi, lane_); witem_colmax(wi, rr2, lane_); }
            xcd_barrier(bar);
#endif
            LAS float* scr = (LAS float*)(F.lds + RING_OFF + wave_ * 16384);
            int it = gw;
            if (it < DEPTH * IT_LAYER) {
                WItem cur = witem(wsrc, (bf16*)(ws + WS_W + (size_t)(it / IT_LAYER) * WL_BYTES), it / IT_LAYER, it % IT_LAYER); WRegs rv = witem_load(cur, lane_);
                for (;;) { const int nx = it + NGW; const bool more = nx < DEPTH * IT_LAYER;
                    WItem nxt = cur; WRegs rn = rv;
                    if (more) { nxt = witem(wsrc, (bf16*)(ws + WS_W + (size_t)(nx / IT_LAYER) * WL_BYTES), nx / IT_LAYER, nx % IT_LAYER); rn = witem_load(nxt, lane_); }
                    witem_store(cur, rv, scr, lane_);
                    if (!more) break;
                    cur = nxt; rv = rn; it = nx; }
            }
            for (int i = gt; i < DEPTH * 49152; i += NGT) { const int L = i / 49152, q = i - L * 49152;
                *(v4u*)((bf16*)(ws + WS_W + (size_t)L * WL_BYTES) + WL_W1 + (size_t)ZC * D + (size_t)q * 8) = (v4u){0u, 0u, 0u, 0u}; }
        }
        for (int i = gt; i < S * 32; i += NGT) { const int pos = i >> 5, j = i & 31; const float ang = (float)pos * INVF128[2 * j]; float sn, cs; sincos_d((double)ang, sn, cs); c64[i] = cs; s64[i] = sn; }
        for (int i = gt; i < S * 64; i += NGT) { const int pos = i >> 6, j = i & 63; const float ang = (float)pos * INVF128[j]; float sn, cs; sincos_d((double)ang, sn, cs); c128[i] = cs; s128[i] = sn; }
        { const float* p = args.in[1];
          for (int i = gt; i < DEPTH * S * PLE / 8; i += NGT) { const f32x4 a = *(const f32x4*)(p + (size_t)i * 8), b = *(const f32x4*)(p + (size_t)i * 8 + 4);
              v4u o; o.x = pk2(a[0], a[1]); o.y = pk2(a[2], a[3]); o.z = pk2(b[0], b[1]); o.w = pk2(b[2], b[3]); *(v4u*)(PBb + (size_t)i * 8) = o; } }
        thin_phase<0>(F, args.in[0], nullptr, X, Hb, nullptr, args.in[2], A8, SA8, !LEAN_X);
    }
    SEAM(0);

    for (int L = 0; L < DEPTH; ++L) {
        const int pb = 1 + L * NPH;
        const bf16* WL = (const bf16*)(ws + WS_W + (size_t)L * WL_BYTES);
        if (PHEN(0) && IN(pb + 0)) for (int rep_ = 0; rep_ < REPN(0); ++rep_) {
#if GATES_I8
            { pg8::StaticOrder So; So.init(Hb, D, WL + WL_W1, D, S, ZP, F.G, (int)blockIdx.x);
              pg8::EpiPlain E{Zb, ZP};
              pg8::gemm_phase<pg8::EpiPlain, pg8::StaticOrder>(F.lds + RING_OFF, F.wave, D, D, D, So, E); }
            { pg8::StaticOrder So; So.init((const bf16*)A8, D / 2, WL + WL_W1 + (size_t)ZP * D, D / 2, S, NG, F.G, (int)blockIdx.x);
              pg8::EpiGateI8 E{GTb, SA8, CMf + L * 5 * D};
              pg8::gemm_phase<pg8::EpiGateI8, pg8::StaticOrder, GATE_ALIGN, false, true>(F.lds + RING_OFF, F.wave, D / 2, D / 2, D / 2, So, E); }
#elif GATES_FP8
            { pg8::StaticOrder So; So.init(Hb, D, WL + WL_W1, D, S, ZP, F.G, (int)blockIdx.x);
              pg8::EpiPlain E{Zb, ZP};
              pg8::gemm_phase<pg8::EpiPlain, pg8::StaticOrder>(F.lds + RING_OFF, F.wave, D, D, D, So, E); }
            { pg8::StaticOrder So; So.init((const bf16*)A8, D / 2, WL + WL_W1 + (size_t)ZP * D, D / 2, S, NG, F.G, (int)blockIdx.x);
              pg8::EpiGate E{GTb};
              pg8::gemm_phase<pg8::EpiGate, pg8::StaticOrder, true, true>(F.lds + RING_OFF, F.wave, D, D, D, So, E); }
#else
            pg8::StaticOrder So; So.init(Hb, D, WL + WL_W1, D, S, N1, F.G, (int)blockIdx.x);
            pg8::EpiG1 E{Zb, GTb};
            pg8::gemm_phase<pg8::EpiG1, pg8::StaticOrder, G1_ALIGN>(F.lds + RING_OFF, F.wave, D, D, D, So, E);
#endif
        }
        SEAM(pb + 0);
        if (PHEN(1) && IN(pb + 1)) {
            PrepP P{Zb, c64, s64, c128, s128, args.in[8] + L * 512, args.in[10] + L * 512, args.in[15] + L * 128, args.in[16] + L * 128};
            prep_phase(F, P);
            if (REPN(1) > 1) { PrepP P2{(bf16*)(ws + WS_END), c64, s64, c128, s128, args.in[8] + L * 512, args.in[10] + L * 512, args.in[15] + L * 128, args.in[16] + L * 128}; prep_phase(F, P2); }
#ifdef REP_BARRIERS
            for (int rb_ = 0; rb_ < REP_BARRIERS; ++rb_) xcd_barrier(bar);
#endif
        }
        SEAM(pb + 1);
        if (PHEN(2) && IN(pb + 2)) for (int rep_ = 0; rep_ < REPN(2); ++rep_) {
            pg8::OrderG2 So{Zb, WL + WL_UQKV, F.G, (int)blockIdx.x};
            pg8::EpiG2 E{QMb, KVMb, (ATT_NEGM && ATT_FASTREF && rep_ == 0) ? (unsigned*)(F.ctl + CW_KN2) + L * 64 : nullptr};
            pg8::gemm_phase<pg8::EpiG2, pg8::OrderG2>(F.lds + RING_OFF, F.wave, 512, ZP, 512, So, E);
#if ATT_NEGM && ATT_FASTREF
            if (rep_ == 0) knorm_pass(F, Zb, (unsigned*)(F.ctl + CW_KN) + L * 4);
#endif
        }
        SEAM(pb + 2);
        if (PHEN(3) && IN(pb + 3)) for (int rep_ = 0; rep_ < REPN(3); ++rep_) {
            AttP P{(L == 0) ? (unsigned*)(F.ctl + 200) : nullptr, Zb, QMb, KVMb, BRb, c64, s64, args.in[14] + L * 4, args.in[12] + L * 256, args.in[13] + L * 128, args.lam_init[L], (const unsigned*)(F.ctl + CW_KN) + L * 4, (const unsigned*)(F.ctl + CW_KN2) + L * 64};
            if (AEN(0)) for (int u = F.vcu; u < 256; u += F.G) unit_mla(F, P, u >> 6, u & 63);
            __syncthreads();
#if defined(PROBE_MIDBAR) && PROBE_MIDBAR >= 2
            xcd_barrier(bar);
#endif
            if (AEN(1)) for (int u = F.vcu; u < 256; u += F.G) unit_axial(F, P, u >> 6, u & 63);
            __syncthreads();
#ifdef PROBE_MIDBAR
            xcd_barrier(bar);
#endif
            if (AEN(2)) for (int u = F.vcu; u < 256; u += F.G) {
_Pragma("unroll 1")
                for (int i2 = 0; i2 < 2; ++i2) { const int uu = 2 * u + i2; unit_diff(F, P, uu >> 7, uu & 127);
#if defined(PROBE_MIDBAR) && PROBE_MIDBAR >= 2
                    xcd_barrier(bar);
#endif
                } }
            if (AEN(3)) for (int u = F.vcu; u < 256; u += F.G) unit_swa(F, P, u >> 6, u & 63);
            __syncthreads();
        }
        SEAM(pb + 3);
        if (PHEN(4) && IN(pb + 4)) for (int rep_ = 0; rep_ < REPN(4); ++rep_) {
#if G3_HALF
            pg8::OrderG3h So{BRb, WL + WL_BR, F.G, (int)blockIdx.x};
            pg8::EpiG3h E{GTb, MGb};
            pg8::gemm_phase_h<pg8::EpiG3h, pg8::OrderG3h>(F.lds + RING_OFF, F.wave, 512, D, 512, So, E);
#else
            pg8::OrderG3 So{BRb, WL + WL_BR, F.G, (int)blockIdx.x};
            pg8::EpiG3 E{GTb, (bf16*)MFf, MGb};
            pg8::gemm_phase<pg8::EpiG3, pg8::OrderG3, G3_ALIGN>(F.lds + RING_OFF, F.wave, 512, D, 512, So, E);
#endif
        }
        SEAM(pb + 4);
#define XCHI(k) pg8::RmsXchg{(float*)(ws + WS_XCH + (size_t)(L * 6 + (k)) * 512 * 1024), (unsigned*)(F.ctl + CW_SEAM + (L * 6 + (k)) * SEAM_BANK), (unsigned*)(F.ctl + CW_TMO)}
        if (PHEN(5) && IN(pb + 5)) for (int rep_ = 0; rep_ < REPN(5); ++rep_) {
#if FUSE_NORM
            pg8::EpiNorm<0, 1> E{X, Hb, nullptr, args.in[3] + L * D, args.in[4] + L * D, XCHI(0), XCHI(1)};
            { pg8::PanelOrder So{MGb, WL + WL_WO, D, D, F.G, (int)blockIdx.x, 0}; pg8::gemm_phase<pg8::EpiNorm<0, 1>, pg8::PanelOrder>(F.lds + RING_OFF, F.wave, D, D, D, So, E); }
            { pg8::PanelOrder So{MGb, WL + WL_WO, D, D, F.G, (int)blockIdx.x, 1}; pg8::gemm_phase<pg8::EpiNorm<0, 1>, pg8::PanelOrder>(F.lds + RING_OFF, F.wave, D, D, D, So, E); }
#else
#ifdef PANEL_PLAIN
            pg8::EpiPlain E{Yb, D};
            { pg8::PanelOrder So{MGb, WL + WL_WO, D, D, F.G, (int)blockIdx.x, 0}; pg8::gemm_phase<pg8::EpiPlain, pg8::PanelOrder>(F.lds + RING_OFF, F.wave, D, D, D, So, E); }
            { pg8::PanelOrder So{MGb, WL + WL_WO, D, D, F.G, (int)blockIdx.x, 1}; pg8::gemm_phase<pg8::EpiPlain, pg8::PanelOrder>(F.lds + RING_OFF, F.wave, D, D, D, So, E); }
#else
            pg8::StaticOrder So; So.init(MGb, D, WL + WL_WO, D, S, D, F.G, (int)blockIdx.x);
            pg8::EpiPlain E{Yb, D};
            pg8::gemm_phase<pg8::EpiPlain, pg8::StaticOrder>(F.lds + RING_OFF, F.wave, D, D, D, So, E);
#endif
#endif
        }
        SEAM(pb + 5);
#if !FUSE_NORM
        if (PHEN(6) && IN(pb + 6)) { thin_phase<1>(F, (LEAN_X && L == 0) ? args.in[0] : nullptr, Yb, X, (GATES_I8 && FFN_I8 && !MK_DEBUG) ? nullptr : Hb, args.in[3] + L * D, args.in[4] + L * D, (GATES_I8 && FFN_I8) ? A8 : nullptr, SA8);
            if (REPN(6) > 1) thin_phase<4>(F, X, Yb, (float*)GTb, GTb + (size_t)S * D * 2, args.in[3] + L * D, args.in[4] + L * D); }
        SEAM(pb + 6);
#endif
        if (PHEN(7) && IN(pb + 7)) for (int rep_ = 0; rep_ < REPN(7); ++rep_) {
#if GATES_I8 && FFN_I8
            pg8::StaticOrder So; So.init((const bf16*)A8, D / 2, WL + WL_FI, D / 2, S, 2 * FF, F.G, (int)blockIdx.x);
            pg8::EpiSwiGLUI8 E{HIDb, SA8, CMf + (CW_CMF - CW_CM) + L * 2 * FF};
            pg8::gemm_phase<pg8::EpiSwiGLUI8, pg8::StaticOrder, I8_ALIGN, false, true>(F.lds + RING_OFF, F.wave, D / 2, D / 2, D / 2, So, E);
#else
            pg8::StaticOrder So; So.init(Hb, D, WL + WL_FI, D, S, 2 * FF, F.G, (int)blockIdx.x);
            pg8::EpiSwiGLU E{HIDb};
            pg8::gemm_phase<pg8::EpiSwiGLU, pg8::StaticOrder>(F.lds + RING_OFF, F.wave, D, D, D, So, E);
#endif
        }
        SEAM(pb + 7);
        if (PHEN(8) && IN(pb + 8)) for (int rep_ = 0; rep_ < REPN(8); ++rep_) {
#if FUSE_NORM
            { pg8::EpiNorm<0, 2> E{X, XBb, nullptr, args.in[5] + L * D, nullptr, XCHI(2), XCHI(2)};
              { pg8::PanelOrder So{HIDb, WL + WL_FO, FF, FF, F.G, (int)blockIdx.x, 0}; pg8::gemm_phase<pg8::EpiNorm<0, 2>, pg8::PanelOrder>(F.lds + RING_OFF, F.wave, FF, FF, FF, So, E); }
              { pg8::PanelOrder So{HIDb, WL + WL_FO, FF, FF, F.G, (int)blockIdx.x, 1}; pg8::gemm_phase<pg8::EpiNorm<0, 2>, pg8::PanelOrder>(F.lds + RING_OFF, F.wave, FF, FF, FF, So, E); } }
#else
#ifdef PANEL_PLAIN
            { pg8::EpiPlain E{Yb, D};
              { pg8::PanelOrder So{HIDb, WL + WL_FO, FF, FF, F.G, (int)blockIdx.x, 0}; pg8::gemm_phase<pg8::EpiPlain, pg8::PanelOrder>(F.lds + RING_OFF, F.wave, FF, FF, FF, So, E); }
              { pg8::PanelOrder So{HIDb, WL + WL_FO, FF, FF, F.G, (int)blockIdx.x, 1}; pg8::gemm_phase<pg8::EpiPlain, pg8::PanelOrder>(F.lds + RING_OFF, F.wave, FF, FF, FF, So, E); } }
#else
            { pg8::StaticOrder So; So.init(HIDb, FF, WL + WL_FO, FF, S, D, F.G, (int)blockIdx.x);
              pg8::EpiPlain E{Yb, D};
              pg8::gemm_phase<pg8::EpiPlain, pg8::StaticOrder>(F.lds + RING_OFF, F.wave, FF, FF, FF, So, E); }
#endif
#endif
            { pg8::StaticOrder So; So.init(PBb + (size_t)L * S * PLE, PLE, WL + WL_PLE, PLE, S, D, F.G, (int)blockIdx.x);
              pg8::EpiPlain E{P2b, D};
              pg8::gemm_phase<pg8::EpiPlain, pg8::StaticOrder>(F.lds + RING_OFF, F.wave, PLE, PLE, PLE, So, E); }
        }
        SEAM(pb + 8);
#if !FUSE_NORM
        if (PHEN(9) && IN(pb + 9)) { thin_phase<2>(F, nullptr, Yb, X, Hb, args.in[5] + L * D, nullptr, A8, SA8, !LEAN_X);
            if (REPN(9) > 1) thin_phase<4>(F, X, Yb, (float*)GTb, GTb + (size_t)S * D * 2, args.in[5] + L * D, args.in[5] + L * D); }
        SEAM(pb + 9);
#endif
        if (PHEN(10) && IN(pb + 10)) for (int rep_ = 0; rep_ < REPN(10); ++rep_) {
#if FUSE_NORM
            if (L + 1 < DEPTH) { pg8::EpiNorm<1, 1> E{X, Hb, P2b, args.in[6] + L * D, args.in[2] + (L + 1) * D, XCHI(3), XCHI(4)};
                { pg8::PanelOrder So{XBb, WL + WL_PG, D, D, F.G, (int)blockIdx.x, 0}; pg8::gemm_phase<pg8::EpiNorm<1, 1>, pg8::PanelOrder>(F.lds + RING_OFF, F.wave, D, D, D, So, E); }
                { pg8::PanelOrder So{XBb, WL + WL_PG, D, D, F.G, (int)blockIdx.x, 1}; pg8::gemm_phase<pg8::EpiNorm<1, 1>, pg8::PanelOrder>(F.lds + RING_OFF, F.wave, D, D, D, So, E); } }
            else { pg8::EpiNorm<1, 0> E{X, nullptr, P2b, args.in[6] + L * D, nullptr, XCHI(3), XCHI(3)};
                { pg8::PanelOrder So{XBb, WL + WL_PG, D, D, F.G, (int)blockIdx.x, 0}; pg8::gemm_phase<pg8::EpiNorm<1, 0>, pg8::PanelOrder>(F.lds + RING_OFF, F.wave, D, D, D, So, E); }
                { pg8::PanelOrder So{XBb, WL + WL_PG, D, D, F.G, (int)blockIdx.x, 1}; pg8::gemm_phase<pg8::EpiNorm<1, 0>, pg8::PanelOrder>(F.lds + RING_OFF, F.wave, D, D, D, So, E); } }
#else
#if GATES_I8
            pg8::EpiPleI8 E8{P2b, LEAN_X ? GTb : Yb, SA8, CMf + (L * 5 + 4) * D};
            pg8::StaticOrder So8; So8.init((const bf16*)A8, D / 2, WL + WL_PG, D / 2, S, D, F.G, (int)blockIdx.x);
            pg8::gemm_phase<pg8::EpiPleI8, pg8::StaticOrder, I8_ALIGN, false, true>(F.lds + RING_OFF, F.wave, D / 2, D / 2, D / 2, So8, E8);
#else
            pg8::EpiPle E{P2b, Yb};
#if GATES_FP8
            pg8::StaticOrder So; So.init((const bf16*)A8, D / 2, WL + WL_PG, D / 2, S, D, F.G, (int)blockIdx.x);
            pg8::gemm_phase<pg8::EpiPle, pg8::StaticOrder, true, true>(F.lds + RING_OFF, F.wave, D, D, D, So, E);
#else
            pg8::StaticOrder So; So.init(Hb, D, WL + WL_PG, D, S, D, F.G, (int)blockIdx.x);
            pg8::gemm_phase<pg8::EpiPle, pg8::StaticOrder>(F.lds + RING_OFF, F.wave, D, D, D, So, E);
#endif
#endif
#endif
        }
        SEAM(pb + 10);
#if !FUSE_NORM
        if (PHEN(11) && IN(pb + 11)) {
#if LEAN_X
            if (L + 1 < DEPTH) thin_phase<1, true>(F, nullptr, Yb, X, Hb, args.in[5] + L * D, args.in[2] + (L + 1) * D, A8, SA8, true, GTb, args.in[6] + L * D);
            else thin_phase<3, true>(F, nullptr, Yb, X, Hb, args.in[5] + L * D, nullptr, nullptr, nullptr, true, GTb, args.in[6] + L * D);
#else
            if (L + 1 < DEPTH) thin_phase<1>(F, nullptr, Yb, X, Hb, args.in[6] + L * D, args.in[2] + (L + 1) * D, A8, SA8);
            else thin_phase<3>(F, nullptr, Yb, X, Hb, args.in[6] + L * D, nullptr);
#endif
            if (REPN(11) > 1) thin_phase<4>(F, X, Yb, (float*)GTb, GTb + (size_t)S * D * 2, args.in[6] + L * D, args.in[6] + L * D);
        }
        SEAM(pb + 11);
#endif
    }
#undef IN
#undef SEAM
}
extern "C" void kernel_launch(void* const* d_in, const int* in_sizes, int n_in, void* d_out, int out_size, void* d_ws, size_t ws_size, hipStream_t stream) {
    static int grid = 0;
    if (grid == 0) {
        const size_t need = MK_DEBUG ? WS_DBG_END : WS_END4;
        if (n_in != 24 || in_sizes[0] != S * D || out_size != S * D || ws_size < need) {
            fprintf(stderr, "kernel_launch: built for 24 inputs, x and out of %d floats, >= %zu bytes of workspace; got n_in %d, in0 %d, out %d, ws %zu; nothing launched\n", S * D, need, n_in, n_in > 0 ? in_sizes[0] : -1, out_size, ws_size);
            grid = -1; return; }
        int dev = 0, cus = 0, per_cu = 0;
        if (hipGetDevice(&dev) != hipSuccess || hipDeviceGetAttribute(&cus, hipDeviceAttributeMultiprocessorCount, dev) != hipSuccess) { fprintf(stderr, "kernel_launch: hipGetDevice / hipDeviceGetAttribute failed\n"); grid = -1; return; }
        if (hipFuncSetAttribute((const void*)mk_fwd, hipFuncAttributeMaxDynamicSharedMemorySize, LDS_BYTES) != hipSuccess) { fprintf(stderr, "kernel_launch: hipFuncSetAttribute failed\n"); grid = -1; return; }
        if (hipOccupancyMaxActiveBlocksPerMultiprocessor(&per_cu, (const void*)mk_fwd, NWAVES * 64, LDS_BYTES) != hipSuccess || per_cu < 1)
            fprintf(stderr, "kernel_launch: note: the occupancy query reports %d workgroups per CU\n", per_cu);
        (void)hipGetLastError();
        grid = cus;
    }
    if (grid < 0) return;
    if (hipMemsetAsync((char*)d_ws + WS_CTL, 0, CTL_ZERO_BYTES, stream) != hipSuccess) { fprintf(stderr, "kernel_launch: hipMemsetAsync failed\n"); return; }
    Args a{};
    for (int i = 0; i < 24; ++i) a.in[i] = (const float*)d_in[i];
    a.out = (float*)d_out; a.ws = (unsigned char*)d_ws;
    for (int i = 0; i < DEPTH; ++i) a.lam_init[i] = (float)(0.8 - 0.6 * exp(-0.3 * (double)i));
#if MK_DEBUG
    for (int ph = 0; ph < NPHASES; ++ph) {
        a.ph_lo = ph; a.ph_hi = ph + 1; a.li = 0;
        dbg_pre(ph, a, stream);
        hipLaunchKernelGGL(mk_fwd, dim3(grid), dim3(NWAVES * 64), LDS_BYTES, stream, a);
        dbg_post(ph, a, stream);
    }
    dbg_final(a, stream);
#else
    a.ph_lo = 0; a.ph_hi = NPHASES; a.li = 0;
    hipLaunchKernelGGL(mk_fwd, dim3(grid), dim3(NWAVES * 64), LDS_BYTES, stream, a);
#endif
    const hipError_t le = hipPeekAtLastError();
    if (le != hipSuccess) fprintf(stderr, "kernel_launch: launch failed: %s (grid %d)\n", hipGetErrorName(le), grid);
}
```

```cpp
#include <hip/hip_runtime.h>
#include <cstdio>
#include <cstdint>
#include <cmath>

#ifndef MK_DEBUG
#define MK_DEBUG 0
#endif

#ifndef ATT_NEGM
#define ATT_NEGM 1
#endif
#ifndef ATT_HS
#define ATT_HS 0
#endif
#ifndef GATES_I8
#define GATES_I8 1
#endif
#ifndef FFN_I8
#define FFN_I8 1
#endif
#ifndef GATES_FP8
#define GATES_FP8 0
#endif
#define GAS __attribute__((address_space(1)))
#define LAS __attribute__((address_space(3)))
typedef unsigned short bf16;
typedef unsigned v4u __attribute__((ext_vector_type(4)));
typedef unsigned v2u __attribute__((ext_vector_type(2)));
typedef float f32x4 __attribute__((ext_vector_type(4)));
typedef float f32x2 __attribute__((ext_vector_type(2)));
typedef short bf16x8 __attribute__((ext_vector_type(8)));
typedef short s16x4 __attribute__((ext_vector_type(4)));
typedef float f32x16 __attribute__((ext_vector_type(16)));
typedef GAS unsigned gu32;
#define RLX_AGENT __ATOMIC_RELAXED, __HIP_MEMORY_SCOPE_AGENT
#define LDS_WAIT() asm volatile("s_waitcnt lgkmcnt(0)" ::: "memory")
#define VM_WAIT() asm volatile("s_waitcnt vmcnt(0)" ::: "memory")

constexpr int S = 16384, D = 2048, DEPTH = 4, FF = 5632, PLE = 256;
constexpr int ZC = 4672, ZP = 4864, NG = 8192, N1 = ZP + NG;
constexpr int Z_CQ = 0, Z_CKV = 512, Z_KR = 1024, Z_DQ = 1088, Z_DK = 1600, Z_DV = 2112, Z_SQ = 2624, Z_SK = 3136, Z_SV = 3392, Z_AQ = 3648, Z_AK = 4160, Z_AV = 4416;
constexpr int QM_P = 768, KVM_P = 1024;
constexpr float RMS_EPS = 1e-6f;
constexpr float LOG2E = 1.4426950408889634f;

constexpr size_t MiB = 1u << 20;
constexpr size_t WS_CTL = 0, CTL_ZERO_BYTES = 1 * MiB;
constexpr size_t WS_TAB64 = 1 * MiB;
constexpr size_t WS_TAB128 = 5 * MiB;
constexpr size_t WS_W = 13 * MiB;
constexpr size_t WL_W1 = 0;
constexpr size_t WL_UQKV = WL_W1 + (size_t)N1 * D;
constexpr size_t WL_BR = WL_UQKV + (size_t)1792 * 512;
constexpr size_t WL_WO = WL_BR + (size_t)4 * D * 512;
constexpr size_t WL_FI = WL_WO + (size_t)D * D;
constexpr size_t WL_FO = WL_FI + (size_t)2 * FF * D;
constexpr size_t WL_PLE = WL_FO + (size_t)D * FF;
constexpr size_t WL_PG = WL_PLE + (size_t)D * PLE;
constexpr size_t WL_ELEMS = WL_PG + (size_t)D * D;
constexpr size_t WL_BYTES = WL_ELEMS * 2;
constexpr size_t WS_PB = WS_W + ((4 * WL_BYTES + MiB - 1) / MiB) * MiB;
constexpr size_t WS_H = WS_PB + 32 * MiB;
constexpr size_t WS_Z = WS_H + 64 * MiB;
constexpr size_t WS_GT = WS_Z + 152 * MiB;
constexpr size_t WS_QM = WS_GT + 256 * MiB;
constexpr size_t WS_KVM = WS_QM + 24 * MiB;
constexpr size_t WS_BR = WS_KVM + 32 * MiB;
constexpr size_t WS_END = WS_BR + 64 * MiB;
constexpr size_t WS_XCH = WS_END;
constexpr size_t WS_END2 = WS_XCH + 12 * MiB;
constexpr size_t WS_A8 = WS_END2;
constexpr size_t WS_END3 = WS_A8 + 32 * MiB;
constexpr size_t WS_SA = WS_END3;
constexpr size_t WS_END4 = WS_SA + 1 * MiB;
constexpr size_t WS_DBG_ZCOPY = WS_QM;
constexpr size_t WS_DBG_END = WS_END4;

constexpr int CW_TMO = 0, CW_CODE = 1;
constexpr int CW_ERR = 64;
constexpr int CW_CM = 131072;
constexpr int CW_CMF = CW_CM + DEPTH * 5 * 2048;
constexpr int CW_KN2 = 230400;
constexpr int CW_KN = 230000;
#ifndef ATT_FASTDUP
#define ATT_FASTDUP 1
#endif
#ifndef ATT_QKFIN
#define ATT_QKFIN 1
#endif
#ifndef QKFSEL
#define QKFSEL (!ROPEK)
#endif
#ifndef ATT_ILV
#define ATT_ILV 1
#endif
#ifndef DUPSEL
#define DUPSEL (!ROPEK)
#endif
#ifndef ATT_LMFMA
#define ATT_LMFMA 0
#endif
#ifndef LMSEL
#define LMSEL (NQ == 4)
#endif
#ifndef ATT_SPRIO
#define ATT_SPRIO 1
#endif
#ifndef ATT_ILV3
#define ATT_ILV3 0
#endif
#ifndef ATT_ILV2
#define ATT_ILV2 0
#endif
#ifndef ATT_NOSWAP
#define ATT_NOSWAP 1
#endif
#ifndef ATT_LPART
#define ATT_LPART 0
#endif
#ifndef ATT_FASTREF
#define ATT_FASTREF 1
#endif
constexpr int CW_BAR = 4096;
constexpr int CW_SEAM = 16384, SEAM_BANK = 64 * 64;

constexpr int NWAVES = 8;
constexpr int RING_OFF = 0, RING_BYTES = 131072;
constexpr int LDSCTL_OFF = 143360, MISC_OFF = LDSCTL_OFF + 320;
constexpr int LDS_BYTES = 147456;

__device__ __forceinline__ unsigned f2bf(float f) { unsigned u = __builtin_bit_cast(unsigned, f); return (u + 0x7fffu + ((u >> 16) & 1u)) >> 16; }
__device__ __forceinline__ unsigned pk2(float lo, float hi) { return f2bf(lo) | (f2bf(hi) << 16); }
__device__ __forceinline__ float bf2f(unsigned b) { return __builtin_bit_cast(float, b << 16); }
__device__ __forceinline__ float bflo(unsigned w) { return __builtin_bit_cast(float, w << 16); }
__device__ __forceinline__ float bfhi(unsigned w) { return __builtin_bit_cast(float, w & 0xffff0000u); }
typedef __bf16 bf16x2_t __attribute__((ext_vector_type(2)));
__device__ __forceinline__ unsigned cvt_pk_bf16(float lo, float hi) { const f32x2 v = {lo, hi}; const bf16x2_t b = __builtin_convertvector(v, bf16x2_t); return __builtin_bit_cast(unsigned, b); }
template <int M> __device__ __forceinline__ float shx(float v) { static_assert(M >= 1 && M <= 16, "shx: xor mask 1..16");
    return __builtin_bit_cast(float, __builtin_amdgcn_ds_swizzle(__builtin_bit_cast(int, v), 0x1F | (M << 10))); }
__device__ __forceinline__ float add32(float v) { auto rr = __builtin_amdgcn_permlane32_swap(__float_as_uint(v), __float_as_uint(v), false, false);
    return __uint_as_float(rr[0]) + __uint_as_float(rr[1]); }
__device__ __forceinline__ float sum32(float v) { v += shx<1>(v); v += shx<2>(v); v += shx<4>(v); v += shx<8>(v); v += shx<16>(v); return v; }
__device__ __forceinline__ float wave_sum(float v) { return add32(sum32(v)); }
__device__ __forceinline__ float wave_max(float v) { v = fmaxf(v, shx<1>(v)); v = fmaxf(v, shx<2>(v)); v = fmaxf(v, shx<4>(v)); v = fmaxf(v, shx<8>(v)); v = fmaxf(v, shx<16>(v));
    auto rr = __builtin_amdgcn_permlane32_swap(__float_as_uint(v), __float_as_uint(v), false, false); return fmaxf(__uint_as_float(rr[0]), __uint_as_float(rr[1])); }
__device__ __forceinline__ unsigned pk4_i8(float a, float b, float c, float d) { const int ia = (int)rintf(a), ib = (int)rintf(b), ic = (int)rintf(c), id = (int)rintf(d);
    return ((unsigned)ia & 0xffu) | (((unsigned)ib & 0xffu) << 8) | (((unsigned)ic & 0xffu) << 16) | ((unsigned)id << 24); }
__device__ __forceinline__ int lane_id() { unsigned z = 0u; asm volatile("" : "+v"(z)); return (int)__builtin_amdgcn_mbcnt_hi(~0u, __builtin_amdgcn_mbcnt_lo(~0u, z)); }
__device__ __forceinline__ int opq_tid(int wave) { int t = wave * 64 + lane_id(); asm volatile("" : "+v"(t)); return t; }
__device__ __forceinline__ unsigned pk4_fp8(float a, float b, float c, float d) { unsigned w = 0u; w = __builtin_amdgcn_cvt_pk_fp8_f32(a, b, w, false); w = __builtin_amdgcn_cvt_pk_fp8_f32(c, d, w, true); return w; }
__device__ __forceinline__ float sigmoidf_(float v) { return __builtin_amdgcn_rcpf(1.0f + __builtin_amdgcn_exp2f(-v * LOG2E)); }

#define XB_TMO      128
#define XB_XCNT(j)  (256  + 64 * (j))
#define XB_XSUB(j)  (1280 + 64 * (j))
#define XB_XGEN(j)  (2304 + 64 * (j))
#define XB_TOP      3328
#define XB_TOPGEN   3392
#define XCD_BAR_WORDS 3456
#define XB_SPIN_CAP (1u << 18)

__device__ __forceinline__ unsigned xb_ld(unsigned* p)              { return __hip_atomic_load(p, __ATOMIC_RELAXED, __HIP_MEMORY_SCOPE_AGENT); }
__device__ __forceinline__ unsigned xb_add(unsigned* p, unsigned v) { return __hip_atomic_fetch_add(p, v, __ATOMIC_RELAXED, __HIP_MEMORY_SCOPE_AGENT); }
__device__ __forceinline__ unsigned xb_xcc_id() { return (unsigned)__builtin_amdgcn_s_getreg((3 << 11) | 20) & 0xFu; }
#define XB_SPIN(cond, bar) do { unsigned _sp = 0; while (cond) { __builtin_amdgcn_s_sleep(1); \
    if ((++_sp & 255u) == 0u) { if (xb_ld(&(bar)[XB_TMO])) break; if (_sp > XB_SPIN_CAP) { atomicAdd(&(bar)[XB_TMO], 1u); break; } } } } while (0)

struct XcdBarrier {
    unsigned* bar; unsigned x; int wave;
    volatile LAS unsigned* st;
};
__device__ __forceinline__ XcdBarrier xcd_barrier_post(unsigned* bar, volatile LAS unsigned* st, int wave) {
    XcdBarrier b; b.bar = bar; b.x = xb_xcc_id(); b.st = st; b.wave = wave;
    if (threadIdx.x == 0) (void)xb_add(&bar[XB_XCNT(b.x)], 1u);
    return b;
}
__device__ __forceinline__ void xcd_barrier_complete(unsigned* bar, unsigned x, unsigned& nloc, unsigned& nx) {
    const unsigned G = gridDim.x * gridDim.y * gridDim.z;
    unsigned sum, cnt, mine, sp = 0u;
    for (;;) {
        sum = 0u; cnt = 0u; mine = 0u;
#pragma unroll
        for (unsigned j = 0; j < 16; ++j) { const unsigned c = xb_ld(&bar[XB_XCNT(j)]); sum += c; cnt += (c > 0u) ? 1u : 0u; mine = (j == x) ? c : mine; }
        if (sum == G) break;
        __builtin_amdgcn_s_sleep(1);
        if ((++sp & 255u) == 0u) { if (xb_ld(&bar[XB_TMO])) break; if (sp > XB_SPIN_CAP) { atomicAdd(&bar[XB_TMO], 1u); break; } }
    }
    nloc = mine > 0u ? mine : 1u; nx = cnt > 0u ? cnt : 1u;
}
__device__ __forceinline__ void xcd_barrier(const XcdBarrier& b) {
    asm volatile("s_waitcnt vmcnt(0)" ::: "memory");
    __syncthreads();
    if (b.wave == 0 && lane_id() == 0) {
        unsigned* bar = b.bar;
        __builtin_amdgcn_s_waitcnt(0);
        unsigned nloc = b.st[0], nx = b.st[1];
        if (nloc == 0u) { xcd_barrier_complete(bar, b.x, nloc, nx); b.st[0] = nloc; b.st[1] = nx; }
        const unsigned old = xb_add(&bar[XB_XSUB(b.x)], 1u);
        const unsigned gen = old / nloc;
        if (old + 1u == (gen + 1u) * nloc) {
            __builtin_amdgcn_fence(__ATOMIC_RELEASE, "agent");
            asm volatile("s_waitcnt vmcnt(0)" ::: "memory");
            const unsigned og = xb_add(&bar[XB_TOP], 1u);
            const unsigned tg = og / nx;
            if (og + 1u == (tg + 1u) * nx) xb_add(&bar[XB_TOPGEN], 1u);
            else XB_SPIN(xb_ld(&bar[XB_TOPGEN]) == tg, bar);
            __builtin_amdgcn_fence(__ATOMIC_ACQUIRE, "agent");
            xb_add(&bar[XB_XGEN(b.x)], 1u);
            asm volatile("s_waitcnt vmcnt(0)" ::: "memory");
        } else {
            XB_SPIN(xb_ld(&bar[XB_XGEN(b.x)]) == gen, bar);
            __builtin_amdgcn_fence(__ATOMIC_ACQUIRE, "agent");
            asm volatile("s_waitcnt vmcnt(0)" ::: "memory");
        }
    }
    __syncthreads();
}
namespace pg8 {
#define PG8_LAS __attribute__((address_space(3)))
typedef unsigned short bf16_t;
constexpr int BM = 256, BK = 64, HALF = 128, HTB = HALF * BK * 2  , STAGE_BYTES = 8 * HTB, NXCD = 8, WGM = 8;

__host__ __device__ __forceinline__ int lds_byte(int r, int c) { const int st = (r >> 4) * 2 + (c >> 5), rr = r & 15, cc = c & 31, ob = rr * 64 + cc * 2; return st * 1024 + (ob ^ (((ob >> 9) & 1) << 5)); }
__host__ __device__ __forceinline__ void stage_rc(int b, int& R, int& C) { const int st = b / 1024, sb = b % 1024, swz = sb ^ (((sb >> 9) & 1) << 5); R = (st >> 1) * 16 + swz / 64; C = (st & 1) * 32 + (swz % 64) / 2; }
__host__ __device__ __forceinline__ int perm32(int rho) { const int n = rho >> 4, i = rho & 15; return 8 * (i >> 2) + 4 * n + (i & 3); }

typedef int v8i_t __attribute__((ext_vector_type(8)));
typedef int v4i_t __attribute__((ext_vector_type(4)));
__device__ __forceinline__ v8i_t cat8(bf16x8 lo, bf16x8 hi) { const v4i_t a = __builtin_bit_cast(v4i_t, lo), b = __builtin_bit_cast(v4i_t, hi); return __builtin_shufflevector(a, b, 0, 1, 2, 3, 4, 5, 6, 7); }
__device__ __forceinline__ const char* uptr(const char* p) { const unsigned long long v = (unsigned long long)p; const unsigned lo = (unsigned)__builtin_amdgcn_readfirstlane((int)(unsigned)v), hi = (unsigned)__builtin_amdgcn_readfirstlane((int)(unsigned)(v >> 32)); return (const char*)(((unsigned long long)hi << 32) | lo); }
__device__ __forceinline__ void mx_mfma(f32x4& acc, const v8i_t a, const v8i_t b, const int sa, const int sb) {
    asm volatile("v_mfma_scale_f32_16x16x128_f8f6f4 %0, %1, %2, %0, %3, %4 op_sel_hi:[0,0,0]" : "+v"(acc) : "v"(a), "v"(b), "v"(sa), "v"(sb)); }
__device__ __forceinline__ void i8_mfma(f32x4& acc, const bf16x8 a, const bf16x8 b) {
    asm volatile("v_mfma_i32_16x16x64_i8 %0, %1, %2, %0" : "+v"(acc) : "v"(a), "v"(b)); }
__device__ __forceinline__ f32x4 i2f4(const f32x4 a) { const v4i_t i = __builtin_bit_cast(v4i_t, a); return (f32x4){(float)i[0], (float)i[1], (float)i[2], (float)i[3]}; }
struct Unit { int pm, pn, j; };

__device__ __forceinline__ void tile_of(int L, int nM, int nN, int& pm, int& pn) {
    const int nwg = nM * nN; int wgid = L;
    { const int q = nwg / NXCD, r = nwg % NXCD, xcd = wgid % NXCD, off = wgid / NXCD; wgid = (xcd < r ? xcd * (q + 1) : r * (q + 1) + (xcd - r) * q) + off; }
    const int nig = WGM * nN, gid = wgid / nig, fm = gid * WGM, gsz = (nM - fm) < WGM ? (nM - fm) : WGM;
    pm = fm + ((wgid % nig) % gsz); pn = (wgid % nig) / gsz;
}
struct StaticOrder {
    static constexpr bool SINGLE = false;
    const bf16_t* A; const bf16_t* Bt; int lda, ldb; int nM, nN, nwg, G, c;
    __device__ void init(const bf16_t* A_, int lda_, const bf16_t* Bt_, int ldb_, int M, int N, int G_, int c_) { A = A_; Bt = Bt_; lda = lda_; ldb = ldb_; nM = M / BM; nN = N / BM; nwg = nM * nN; G = G_; c = c_; }
    __device__ __forceinline__ bool next(int i, Unit& u) const { const long L = (long)i * G + c; if (L >= nwg) return false; tile_of((int)L, nM, nN, u.pm, u.pn); u.j = 0; return true; }
    __device__ __forceinline__ const char* pa(const Unit& u) const { return (const char*)(A + (size_t)u.pm * BM * lda); }
    __device__ __forceinline__ const char* pb(const Unit& u) const { return (const char*)(Bt + (size_t)u.pn * BM * ldb); }
    __device__ __forceinline__ void a_ready(const Unit&) const {}
    __device__ __forceinline__ void done(const Unit&) const {}
};
struct OrderG2 {
    static constexpr bool SINGLE = false;
    const bf16_t* A; const bf16_t* Bt; int G, c;
    __device__ __forceinline__ bool next(int i, Unit& u) const { const long L = (long)i * G + c; if (L >= 64 * 7) return false; tile_of((int)L, 64, 7, u.pm, u.pn); u.j = 0; return true; }
    __device__ __forceinline__ const char* pa(const Unit& u) const { return (const char*)(A + (size_t)u.pm * BM * ZP + (u.pn < 3 ? 0 : 512)); }
    __device__ __forceinline__ const char* pb(const Unit& u) const { return (const char*)(Bt + (size_t)u.pn * BM * 512); }
    __device__ __forceinline__ void a_ready(const Unit&) const {}
    __device__ __forceinline__ void done(const Unit&) const {}
};
struct OrderG3 {
    static constexpr bool SINGLE = false;
    const bf16_t* A; const bf16_t* Bt; int G, c;
    __device__ __forceinline__ bool next(int i, Unit& u) const { const long t = (long)(i >> 2) * G + c; if (t >= 512) return false; tile_of((int)t, 64, 8, u.pm, u.pn); u.j = i & 3; return true; }
    __device__ __forceinline__ const char* pa(const Unit& u) const { return (const char*)(A + (size_t)u.pm * BM * D + u.j * 512); }
    __device__ __forceinline__ const char* pb(const Unit& u) const { return (const char*)(Bt + (size_t)u.j * D * 512 + (size_t)u.pn * BM * 512); }
    __device__ __forceinline__ void a_ready(const Unit&) const {}
    __device__ __forceinline__ void done(const Unit&) const {}
};

__device__ __forceinline__ v4u pack8(const f32x4 v0, const f32x4 v1) { v4u w; w.x = cvt_pk_bf16(v0[0], v0[1]); w.y = cvt_pk_bf16(v0[2], v0[3]); w.z = cvt_pk_bf16(v1[0], v1[1]); w.w = cvt_pk_bf16(v1[2], v1[3]); return w; }
__device__ __forceinline__ f32x4 sig4(const f32x4 v) { f32x4 r; r[0] = sigmoidf_(v[0]); r[1] = sigmoidf_(v[1]); r[2] = sigmoidf_(v[2]); r[3] = sigmoidf_(v[3]); return r; }
__device__ __forceinline__ void unpack8(const v4u w, f32x4& a, f32x4& b) { a[0] = bflo(w.x); a[1] = bfhi(w.x); a[2] = bflo(w.y); a[3] = bfhi(w.y); b[0] = bflo(w.z); b[1] = bfhi(w.z); b[2] = bflo(w.w); b[3] = bfhi(w.w); }

struct EpiG1 {
    static constexpr bool XCHG = false;
    bf16_t* Z; bf16_t* GT;
    __device__ __forceinline__ void operator()(const f32x4 (&acc)[2][2][4][2], const Unit& u, int wr, int wc, int fr, int fq) const {
        const int row0 = u.pm * BM + wr * 64 + fr, cw = wc * 32 + 8 * fq;
        if (u.pn < 19) {
            bf16_t* base = Z + u.pn * BM + cw;
#pragma unroll
            for (int ai = 0; ai < 2; ++ai)
#pragma unroll
                for (int m = 0; m < 4; ++m) { bf16_t* rowp = base + (size_t)(row0 + ai * HALF + m * 16) * ZP;
#pragma unroll
                    for (int bj = 0; bj < 2; ++bj) *(v4u*)(rowp + bj * HALF) = pack8(acc[ai][bj][m][0], acc[ai][bj][m][1]); }
        } else {
            bf16_t* base = GT + (u.pn - 19) * BM + cw;
#pragma unroll
            for (int ai = 0; ai < 2; ++ai)
#pragma unroll
                for (int m = 0; m < 4; ++m) { bf16_t* rowp = base + (size_t)(row0 + ai * HALF + m * 16) * NG;
#pragma unroll
                    for (int bj = 0; bj < 2; ++bj) *(v4u*)(rowp + bj * HALF) = pack8(sig4(acc[ai][bj][m][0]), sig4(acc[ai][bj][m][1])); }
        }
    }
};
struct EpiGate {
    static constexpr bool XCHG = false;
    bf16_t* GT;
    __device__ __forceinline__ void operator()(const f32x4 (&acc)[2][2][4][2], const Unit& u, int wr, int wc, int fr, int fq) const {
        const int row0 = u.pm * BM + wr * 64 + fr; bf16_t* base = GT + u.pn * BM + wc * 32 + 8 * fq;
#pragma unroll
        for (int ai = 0; ai < 2; ++ai)
#pragma unroll
            for (int m = 0; m < 4; ++m) { bf16_t* rowp = base + (size_t)(row0 + ai * HALF + m * 16) * NG;
#pragma unroll
                for (int bj = 0; bj < 2; ++bj) *(v4u*)(rowp + bj * HALF) = pack8(sig4(acc[ai][bj][m][0]), sig4(acc[ai][bj][m][1])); }
    }
};
struct EpiGateI8 {
    static constexpr bool XCHG = false;
    bf16_t* GT; const float* SA; const float* CM;
    __device__ __forceinline__ void operator()(const f32x4 (&acc)[2][2][4][2], const Unit& u, int wr, int wc, int fr, int fq) const {
        const int row0 = u.pm * BM + wr * 64 + fr, c0 = u.pn * BM + wc * 32 + 8 * fq; bf16_t* base = GT + c0;
        f32x4 sw[2][2];
#pragma unroll
        for (int bj = 0; bj < 2; ++bj) { sw[bj][0] = *(const f32x4*)(CM + c0 + bj * HALF) * (1.0f / 127.0f); sw[bj][1] = *(const f32x4*)(CM + c0 + bj * HALF + 4) * (1.0f / 127.0f); }
#pragma unroll
        for (int ai = 0; ai < 2; ++ai)
#pragma unroll
            for (int m = 0; m < 4; ++m) { const int row = row0 + ai * HALF + m * 16; const float sa = SA[row]; bf16_t* rowp = base + (size_t)row * NG;
#pragma unroll
                for (int bj = 0; bj < 2; ++bj) *(v4u*)(rowp + bj * HALF) = pack8(sig4(i2f4(acc[ai][bj][m][0]) * sw[bj][0] * sa), sig4(i2f4(acc[ai][bj][m][1]) * sw[bj][1] * sa)); }
    }
};
struct EpiPleI8 {
    static constexpr bool XCHG = false;
    const bf16_t* P2; bf16_t* O; const float* SA; const float* CM;
    __device__ __forceinline__ void operator()(const f32x4 (&acc)[2][2][4][2], const Unit& u, int wr, int wc, int fr, int fq) const {
        const int row0 = u.pm * BM + wr * 64 + fr; const int c0 = u.pn * BM + wc * 32 + 8 * fq;
        f32x4 sw[2][2];
#pragma unroll
        for (int bj = 0; bj < 2; ++bj) { sw[bj][0] = *(const f32x4*)(CM + c0 + bj * HALF) * (1.0f / 127.0f); sw[bj][1] = *(const f32x4*)(CM + c0 + bj * HALF + 4) * (1.0f / 127.0f); }
#pragma unroll
        for (int ai = 0; ai < 2; ++ai)
#pragma unroll
            for (int m = 0; m < 4; ++m) { const int row = row0 + ai * HALF + m * 16; const float sa = SA[row]; const size_t ro = (size_t)row * D + c0;
#pragma unroll
                for (int bj = 0; bj < 2; ++bj) { f32x4 p0, p1; unpack8(*(const v4u*)(P2 + ro + bj * HALF), p0, p1);
                    *(v4u*)(O + ro + bj * HALF) = pack8(sig4(i2f4(acc[ai][bj][m][0]) * sw[bj][0] * sa) * p0, sig4(i2f4(acc[ai][bj][m][1]) * sw[bj][1] * sa) * p1); }
                asm volatile("" ::: "memory"); }
    }
};
struct EpiSwiGLUI8 {
    static constexpr bool XCHG = false;
    bf16_t* Hd; const float* SA; const float* CM;
    __device__ __forceinline__ void operator()(const f32x4 (&acc)[2][2][4][2], const Unit& u, int wr, int wc, int fr, int fq) const {
        const int row0 = u.pm * BM + wr * 64 + fr; const int c0 = u.pn * HALF + wc * 32 + 8 * fq; bf16_t* base = Hd + c0;
        const f32x4 sg0 = *(const f32x4*)(CM + c0) * (1.0f / 127.0f), sg1 = *(const f32x4*)(CM + c0 + 4) * (1.0f / 127.0f);
        const f32x4 su0 = *(const f32x4*)(CM + FF + c0) * (1.0f / 127.0f), su1 = *(const f32x4*)(CM + FF + c0 + 4) * (1.0f / 127.0f);
#pragma unroll
        for (int ai = 0; ai < 2; ++ai)
#pragma unroll
            for (int m = 0; m < 4; ++m) { const int row = row0 + ai * HALF + m * 16; const float sa = SA[row]; bf16_t* rowp = base + (size_t)row * FF;
                const f32x4 g0 = i2f4(acc[ai][0][m][0]) * sg0 * sa, g1 = i2f4(acc[ai][0][m][1]) * sg1 * sa;
                const f32x4 v0 = g0 * sig4(g0) * (i2f4(acc[ai][1][m][0]) * su0 * sa), v1 = g1 * sig4(g1) * (i2f4(acc[ai][1][m][1]) * su1 * sa);
                *(v4u*)rowp = pack8(v0, v1); }
    }
};
struct EpiG2 {
    static constexpr bool XCHG = false;
    bf16_t* QM; bf16_t* KVM; unsigned* KN2;
    __device__ __forceinline__ void operator()(const f32x4 (&acc)[2][2][4][2], const Unit& u, int wr, int wc, int fr, int fq) const {
        const int row0 = u.pm * BM + wr * 64 + fr, cw = wc * 32 + 8 * fq;
        const int ldc = u.pn < 3 ? QM_P : KVM_P; bf16_t* base = (u.pn < 3 ? QM + u.pn * BM : KVM + (u.pn - 3) * BM) + cw;
        if (KN2 != nullptr && u.pn >= 3) {
            float mx = 0.f;
#pragma unroll
            for (int ai = 0; ai < 2; ++ai)
#pragma unroll
                for (int m = 0; m < 4; ++m) { const f32x4 a = acc[ai][0][m][0], b = acc[ai][0][m][1];
                    mx = fmaxf(mx, (a[0] * a[0] + a[1] * a[1]) + (a[2] * a[2] + a[3] * a[3]) + (b[0] * b[0] + b[1] * b[1]) + (b[2] * b[2] + b[3] * b[3])); }
            mx = fmaxf(mx, shx<1>(mx)); mx = fmaxf(mx, shx<2>(mx)); mx = fmaxf(mx, shx<4>(mx)); mx = fmaxf(mx, shx<8>(mx));
            if (fr == 0) atomicMax(KN2 + (u.pn - 3) * 16 + wc * 4 + fq, __float_as_uint(mx));
        }
#pragma unroll
        for (int ai = 0; ai < 2; ++ai)
#pragma unroll
            for (int m = 0; m < 4; ++m) { bf16_t* rowp = base + (size_t)(row0 + ai * HALF + m * 16) * ldc;
#pragma unroll
                for (int bj = 0; bj < 2; ++bj) *(v4u*)(rowp + bj * HALF) = pack8(acc[ai][bj][m][0], acc[ai][bj][m][1]); }
    }
};
struct EpiPlain {
    static constexpr bool XCHG = false;
    bf16_t* O; int ldc;
    __device__ __forceinline__ void operator()(const f32x4 (&acc)[2][2][4][2], const Unit& u, int wr, int wc, int fr, int fq) const {
        const int row0 = u.pm * BM + wr * 64 + fr; bf16_t* base = O + u.pn * BM + wc * 32 + 8 * fq;
#pragma unroll
        for (int ai = 0; ai < 2; ++ai)
#pragma unroll
            for (int m = 0; m < 4; ++m) { bf16_t* rowp = base + (size_t)(row0 + ai * HALF + m * 16) * ldc;
#pragma unroll
                for (int bj = 0; bj < 2; ++bj) *(v4u*)(rowp + bj * HALF) = pack8(acc[ai][bj][m][0], acc[ai][bj][m][1]); }
    }
};
struct EpiSwiGLU {
    static constexpr bool XCHG = false;
    bf16_t* Hd;
    __device__ __forceinline__ void operator()(const f32x4 (&acc)[2][2][4][2], const Unit& u, int wr, int wc, int fr, int fq) const {
        const int row0 = u.pm * BM + wr * 64 + fr; bf16_t* base = Hd + u.pn * HALF + wc * 32 + 8 * fq;
#pragma unroll
        for (int ai = 0; ai < 2; ++ai)
#pragma unroll
            for (int m = 0; m < 4; ++m) { bf16_t* rowp = base + (size_t)(row0 + ai * HALF + m * 16) * FF;
                const f32x4 g0 = acc[ai][0][m][0], g1 = acc[ai][0][m][1];
                const f32x4 v0 = g0 * sig4(g0) * acc[ai][1][m][0], v1 = g1 * sig4(g1) * acc[ai][1][m][1];
                *(v4u*)rowp = pack8(v0, v1); }
    }
};
struct EpiPle {
    static constexpr bool XCHG = false;
    const bf16_t* P2; bf16_t* O;
    __device__ __forceinline__ void operator()(const f32x4 (&acc)[2][2][4][2], const Unit& u, int wr, int wc, int fr, int fq) const {
        const int row0 = u.pm * BM + wr * 64 + fr; const int c0 = u.pn * BM + wc * 32 + 8 * fq;
#pragma unroll
        for (int ai = 0; ai < 2; ++ai)
#pragma unroll
            for (int m = 0; m < 4; ++m) { const size_t ro = (size_t)(row0 + ai * HALF + m * 16) * D + c0;
#pragma unroll
                for (int bj = 0; bj < 2; ++bj) { f32x4 p0, p1; unpack8(*(const v4u*)(P2 + ro + bj * HALF), p0, p1);
                    *(v4u*)(O + ro + bj * HALF) = pack8(sig4(acc[ai][bj][m][0]) * p0, sig4(acc[ai][bj][m][1]) * p1); }
                asm volatile("" ::: "memory"); }
    }
};
struct EpiG3 {
    static constexpr bool XCHG = false;
    const bf16_t* GT; bf16_t* MF; bf16_t* MG;
    __device__ __forceinline__ void operator()(const f32x4 (&acc)[2][2][4][2], const Unit& u, int wr, int wc, int fr, int fq) const {
        const int row0 = u.pm * BM + wr * 64 + fr; const int c0 = u.pn * BM + wc * 32 + 8 * fq; const int j = u.j;
        bf16_t* const dst = (j < 3) ? MF : MG;
#pragma unroll
        for (int ai = 0; ai < 2; ++ai)
#pragma unroll
            for (int m = 0; m < 4; ++m) { const size_t row = (size_t)(row0 + ai * HALF + m * 16);
#pragma unroll
                for (int bj = 0; bj < 2; ++bj) { const int c = c0 + bj * HALF;
                    f32x4 g0, g1; unpack8(*(const v4u*)(GT + row * NG + j * D + c), g0, g1);
                    f32x4 v0 = g0 * acc[ai][bj][m][0], v1 = g1 * acc[ai][bj][m][1];
                    if (j > 0) { f32x4 p0, p1; unpack8(*(const v4u*)(MF + row * D + c), p0, p1); v0 += p0; v1 += p1; }
                    *(v4u*)(dst + row * D + c) = pack8(v0, v1); }
                asm volatile("" ::: "memory"); }
    }
};


struct PanelOrder {
    static constexpr bool SINGLE = true;
    const bf16_t* A; const bf16_t* Bt; int lda, ldb, G, c, round;
    __device__ __forceinline__ bool next(int i, Unit& u) const { if (i >= 1 || G != 256) return false; const int k = c >> 3; u.pm = round * 32 + (c & 7) * 4 + (k >> 3); u.pn = k & 7; u.j = round; return true; }
    __device__ __forceinline__ const char* pa(const Unit& u) const { return (const char*)(A + (size_t)u.pm * BM * lda); }
    __device__ __forceinline__ const char* pb(const Unit& u) const { return (const char*)(Bt + (size_t)u.pn * BM * ldb); }
    __device__ __forceinline__ void a_ready(const Unit&) const {}
    __device__ __forceinline__ void done(const Unit&) const {}
};
constexpr int XCH_LDS_OFF = 131072 + 1024;
struct RmsXchg {
    float* xbuf;
    unsigned* cnt;
    unsigned* tmo;
    __device__ __forceinline__ void run(const f32x4 (&v)[2][2][4][2], const Unit& u, int wr, int wc, int fr, int fq, PG8_LAS unsigned char* lds, int wid, int lane) const {
        PG8_LAS float* P = (PG8_LAS float*)(lds + XCH_LDS_OFF);
        PG8_LAS float* Sx = (PG8_LAS float*)(lds + XCH_LDS_OFF + 4096);
        PG8_LAS unsigned* flag = (PG8_LAS unsigned*)(lds + XCH_LDS_OFF + 4096 + 1024);
#pragma unroll
        for (int ai = 0; ai < 2; ++ai)
#pragma unroll
            for (int m = 0; m < 4; ++m) { float s = 0.f;
#pragma unroll
                for (int bj = 0; bj < 2; ++bj)
#pragma unroll
                    for (int n = 0; n < 2; ++n) { const f32x4 x = v[ai][bj][m][n]; s += (x[0] * x[0] + x[1] * x[1]) + (x[2] * x[2] + x[3] * x[3]); }
                s += shx<16>(s); s = add32(s);
                if (fq == 0) P[(ai * HALF + wr * 64 + m * 16 + fr) * 4 + wc] = s; }
        asm volatile("s_waitcnt lgkmcnt(0)" ::: "memory"); __builtin_amdgcn_s_barrier(); asm volatile("" ::: "memory");
        const int row = wid * 32 + (lane & 31);
        if (lane < 32) { const float t = (P[row * 4 + 0] + P[row * 4 + 1]) + (P[row * 4 + 2] + P[row * 4 + 3]);
            __hip_atomic_store(xbuf + ((size_t)u.pm * BM + row) * 8 + u.pn, t, __ATOMIC_RELAXED, __HIP_MEMORY_SCOPE_AGENT); }
        asm volatile("s_waitcnt vmcnt(0)" ::: "memory");
        if (lane == 0) __hip_atomic_fetch_add(cnt + 64 * u.pm, 1u, __ATOMIC_RELAXED, __HIP_MEMORY_SCOPE_AGENT);
        if (wid == 0) {
            const unsigned long long t0 = __builtin_amdgcn_s_memrealtime(); unsigned polls = 0;
            for (;;) {
                if ((unsigned)__builtin_amdgcn_readfirstlane(__hip_atomic_load(cnt + 64 * u.pm, __ATOMIC_RELAXED, __HIP_MEMORY_SCOPE_AGENT)) >= 64u) break;
                if ((++polls & 63u) == 0u) { if (__builtin_amdgcn_readfirstlane(__hip_atomic_load(tmo, __ATOMIC_RELAXED, __HIP_MEMORY_SCOPE_AGENT)) != 0u) break;
                    if (__builtin_amdgcn_s_memrealtime() - t0 > 2000000ull) { if (lane == 0) __hip_atomic_store(tmo, 1u, __ATOMIC_RELAXED, __HIP_MEMORY_SCOPE_AGENT); break; } }
                __builtin_amdgcn_s_sleep(2);
            }
            __builtin_amdgcn_fence(__ATOMIC_ACQUIRE, "agent");
            if (lane == 0) flag[0] = 0u;
        }
        asm volatile("s_waitcnt vmcnt(0) lgkmcnt(0)" ::: "memory"); __builtin_amdgcn_s_barrier(); asm volatile("" ::: "memory");
        if (lane < 32) { const float* slot = xbuf + ((size_t)u.pm * BM + row) * 8; float t = 0.f;
#pragma unroll
            for (int q = 0; q < 8; ++q) t += __hip_atomic_load(slot + q, __ATOMIC_RELAXED, __HIP_MEMORY_SCOPE_AGENT);
            Sx[row] = 1.0f / sqrtf(t * (1.0f / 2048.0f) + 1e-6f); }
        asm volatile("s_waitcnt lgkmcnt(0)" ::: "memory"); __builtin_amdgcn_s_barrier(); asm volatile("" ::: "memory");
    }
};
template <int PRE, int POST> struct EpiNorm {
    static constexpr bool XCHG = true;
    float* X; bf16_t* Hout; const bf16_t* P2; const float* gpost; const float* gpre; RmsXchg st1, st2;
    __device__ __forceinline__ void fused(f32x4 (&acc)[2][2][4][2], const Unit& u, int wr, int wc, int fr, int fq, PG8_LAS unsigned char* lds, int wid, int lane) const {
        const PG8_LAS float* Sx = (const PG8_LAS float*)(lds + XCH_LDS_OFF + 4096);
        const int row0 = u.pm * BM + wr * 64 + fr, c0 = u.pn * BM + wc * 32 + 8 * fq;
        if constexpr (PRE == 1) {
#pragma unroll
            for (int ai = 0; ai < 2; ++ai)
#pragma unroll
                for (int m = 0; m < 4; ++m) { const size_t ro = (size_t)(row0 + ai * HALF + m * 16) * D + c0;
#pragma unroll
                    for (int bj = 0; bj < 2; ++bj) { f32x4 p0, p1; unpack8(*(const v4u*)(P2 + ro + bj * HALF), p0, p1);
                        acc[ai][bj][m][0] = sig4(acc[ai][bj][m][0]) * p0; acc[ai][bj][m][1] = sig4(acc[ai][bj][m][1]) * p1;
                        asm volatile("" : "+v"(acc[ai][bj][m][0]), "+v"(acc[ai][bj][m][1])); asm volatile("" ::: "memory"); }
                    asm volatile("" : "+v"(acc[ai][0][m][0]), "+v"(acc[ai][0][m][1]), "+v"(acc[ai][1][m][0]), "+v"(acc[ai][1][m][1])); asm volatile("" ::: "memory"); }
        }
        st1.run(acc, u, wr, wc, fr, fq, lds, wid, lane);
#pragma unroll
        for (int ai = 0; ai < 2; ++ai)
#pragma unroll
            for (int m = 0; m < 4; ++m) { const int r = ai * HALF + wr * 64 + m * 16 + fr; const float rs = Sx[r]; const size_t ro = (size_t)(u.pm * BM + r) * D + c0;
#pragma unroll
                for (int bj = 0; bj < 2; ++bj) { float* xp = X + ro + bj * HALF; const float* gp = gpost + c0 + bj * HALF;
                    const f32x4 x0 = *(const f32x4*)xp, x1 = *(const f32x4*)(xp + 4), g0 = *(const f32x4*)gp, g1 = *(const f32x4*)(gp + 4);
                    const f32x4 n0 = x0 + acc[ai][bj][m][0] * rs * g0, n1 = x1 + acc[ai][bj][m][1] * rs * g1;
                    *(f32x4*)xp = n0; *(f32x4*)(xp + 4) = n1; acc[ai][bj][m][0] = n0; acc[ai][bj][m][1] = n1;
                    if constexpr (POST == 2) *(v4u*)(Hout + ro + bj * HALF) = pack8(n0, n1);
                    asm volatile("" : "+v"(acc[ai][bj][m][0]), "+v"(acc[ai][bj][m][1])); asm volatile("" ::: "memory"); }
                asm volatile("" : "+v"(acc[ai][0][m][0]), "+v"(acc[ai][0][m][1]), "+v"(acc[ai][1][m][0]), "+v"(acc[ai][1][m][1])); asm volatile("" ::: "memory"); }
        if constexpr (POST == 1) {
            st2.run(acc, u, wr, wc, fr, fq, lds, wid, lane);
#pragma unroll
            for (int ai = 0; ai < 2; ++ai)
#pragma unroll
                for (int m = 0; m < 4; ++m) { const int r = ai * HALF + wr * 64 + m * 16 + fr; const float rs = Sx[r]; const size_t ro = (size_t)(u.pm * BM + r) * D + c0;
#pragma unroll
                    for (int bj = 0; bj < 2; ++bj) { const float* gp = gpre + c0 + bj * HALF; const f32x4 g0 = *(const f32x4*)gp, g1 = *(const f32x4*)(gp + 4);
                        *(v4u*)(Hout + ro + bj * HALF) = pack8(acc[ai][bj][m][0] * rs * g0, acc[ai][bj][m][1] * rs * g1); asm volatile("" ::: "memory"); }
                    }
        }
    }
};

template <class Epi, class Sched, bool ALIGN_EPI = true, bool FP8 = false, bool I8 = false>
__device__ __forceinline__ void gemm_phase(PG8_LAS unsigned char* lds, const int wv, const int K, const int lda, const int ldb, const Sched& S, const Epi& E) {
    const int tid = opq_tid(wv), wid = __builtin_amdgcn_readfirstlane(tid >> 6), lane = tid & 63, wr = wid >> 2, wc = wid & 3, fr = lane & 15, fq = lane >> 4;
    const int nt = FP8 ? K / 128 : K / BK;
    unsigned voffA[2], voffB[2];
#pragma unroll
    for (int i = 0; i < 2; ++i) { int R, C; stage_rc(tid * 16 + i * 8192, R, C); const int Rb = (R & ~31) + perm32(R & 31);
        if constexpr (FP8) { const int p_ = C >> 3, g_ = (p_ < 4) ? 2 * p_ : 2 * (p_ - 4) + 1; voffA[i] = (unsigned)(R * lda + g_ * 16); voffB[i] = (unsigned)(Rb * ldb + g_ * 16); }
        else { voffA[i] = (unsigned)(R * lda + C) * 2u; voffB[i] = (unsigned)(Rb * ldb + C) * 2u; } }
    const size_t kstep = (size_t)(BK * 2);
    const size_t hstepA = (size_t)HALF * lda * (FP8 ? 1 : 2), hstepB = (size_t)HALF * ldb * (FP8 ? 1 : 2);
    const unsigned ldsw = (unsigned)wid * 1024u;
    const int aoff = lds_byte(wr * 64 + fr, fq * 8), boff = lds_byte(wc * 32 + fr, fq * 8);
#define PG8_SA(b, h) (((b) * 2 + (h)) * HTB)
#define PG8_SB(b, h) ((4 + (b) * 2 + (h)) * HTB)
#define PG8_STAGE(bufoff, gbase, voff) do { const char* gb_ = uptr((const char*)(gbase)); _Pragma("unroll") for (int _i = 0; _i < 2; ++_i) \
        __builtin_amdgcn_global_load_lds((const unsigned*)(gb_ + (voff)[_i]), (PG8_LAS unsigned*)(lds + (bufoff) + ldsw + _i * 8192), 16, 0, 0); } while (0)
#define PG8_LDA(dst, b, h) do { _Pragma("unroll") for (int m = 0; m < 4; ++m) _Pragma("unroll") for (int k = 0; k < 2; ++k) dst[m][k] = *(const PG8_LAS bf16x8*)(lds + PG8_SA(b, h) + aoff + m * 2048 + k * 1024); } while (0)
#define PG8_LDB(dst, b, h) do { _Pragma("unroll") for (int n = 0; n < 2; ++n) _Pragma("unroll") for (int k = 0; k < 2; ++k) dst[n][k] = *(const PG8_LAS bf16x8*)(lds + PG8_SB(b, h) + boff + n * 2048 + k * 1024); } while (0)
#define PG8_MMA(ai, bj, At, Bt) do { __builtin_amdgcn_s_setprio(1); \
        if constexpr (FP8) { _Pragma("unroll") for (int m = 0; m < 4; ++m) _Pragma("unroll") for (int n = 0; n < 2; ++n) \
            mx_mfma(acc[ai][bj][m][n], cat8(Bt[n][0], Bt[n][1]), cat8(At[m][0], At[m][1]), sc_w, sc_a); } \
        else if constexpr (I8) { _Pragma("unroll") for (int m = 0; m < 4; ++m) _Pragma("unroll") for (int n = 0; n < 2; ++n) _Pragma("unroll") for (int k = 0; k < 2; ++k) \
            i8_mfma(acc[ai][bj][m][n], Bt[n][k], At[m][k]); } \
        else { _Pragma("unroll") for (int m = 0; m < 4; ++m) _Pragma("unroll") for (int n = 0; n < 2; ++n) _Pragma("unroll") for (int k = 0; k < 2; ++k) \
            acc[ai][bj][m][n] = __builtin_amdgcn_mfma_f32_16x16x32_bf16(Bt[n][k], At[m][k], acc[ai][bj][m][n], 0, 0, 0); } \
        __builtin_amdgcn_s_setprio(0); } while (0)
#define PG8_WAIT_V(n) asm volatile("s_waitcnt vmcnt(" #n ")" ::: "memory")
#define PG8_WAIT_L(n) asm volatile("s_waitcnt lgkmcnt(" #n ")" ::: "memory")
#define PG8_BAR __builtin_amdgcn_s_barrier()
#define PG8_SCHED __builtin_amdgcn_sched_barrier(0)
    Unit cur, nxt; int ui = 0;
    if (!S.next(0, cur)) return;
    f32x4 acc[2][2][4][2];
#pragma unroll
    for (int a = 0; a < 2; ++a)
#pragma unroll
        for (int b = 0; b < 2; ++b)
#pragma unroll
            for (int m = 0; m < 4; ++m)
#pragma unroll
                for (int n = 0; n < 2; ++n) acc[a][b][m][n] = (f32x4){0.f, 0.f, 0.f, 0.f};
    bf16x8 At[4][2], B0[2][2], B1[2][2];
    int sc_w = 0x79797979, sc_a = 0x7f7f7f7f; if constexpr (FP8) asm volatile("" : "+v"(sc_w), "+v"(sc_a));
    const char* cA = S.pa(cur); const char* cB = S.pb(cur);
    S.a_ready(cur);
    PG8_STAGE(PG8_SB(0, 0), cB, voffB); PG8_STAGE(PG8_SB(0, 1), cB + hstepB, voffB); PG8_STAGE(PG8_SA(0, 0), cA, voffA); PG8_STAGE(PG8_SA(0, 1), cA + hstepA, voffA);
    if (wr == 1) PG8_BAR;
    PG8_WAIT_V(2); PG8_BAR;
    PG8_STAGE(PG8_SB(1, 0), cB + kstep, voffB); PG8_STAGE(PG8_SA(1, 0), cA + kstep, voffA); PG8_STAGE(PG8_SB(1, 1), cB + hstepB + kstep, voffB);
    PG8_WAIT_V(6); PG8_BAR;
    for (;;) {
        const bool has_next = Sched::SINGLE ? false : S.next(ui + 1, nxt);
        const char* nA = has_next ? S.pa(nxt) : cA; const char* nB = has_next ? S.pb(nxt) : cB;
#pragma unroll 1
        for (int t = 0; t < nt; t += 2) {
            const bool last = (t == nt - 2);
            const char* a1 = cA + (size_t)(t + 1) * kstep;
            const char* a2 = last ? nA : cA + (size_t)(t + 2) * kstep; const char* b2 = last ? nB : cB + (size_t)(t + 2) * kstep;
            const char* a3 = a2 + kstep; const char* b3 = b2 + kstep;
            if (last && has_next) S.a_ready(nxt);
            PG8_LDB(B0, 0, 0); PG8_LDB(B1, 0, 1); PG8_SCHED; PG8_LDA(At, 0, 0); PG8_STAGE(PG8_SA(1, 1), a1 + hstepA, voffA);
            PG8_WAIT_V(8); PG8_WAIT_L(0); PG8_BAR; PG8_MMA(0, 0, At, B0); PG8_MMA(0, 1, At, B1); PG8_BAR; PG8_SCHED;
            PG8_LDA(At, 0, 1); PG8_STAGE(PG8_SB(0, 0), b2, voffB); PG8_STAGE(PG8_SB(0, 1), b2 + hstepB, voffB); PG8_STAGE(PG8_SA(0, 0), a2, voffA);
            PG8_WAIT_V(8); PG8_WAIT_L(0); PG8_BAR; PG8_MMA(1, 0, At, B0); PG8_MMA(1, 1, At, B1); PG8_BAR; PG8_SCHED;
            PG8_LDB(B0, 1, 0); PG8_LDB(B1, 1, 1); PG8_SCHED; PG8_LDA(At, 1, 0); PG8_STAGE(PG8_SA(0, 1), a2 + hstepA, voffA);
            PG8_WAIT_V(8); PG8_WAIT_L(0); PG8_BAR; PG8_MMA(0, 0, At, B0); PG8_MMA(0, 1, At, B1); PG8_BAR; PG8_SCHED;
            PG8_LDA(At, 1, 1); PG8_STAGE(PG8_SB(1, 0), b3, voffB); PG8_STAGE(PG8_SB(1, 1), b3 + hstepB, voffB); PG8_STAGE(PG8_SA(1, 0), a3, voffA);
            PG8_WAIT_V(8); PG8_WAIT_L(0); PG8_BAR; PG8_MMA(1, 0, At, B0); PG8_MMA(1, 1, At, B1); PG8_BAR; PG8_SCHED;
        }
        if constexpr (FP8 || I8) asm volatile("s_nop 15\n\ts_nop 15" ::: "memory");
        if constexpr (ALIGN_EPI) { if (wr == 0) PG8_BAR; }
        if constexpr (Epi::XCHG) E.fused(acc, cur, wr, wc, fr, fq, lds, wid, lane); else E(acc, cur, wr, wc, fr, fq);
        S.done(cur);
        if (!has_next) break;
#pragma unroll
        for (int a = 0; a < 2; ++a)
#pragma unroll
            for (int b = 0; b < 2; ++b)
#pragma unroll
                for (int m = 0; m < 4; ++m)
#pragma unroll
                    for (int n = 0; n < 2; ++n) acc[a][b][m][n] = (f32x4){0.f, 0.f, 0.f, 0.f};
        cur = nxt; cA = nA; cB = nB; ++ui;
        if constexpr (ALIGN_EPI) { if (wr == 1) PG8_BAR; }
    }
    PG8_WAIT_V(0);
    if constexpr (!ALIGN_EPI) { if (wr == 0) PG8_BAR; }
    PG8_BAR;
#undef PG8_SA
#undef PG8_SB
#undef PG8_STAGE
#undef PG8_LDA
#undef PG8_LDB
#undef PG8_MMA
#undef PG8_WAIT_V
#undef PG8_WAIT_L
#undef PG8_BAR
#undef PG8_SCHED
}

struct OrderG3h {
    static constexpr bool SINGLE = false;
    const bf16_t* A; const bf16_t* Bt; int G, c;
    __device__ __forceinline__ bool next(int i, Unit& u) const { const long t = (long)(i >> 2) * G + c; if (t >= 1024) return false; tile_of((int)t, 64, 16, u.pm, u.pn); u.j = i & 3; return true; }
    __device__ __forceinline__ const char* pa(const Unit& u) const { return (const char*)(A + (size_t)u.pm * BM * D + u.j * 512); }
    __device__ __forceinline__ const char* pb(const Unit& u) const { return (const char*)(Bt + (size_t)u.j * D * 512 + (size_t)u.pn * HALF * 512); }
};
struct EpiG3h {
    const bf16_t* GT; bf16_t* MG;
    __device__ __forceinline__ void operator()(const f32x4 (&acc)[2][4][2], f32x4 (&mg)[2][4][2], const Unit& u, int wr, int wc, int fr, int fq) const {
        const int row0 = u.pm * BM + wr * 64 + fr; const int c0 = u.pn * HALF + wc * 32 + 8 * fq; const int j = u.j;
#pragma unroll
        for (int ai = 0; ai < 2; ++ai)
#pragma unroll
            for (int m = 0; m < 4; ++m) { const size_t row = (size_t)(row0 + ai * HALF + m * 16);
                f32x4 g0, g1; unpack8(*(const v4u*)(GT + row * NG + j * D + c0), g0, g1);
                f32x4 v0 = g0 * acc[ai][m][0], v1 = g1 * acc[ai][m][1];
                if (j > 0) { v0 += mg[ai][m][0]; v1 += mg[ai][m][1]; }
                mg[ai][m][0] = v0; mg[ai][m][1] = v1;
                if (j == 3) *(v4u*)(MG + row * D + c0) = pack8(v0, v1); }
    }
};
template <class Epi, class Sched>
__device__ __forceinline__ void gemm_phase_h(PG8_LAS unsigned char* lds, const int wv, const int K, const int lda, const int ldb, const Sched& S, const Epi& E) {
    const int tid = opq_tid(wv), wid = __builtin_amdgcn_readfirstlane(tid >> 6), lane = tid & 63, wr = wid >> 2, wc = wid & 3, fr = lane & 15, fq = lane >> 4;
    const int nt = K / BK;
    unsigned voffA[2], voffB[2];
#pragma unroll
    for (int i = 0; i < 2; ++i) { int R, C; stage_rc(tid * 16 + i * 8192, R, C); const int Rb = (R & ~31) + perm32(R & 31);
        voffA[i] = (unsigned)(R * lda + C) * 2u; voffB[i] = (unsigned)(Rb * ldb + C) * 2u; }
    const size_t kstep = (size_t)(BK * 2);
    const size_t hstepA = (size_t)HALF * lda * 2;
    const unsigned ldsw = (unsigned)wid * 1024u;
    const int aoff = lds_byte(wr * 64 + fr, fq * 8), boff = lds_byte(wc * 32 + fr, fq * 8);
#define PG8_SA(b, h) (((b) * 2 + (h)) * HTB)
#define PG8_SB(b) ((4 + (b) * 2) * HTB)
#define PG8_STAGE(bufoff, gbase, voff) do { const char* gb_ = uptr((const char*)(gbase)); _Pragma("unroll") for (int _i = 0; _i < 2; ++_i) \
        __builtin_amdgcn_global_load_lds((const unsigned*)(gb_ + (voff)[_i]), (PG8_LAS unsigned*)(lds + (bufoff) + ldsw + _i * 8192), 16, 0, 0); } while (0)
#define PG8_LDA(dst, b, h) do { _Pragma("unroll") for (int m = 0; m < 4; ++m) _Pragma("unroll") for (int k = 0; k < 2; ++k) dst[m][k] = *(const PG8_LAS bf16x8*)(lds + PG8_SA(b, h) + aoff + m * 2048 + k * 1024); } while (0)
#define PG8_LDB(dst, b) do { _Pragma("unroll") for (int n = 0; n < 2; ++n) _Pragma("unroll") for (int k = 0; k < 2; ++k) dst[n][k] = *(const PG8_LAS bf16x8*)(lds + PG8_SB(b) + boff + n * 2048 + k * 1024); } while (0)
#define PG8_MMA(ai, At, Bt) do { __builtin_amdgcn_s_setprio(1); _Pragma("unroll") for (int m = 0; m < 4; ++m) _Pragma("unroll") for (int n = 0; n < 2; ++n) _Pragma("unroll") for (int k = 0; k < 2; ++k) \
        acc[ai][m][n] = __builtin_amdgcn_mfma_f32_16x16x32_bf16(Bt[n][k], At[m][k], acc[ai][m][n], 0, 0, 0); __builtin_amdgcn_s_setprio(0); } while (0)
#define PG8_WAIT_V(n) asm volatile("s_waitcnt vmcnt(" #n ")" ::: "memory")
#define PG8_WAIT_L(n) asm volatile("s_waitcnt lgkmcnt(" #n ")" ::: "memory")
#define PG8_BAR __builtin_amdgcn_s_barrier()
#define PG8_SCHED __builtin_amdgcn_sched_barrier(0)
    Unit cur, nxt; int ui = 0;
    if (!S.next(0, cur)) return;
    f32x4 acc[2][4][2], mg[2][4][2];
#pragma unroll
    for (int a = 0; a < 2; ++a)
#pragma unroll
        for (int m = 0; m < 4; ++m)
#pragma unroll
            for (int n = 0; n < 2; ++n) { acc[a][m][n] = (f32x4){0.f, 0.f, 0.f, 0.f}; mg[a][m][n] = (f32x4){0.f, 0.f, 0.f, 0.f}; }
    bf16x8 At[4][2], B0[2][2];
    const char* cA = S.pa(cur); const char* cB = S.pb(cur);
    PG8_STAGE(PG8_SB(0), cB, voffB); PG8_STAGE(PG8_SA(0, 0), cA, voffA); PG8_STAGE(PG8_SA(0, 1), cA + hstepA, voffA);
    if (wr == 1) PG8_BAR;
    PG8_WAIT_V(2); PG8_BAR;
    PG8_STAGE(PG8_SB(1), cB + kstep, voffB); PG8_STAGE(PG8_SA(1, 0), cA + kstep, voffA);
    PG8_WAIT_V(4); PG8_BAR;
    for (;;) {
        const bool has_next = S.next(ui + 1, nxt);
        const char* nA = has_next ? S.pa(nxt) : cA; const char* nB = has_next ? S.pb(nxt) : cB;
#pragma unroll 1
        for (int t = 0; t < nt; t += 2) {
            const bool last = (t == nt - 2);
            const char* a1 = cA + (size_t)(t + 1) * kstep;
            const char* a2 = last ? nA : cA + (size_t)(t + 2) * kstep; const char* b2 = last ? nB : cB + (size_t)(t + 2) * kstep;
            const char* a3 = a2 + kstep; const char* b3 = b2 + kstep;
            PG8_LDB(B0, 0); PG8_SCHED; PG8_LDA(At, 0, 0); PG8_STAGE(PG8_SA(1, 1), a1 + hstepA, voffA);
            PG8_WAIT_V(6); PG8_WAIT_L(0); PG8_BAR; PG8_MMA(0, At, B0); PG8_BAR; PG8_SCHED;
            PG8_LDA(At, 0, 1); PG8_STAGE(PG8_SB(0), b2, voffB); PG8_STAGE(PG8_SA(0, 0), a2, voffA);
            PG8_WAIT_V(6); PG8_WAIT_L(0); PG8_BAR; PG8_MMA(1, At, B0); PG8_BAR; PG8_SCHED;
            PG8_LDB(B0, 1); PG8_SCHED; PG8_LDA(At, 1, 0); PG8_STAGE(PG8_SA(0, 1), a2 + hstepA, voffA);
            PG8_WAIT_V(6); PG8_WAIT_L(0); PG8_BAR; PG8_MMA(0, At, B0); PG8_BAR; PG8_SCHED;
            PG8_LDA(At, 1, 1); PG8_STAGE(PG8_SB(1), b3, voffB); PG8_STAGE(PG8_SA(1, 0), a3, voffA);
            PG8_WAIT_V(6); PG8_WAIT_L(0); PG8_BAR; PG8_MMA(1, At, B0); PG8_BAR; PG8_SCHED;
        }
        if (wr == 0) PG8_BAR;
        E(acc, mg, cur, wr, wc, fr, fq);
        if (!has_next) break;
#pragma unroll
        for (int a = 0; a < 2; ++a)
#pragma unroll
            for (int m = 0; m < 4; ++m)
#pragma unroll
                for (int n = 0; n < 2; ++n) acc[a][m][n] = (f32x4){0.f, 0.f, 0.f, 0.f};
        cur = nxt; cA = nA; cB = nB; ++ui;
        if (wr == 1) PG8_BAR;
    }
    PG8_WAIT_V(0);
    PG8_BAR;
#undef PG8_SA
#undef PG8_SB
#undef PG8_STAGE
#undef PG8_LDA
#undef PG8_LDB
#undef PG8_MMA
#undef PG8_WAIT_V
#undef PG8_WAIT_L
#undef PG8_BAR
#undef PG8_SCHED
}
}
namespace att {
constexpr int KVBLK = 64;
constexpr int SHM_V = 16384, SHM_K = 16384, SHM_KR = 8192;
constexpr int NVB = ATT_HS ? 3 : 2;
constexpr int OFF_V = 0, OFF_K = NVB * SHM_V, OFF_KR = OFF_K + 2 * SHM_K, OFF_WS = OFF_KR + 2 * SHM_KR, OFF_QR = OFF_WS + 8 * 64 * 4, LDS_ATT = OFF_QR + 8 * 4096;
#define RFLU(x) ((unsigned)__builtin_amdgcn_readfirstlane((int)(x)))
#ifndef KSW_MASK
#define KSW_MASK 7
#endif
#define KSWZ(row, colB) ((row) * 256 + ((colB) ^ (((row) & KSW_MASK) << 4)))
#define KRSWZ(row, chunk) ((row) * 128 + ((((chunk) ^ (((row) >> 1) & 7))) << 4))
#define SBAR() __builtin_amdgcn_sched_barrier(0)
__device__ __forceinline__ int crow(int r, int hi) { return (r & 3) + 8 * (r >> 2) + 4 * hi; }
__device__ __forceinline__ unsigned cvtpk(float lo, float hi) { return cvt_pk_bf16(lo, hi); }

__device__ __forceinline__ void partialSM(f32x16& p0, f32x16& p1, float& m_reg, float& mn, float& alpha, const float C, const float thr) {
  float pmax = p0[0];
#pragma unroll
  for (int r = 1; r < 16; ++r) pmax = fmaxf(pmax, p0[r]);
#pragma unroll
  for (int r = 0; r < 16; ++r) pmax = fmaxf(pmax, p1[r]);
  { auto rr = __builtin_amdgcn_permlane32_swap(__float_as_uint(pmax), __float_as_uint(pmax), false, false);
    pmax = fmaxf(__uint_as_float(rr[0]), __uint_as_float(rr[1])); }
  if (__builtin_expect(__all(pmax - m_reg <= thr), 1)) { mn = m_reg; alpha = 1.f; }
  else { mn = fmaxf(m_reg, pmax); alpha = __builtin_amdgcn_exp2f((m_reg - mn) * C); m_reg = mn; }
  const float mnC = -mn * C;
#ifdef PROBE_VALU
  { float dz = mnC; _Pragma("unroll") for (int r = 0; r < PROBE_VALU; ++r) asm volatile("v_fma_f32 %0, %1, %2, %0" : "+v"(dz) : "v"(C), "v"(mn)); asm volatile("" :: "v"(dz)); }
#endif
#pragma unroll
  for (int r = 0; r < 16; ++r) p0[r] = fmaf(p0[r], C, mnC);
#pragma unroll
  for (int r = 0; r < 16; ++r) p1[r] = fmaf(p1[r], C, mnC);
#pragma unroll
  for (int r = 0; r < 16; ++r) p0[r] = __builtin_amdgcn_exp2f(p0[r]);
}
template <bool LPART = false, bool NOSUM = false, bool P1X = false>
__device__ __forceinline__ void finishSM(f32x16& p0, f32x16& p1, float alpha, float& l_reg, bf16x8& pa0, bf16x8& pa1, bf16x8& pa2, bf16x8& pa3) {
  if constexpr (!P1X) {
#pragma unroll
  for (int r = 0; r < 16; ++r) p1[r] = __builtin_amdgcn_exp2f(p1[r]); }
  if constexpr (!NOSUM) {
  float ps = 0;
#pragma unroll
  for (int r = 0; r < 16; ++r) ps += p0[r];
#pragma unroll
  for (int r = 0; r < 16; ++r) ps += p1[r];
  if constexpr (!LPART) { auto rr = __builtin_amdgcn_permlane32_swap(__float_as_uint(ps), __float_as_uint(ps), false, false);
    ps = __uint_as_float(rr[0]) + __uint_as_float(rr[1]); }
  l_reg = l_reg * alpha + ps; }
#define PK4(P, BASE, OUT) do { unsigned a0 = cvtpk(P[BASE + 0], P[BASE + 1]), a1 = cvtpk(P[BASE + 2], P[BASE + 3]);   \
    unsigned b0 = cvtpk(P[BASE + 4], P[BASE + 5]), b1 = cvtpk(P[BASE + 6], P[BASE + 7]);                              \
    if (ATT_NOSWAP) { v4u w = {a0, a1, b0, b1}; OUT = __builtin_bit_cast(bf16x8, w); } else { \
    auto r0 = __builtin_amdgcn_permlane32_swap(a0, b0, false, false); auto r1 = __builtin_amdgcn_permlane32_swap(a1, b1, false, false); \
    v4u w = {r0[0], r1[0], r0[1], r1[1]}; OUT = __builtin_bit_cast(bf16x8, w); } } while (0)
  PK4(p0, 0, pa0); PK4(p0, 8, pa1); PK4(p1, 0, pa2); PK4(p1, 8, pa3);
#undef PK4
}
template <int NQ, bool ROPEK>
__device__ __forceinline__ void qkt(f32x16& p0, f32x16& p1, const LAS char* Ks, const LAS char* KRs, const LAS char* QRs, const bf16x8 (&qr)[NQ], int r32, int hi, int kd0) {
  p0 = f32x16{}; p1 = f32x16{};
#pragma unroll
  for (int d0 = 0; d0 < NQ; ++d0) { const int cb = ((kd0 + d0) * 16 + hi * 8) * 2;
    const bf16x8 b0 = *(const LAS bf16x8*)(Ks + KSWZ(r32, cb));
    const bf16x8 b1 = *(const LAS bf16x8*)(Ks + KSWZ(32 + r32, cb));
    p0 = __builtin_amdgcn_mfma_f32_32x32x16_bf16(b0, qr[d0], p0, 0, 0, 0);
    p1 = __builtin_amdgcn_mfma_f32_32x32x16_bf16(b1, qr[d0], p1, 0, 0, 0); }
  if constexpr (ROPEK) {
#pragma unroll
    for (int d0 = 0; d0 < 4; ++d0) { const int ch = d0 * 2 + hi;
      const bf16x8 b0 = *(const LAS bf16x8*)(KRs + KRSWZ(r32, ch));
      const bf16x8 b1 = *(const LAS bf16x8*)(KRs + KRSWZ(32 + r32, ch));
      const bf16x8 qq = *(const LAS bf16x8*)(QRs + d0 * 1024);
      p0 = __builtin_amdgcn_mfma_f32_32x32x16_bf16(b0, qq, p0, 0, 0, 0);
      p1 = __builtin_amdgcn_mfma_f32_32x32x16_bf16(b1, qq, p1, 0, 0, 0); }
  }
}
constexpr float THRL = 11.5415603f;
__device__ __forceinline__ void partialSM_nn(f32x16& p0, f32x16& p1, f32x16& negm, float& alpha, const float l_reg, const bool fast = false) {
  alpha = 1.f;
  if (!fast) {
  float pmax = p0[0]; asm volatile("" : "+v"(pmax));
#pragma unroll
  for (int r = 1; r < 16; ++r) pmax = fmaxf(pmax, p0[r]);
#pragma unroll
  for (int r = 0; r < 16; ++r) pmax = fmaxf(pmax, p1[r]);
  { auto rr = __builtin_amdgcn_permlane32_swap(__float_as_uint(pmax), __float_as_uint(pmax), false, false);
    pmax = fmaxf(__uint_as_float(rr[0]), __uint_as_float(rr[1])); }
  if (__builtin_expect(!__all(pmax <= THRL && pmax >= -64.f), 0)) {
    float lc = l_reg;
    if (ATT_LPART) { auto rr = __builtin_amdgcn_permlane32_swap(__float_as_uint(lc), __float_as_uint(lc), false, false); lc = __uint_as_float(rr[0]) + __uint_as_float(rr[1]); }
    const float dl = (pmax > THRL) ? pmax : ((lc == 0.f && pmax < -64.f && pmax > -1e30f) ? pmax : 0.f);
#pragma unroll
    for (int r = 0; r < 16; ++r) { p0[r] -= dl; p1[r] -= dl; }
#pragma unroll
    for (int r = 0; r < 16; ++r) negm[r] -= dl;
    alpha = (dl > 0.f) ? __builtin_amdgcn_exp2f(-dl) : 1.f;
  }
  }
#pragma unroll
  for (int r = 0; r < 16; ++r) p0[r] = __builtin_amdgcn_exp2f(p0[r]);
}
__device__ __forceinline__ void partialSM_n(f32x16& p0, f32x16& p1, float& mref, f32x16& negm, float& alpha, const float l_reg, const bool fast = false) {
  partialSM_nn(p0, p1, negm, alpha, l_reg, fast); mref = -negm[0];
}
template <int NQ, bool ROPEK, bool ZC = false>
__device__ __forceinline__ void qkt_n(f32x16& p0, f32x16& p1, const f32x16& negm, const LAS char* Ks, const LAS char* KRs, const LAS char* QRs, const bf16x8 (&qr)[NQ], int r32, int hi, int kd0) {
#pragma unroll
  for (int d0 = 0; d0 < NQ; ++d0) { const int cb = ((kd0 + d0) * 16 + hi * 8) * 2;
    const bf16x8 b0 = *(const LAS bf16x8*)(Ks + KSWZ(r32, cb));
    const bf16x8 b1 = *(const LAS bf16x8*)(Ks + KSWZ(32 + r32, cb));
    if (d0 == 0 && ZC) { p0 = __builtin_amdgcn_mfma_f32_32x32x16_bf16(b0, qr[0], f32x16{}, 0, 0, 0); p1 = __builtin_amdgcn_mfma_f32_32x32x16_bf16(b1, qr[0], f32x16{}, 0, 0, 0); }
    else if (d0 == 0) { p0 = __builtin_amdgcn_mfma_f32_32x32x16_bf16(b0, qr[0], negm, 0, 0, 0); p1 = __builtin_amdgcn_mfma_f32_32x32x16_bf16(b1, qr[0], negm, 0, 0, 0); }
    else { p0 = __builtin_amdgcn_mfma_f32_32x32x16_bf16(b0, qr[d0], p0, 0, 0, 0); p1 = __builtin_amdgcn_mfma_f32_32x32x16_bf16(b1, qr[d0], p1, 0, 0, 0); } }
  if constexpr (ROPEK) {
#pragma unroll
    for (int d0 = 0; d0 < 4; ++d0) { const int ch = d0 * 2 + hi;
      const bf16x8 b0 = *(const LAS bf16x8*)(KRs + KRSWZ(r32, ch));
      const bf16x8 b1 = *(const LAS bf16x8*)(KRs + KRSWZ(32 + r32, ch));
      const bf16x8 qq = *(const LAS bf16x8*)(QRs + d0 * 1024);
      p0 = __builtin_amdgcn_mfma_f32_32x32x16_bf16(b0, qq, p0, 0, 0, 0);
      p1 = __builtin_amdgcn_mfma_f32_32x32x16_bf16(b1, qq, p1, 0, 0, 0); }
  }
}
template <int BASE> __device__ __forceinline__ bf16x8 pk4f(const f32x16& P) {
  const unsigned a0 = cvtpk(P[BASE + 0], P[BASE + 1]), a1 = cvtpk(P[BASE + 2], P[BASE + 3]), b0 = cvtpk(P[BASE + 4], P[BASE + 5]), b1 = cvtpk(P[BASE + 6], P[BASE + 7]);
  if (ATT_NOSWAP) { const v4u w = {a0, a1, b0, b1}; return __builtin_bit_cast(bf16x8, w); }
  auto r0 = __builtin_amdgcn_permlane32_swap(a0, b0, false, false); auto r1 = __builtin_amdgcn_permlane32_swap(a1, b1, false, false);
  const v4u w = {r0[0], r1[0], r0[1], r1[1]}; return __builtin_bit_cast(bf16x8, w); }
template <int NQ, bool ROPEK, bool NOSUM = false, bool P1X = false>
__device__ __forceinline__ void qkt_fin(f32x16& n0, f32x16& n1, const LAS char* Ks, const LAS char* KRs, const LAS char* QRs, const bf16x8 (&qr)[NQ], int r32, int hi, int kd0,
                                        f32x16& p0, f32x16& p1, float& l_reg, bf16x8& pa0, bf16x8& pa1, bf16x8& pa2, bf16x8& pa3) {
  constexpr int NS = NQ + (ROPEK ? 4 : 0), CPS = (NQ >= 8) ? 1 : 8 / NQ;
  bf16x8 b0, b1, c0, c1, qq = qr[0], qn = qr[0];
  { const int cb = (kd0 * 16 + hi * 8) * 2; b0 = *(const LAS bf16x8*)(Ks + KSWZ(r32, cb)); b1 = *(const LAS bf16x8*)(Ks + KSWZ(32 + r32, cb)); }
  float ps = 0.f;
#pragma unroll
  for (int s_ = 0; s_ < NS; ++s_) {
    if (s_ + 1 < NS) {
      if (s_ + 1 < NQ) { const int cb = ((kd0 + s_ + 1) * 16 + hi * 8) * 2; c0 = *(const LAS bf16x8*)(Ks + KSWZ(r32, cb)); c1 = *(const LAS bf16x8*)(Ks + KSWZ(32 + r32, cb)); qn = qr[(s_ + 1 < NQ) ? s_ + 1 : 0]; }
      else { const int d0 = s_ + 1 - NQ, ch = d0 * 2 + hi; c0 = *(const LAS bf16x8*)(KRs + KRSWZ(r32, ch)); c1 = *(const LAS bf16x8*)(KRs + KRSWZ(32 + r32, ch)); qn = *(const LAS bf16x8*)(QRs + d0 * 1024); }
    }
    if (s_ == 0) { n0 = __builtin_amdgcn_mfma_f32_32x32x16_bf16(b0, qq, f32x16{}, 0, 0, 0); n1 = __builtin_amdgcn_mfma_f32_32x32x16_bf16(b1, qq, f32x16{}, 0, 0, 0); }
    else { n0 = __builtin_amdgcn_mfma_f32_32x32x16_bf16(b0, qq, n0, 0, 0, 0); n1 = __builtin_amdgcn_mfma_f32_32x32x16_bf16(b1, qq, n1, 0, 0, 0); }
#pragma unroll
    for (int c_ = 0; c_ < CPS; ++c_) { const int i = s_ * CPS + c_;
      if (i < 8) { if constexpr (!P1X) { p1[2 * i] = __builtin_amdgcn_exp2f(p1[2 * i]); p1[2 * i + 1] = __builtin_amdgcn_exp2f(p1[2 * i + 1]); }
        if constexpr (!NOSUM) { ps += p0[2 * i]; ps += p0[2 * i + 1];
          if (i >= 1) { ps += p1[2 * i - 2]; ps += p1[2 * i - 1]; } }
        if (i == 1) pa0 = pk4f<0>(p0);
        if (i == 3) pa1 = pk4f<8>(p0);
        if (i == 5) pa2 = pk4f<0>(p1); } }
    __builtin_amdgcn_sched_barrier(0);
    b0 = c0; b1 = c1; qq = qn;
  }
  pa3 = pk4f<8>(p1);
  if constexpr (!NOSUM) { ps += p1[14]; ps += p1[15];
    { auto rr = __builtin_amdgcn_permlane32_swap(__float_as_uint(ps), __float_as_uint(ps), false, false); ps = __uint_as_float(rr[0]) + __uint_as_float(rr[1]); }
    l_reg += ps; }
}
__device__ __forceinline__ void band_mask(f32x16& p0, f32x16& p1, int kb, int qpos, int hi) {
  const float NEG = -INFINITY;
#pragma unroll
  for (int r = 0; r < 16; ++r) { const int d = kb + crow(r, hi) - qpos; if (d > 128 || d < -128) p0[r] = NEG; if (d + 32 > 128 || d + 32 < -128) p1[r] = NEG; }
}
__device__ __forceinline__ int v_st(int k, int c) { const int kk = (k & ~0xC) | ((k & 4) << 1) | ((k & 8) >> 1); return ((kk >> 3) * 4 + (c >> 5)) * 512 + ((kk & 7) * 32 + (c & 31)) * 2; }
__device__ __forceinline__ int v_rd_base(int lane) { return ((lane & 3) << 3) | (((lane >> 2) & 3) << 6) | (((lane >> 4) & 1) << 5) | (((lane >> 5) & 1) << 8); }
constexpr int v_rd_off(int d0, int ks, int half) { return d0 * 512 + ks * 4096 + half * 2048; }
template <int OFF> __device__ __forceinline__ s16x4 tr_read(int vb) {
  s16x4 r; asm volatile("ds_read_b64_tr_b16 %0, %1 offset:%2" : "=&v"(r) : "v"(vb), "i"(OFF) : "memory"); return r;
}
template <int D0, int BO = 0> __device__ __forceinline__ void pv_one(f32x16& od, int vb, bf16x8 pa0, bf16x8 pa1, bf16x8 pa2, bf16x8 pa3) {
  const s16x4 l0 = tr_read<BO + v_rd_off(D0, 0, 0)>(vb), h0 = tr_read<BO + v_rd_off(D0, 0, 1)>(vb), l1 = tr_read<BO + v_rd_off(D0, 1, 0)>(vb), h1 = tr_read<BO + v_rd_off(D0, 1, 1)>(vb);
  const s16x4 l2 = tr_read<BO + v_rd_off(D0, 2, 0)>(vb), h2 = tr_read<BO + v_rd_off(D0, 2, 1)>(vb), l3 = tr_read<BO + v_rd_off(D0, 3, 0)>(vb), h3 = tr_read<BO + v_rd_off(D0, 3, 1)>(vb);
  asm volatile("s_waitcnt lgkmcnt(0)" ::: "memory"); SBAR();
#define PK(L, H) (bf16x8){L[0], L[1], L[2], L[3], H[0], H[1], H[2], H[3]}
#ifdef ATT_PRIO
  __builtin_amdgcn_s_setprio(1);
#endif
  od = __builtin_amdgcn_mfma_f32_32x32x16_bf16(pa0, PK(l0, h0), od, 0, 0, 0);
  od = __builtin_amdgcn_mfma_f32_32x32x16_bf16(pa1, PK(l1, h1), od, 0, 0, 0);
  od = __builtin_amdgcn_mfma_f32_32x32x16_bf16(pa2, PK(l2, h2), od, 0, 0, 0);
  od = __builtin_amdgcn_mfma_f32_32x32x16_bf16(pa3, PK(l3, h3), od, 0, 0, 0);
#ifdef ATT_PRIO
  __builtin_amdgcn_s_setprio(0);
#endif
#undef PK
}
template <int BO = 0>
__device__ __forceinline__ void pv_d0(f32x16 (&o)[4], int vb, bf16x8 pa0, bf16x8 pa1, bf16x8 pa2, bf16x8 pa3) {
  pv_one<0, BO>(o[0], vb, pa0, pa1, pa2, pa3); pv_one<1, BO>(o[1], vb, pa0, pa1, pa2, pa3); pv_one<2, BO>(o[2], vb, pa0, pa1, pa2, pa3); pv_one<3, BO>(o[3], vb, pa0, pa1, pa2, pa3);
}
__device__ __forceinline__ bf16x8 ones8() { const v4u w = {0x3F803F80u, 0x3F803F80u, 0x3F803F80u, 0x3F803F80u}; return __builtin_bit_cast(bf16x8, w); }
template <int BO, bool LM = false, bool BOTH = false>
__device__ __forceinline__ void pv_d0_exp(f32x16 (&o)[4], int vb, bf16x8 pa0, bf16x8 pa1, bf16x8 pa2, bf16x8 pa3, f32x16& pn, f32x16& L, f32x16& pn1);
template <int BO>
__device__ __forceinline__ void pv_d0_exp_sum(f32x16 (&o)[4], int vb, bf16x8 pa0, bf16x8 pa1, bf16x8 pa2, bf16x8 pa3, f32x16& pn, const f32x16& pc0, const f32x16& pc1, float& l_reg) {
  float ps = 0.f;
  pv_one<0, BO>(o[0], vb, pa0, pa1, pa2, pa3);
#pragma unroll
  for (int r = 0; r < 4; ++r) pn[r] = __builtin_amdgcn_exp2f(pn[r]);
#pragma unroll
  for (int r = 0; r < 8; ++r) ps += pc0[r];
  pv_one<1, BO>(o[1], vb, pa0, pa1, pa2, pa3);
#pragma unroll
  for (int r = 4; r < 8; ++r) pn[r] = __builtin_amdgcn_exp2f(pn[r]);
#pragma unroll
  for (int r = 8; r < 16; ++r) ps += pc0[r];
  pv_one<2, BO>(o[2], vb, pa0, pa1, pa2, pa3);
#pragma unroll
  for (int r = 8; r < 12; ++r) pn[r] = __builtin_amdgcn_exp2f(pn[r]);
#pragma unroll
  for (int r = 0; r < 8; ++r) ps += pc1[r];
  pv_one<3, BO>(o[3], vb, pa0, pa1, pa2, pa3);
#pragma unroll
  for (int r = 12; r < 16; ++r) pn[r] = __builtin_amdgcn_exp2f(pn[r]);
#pragma unroll
  for (int r = 8; r < 16; ++r) ps += pc1[r];
  { auto rr = __builtin_amdgcn_permlane32_swap(__float_as_uint(ps), __float_as_uint(ps), false, false); ps = __uint_as_float(rr[0]) + __uint_as_float(rr[1]); }
  l_reg += ps;
}
template <int BO, bool LM, bool BOTH>
__device__ __forceinline__ void pv_d0_exp(f32x16 (&o)[4], int vb, bf16x8 pa0, bf16x8 pa1, bf16x8 pa2, bf16x8 pa3, f32x16& pn, f32x16& L, f32x16& pn1) {
  pv_one<0, BO>(o[0], vb, pa0, pa1, pa2, pa3);
  if constexpr (LM) L = __builtin_amdgcn_mfma_f32_32x32x16_bf16(pa0, ones8(), L, 0, 0, 0);
#pragma unroll
  for (int r = 0; r < 4; ++r) { pn[r] = __builtin_amdgcn_exp2f(pn[r]); if constexpr (BOTH) pn1[r] = __builtin_amdgcn_exp2f(pn1[r]); }
  pv_one<1, BO>(o[1], vb, pa0, pa1, pa2, pa3);
  if constexpr (LM) L = __builtin_amdgcn_mfma_f32_32x32x16_bf16(pa1, ones8(), L, 0, 0, 0);
#pragma unroll
  for (int r = 4; r < 8; ++r) { pn[r] = __builtin_amdgcn_exp2f(pn[r]); if constexpr (BOTH) pn1[r] = __builtin_amdgcn_exp2f(pn1[r]); }
  pv_one<2, BO>(o[2], vb, pa0, pa1, pa2, pa3);
  if constexpr (LM) L = __builtin_amdgcn_mfma_f32_32x32x16_bf16(pa2, ones8(), L, 0, 0, 0);
#pragma unroll
  for (int r = 8; r < 12; ++r) { pn[r] = __builtin_amdgcn_exp2f(pn[r]); if constexpr (BOTH) pn1[r] = __builtin_amdgcn_exp2f(pn1[r]); }
  pv_one<3, BO>(o[3], vb, pa0, pa1, pa2, pa3);
  if constexpr (LM) L = __builtin_amdgcn_mfma_f32_32x32x16_bf16(pa3, ones8(), L, 0, 0, 0);
#pragma unroll
  for (int r = 12; r < 16; ++r) { pn[r] = __builtin_amdgcn_exp2f(pn[r]); if constexpr (BOTH) pn1[r] = __builtin_amdgcn_exp2f(pn1[r]); }
}
template <int BO>
__device__ __forceinline__ void pv_d0_L(f32x16 (&o)[4], int vb, bf16x8 pa0, bf16x8 pa1, bf16x8 pa2, bf16x8 pa3, f32x16& L) {
  pv_one<0, BO>(o[0], vb, pa0, pa1, pa2, pa3); L = __builtin_amdgcn_mfma_f32_32x32x16_bf16(pa0, ones8(), L, 0, 0, 0);
  pv_one<1, BO>(o[1], vb, pa0, pa1, pa2, pa3); L = __builtin_amdgcn_mfma_f32_32x32x16_bf16(pa1, ones8(), L, 0, 0, 0);
  pv_one<2, BO>(o[2], vb, pa0, pa1, pa2, pa3); L = __builtin_amdgcn_mfma_f32_32x32x16_bf16(pa2, ones8(), L, 0, 0, 0);
  pv_one<3, BO>(o[3], vb, pa0, pa1, pa2, pa3); L = __builtin_amdgcn_mfma_f32_32x32x16_bf16(pa3, ones8(), L, 0, 0, 0);
}
__device__ __forceinline__ bf16x8 ld8(const bf16* p) { return *reinterpret_cast<const bf16x8*>(p); }

template <int D0> __device__ __forceinline__ void trd8(s16x4 (&v)[8], int vb) {
  v[0] = tr_read<v_rd_off(D0, 0, 0)>(vb); v[1] = tr_read<v_rd_off(D0, 0, 1)>(vb); v[2] = tr_read<v_rd_off(D0, 1, 0)>(vb); v[3] = tr_read<v_rd_off(D0, 1, 1)>(vb);
  v[4] = tr_read<v_rd_off(D0, 2, 0)>(vb); v[5] = tr_read<v_rd_off(D0, 2, 1)>(vb); v[6] = tr_read<v_rd_off(D0, 3, 0)>(vb); v[7] = tr_read<v_rd_off(D0, 3, 1)>(vb);
}
__device__ __forceinline__ void pv4(f32x16& od, const s16x4 (&v)[8], bf16x8 pa0, bf16x8 pa1, bf16x8 pa2, bf16x8 pa3) {
#define PK(L, H) (bf16x8){L[0], L[1], L[2], L[3], H[0], H[1], H[2], H[3]}
  od = __builtin_amdgcn_mfma_f32_32x32x16_bf16(pa0, PK(v[0], v[1]), od, 0, 0, 0);
  od = __builtin_amdgcn_mfma_f32_32x32x16_bf16(pa1, PK(v[2], v[3]), od, 0, 0, 0);
  od = __builtin_amdgcn_mfma_f32_32x32x16_bf16(pa2, PK(v[4], v[5]), od, 0, 0, 0);
  od = __builtin_amdgcn_mfma_f32_32x32x16_bf16(pa3, PK(v[6], v[7]), od, 0, 0, 0);
#undef PK
}
#define LGKM_WAIT(N) do { asm volatile("s_waitcnt lgkmcnt(" #N ")" ::: "memory"); SBAR(); } while (0)
__device__ __forceinline__ void pv_pipe(f32x16 (&o)[4], int vbk, bf16x8 pa0, bf16x8 pa1, bf16x8 pa2, bf16x8 pa3) {
  s16x4 va[8], vc[8];
  SBAR(); asm volatile("s_waitcnt lgkmcnt(0)" ::: "memory");
  trd8<0>(va, vbk);
  trd8<1>(vc, vbk); LGKM_WAIT(8); pv4(o[0], va, pa0, pa1, pa2, pa3); SBAR();
  trd8<2>(va, vbk); LGKM_WAIT(8); pv4(o[1], vc, pa0, pa1, pa2, pa3); SBAR();
  trd8<3>(vc, vbk); LGKM_WAIT(8); pv4(o[2], va, pa0, pa1, pa2, pa3); SBAR();
  LGKM_WAIT(0); pv4(o[3], vc, pa0, pa1, pa2, pa3); SBAR();
}
#ifdef ATT_PVPIPE
#define PV_D0 pv_pipe
#else
#define PV_D0 pv_d0<0>
#endif
__device__ __forceinline__ void glds16(const void* gsrc, unsigned lds_dst) { unsigned keep;
  asm volatile("s_mov_b32 %0, m0\n\ts_mov_b32 m0, %2\n\ts_nop 0\n\tglobal_load_lds_dwordx4 %1, off\n\ts_mov_b32 m0, %0" : "=&s"(keep) : "v"(gsrc), "s"(lds_dst) : "memory"); }
__device__ __forceinline__ void glds16x2(const void* sbase, unsigned off0, unsigned off1, unsigned lds_dst0, unsigned lds_dst1) { unsigned keep;
  asm volatile("s_nop 4\n\ts_mov_b32 %0, m0\n\ts_mov_b32 m0, %3\n\ts_nop 0\n\tglobal_load_lds_dwordx4 %1, %5\n\ts_mov_b32 m0, %4\n\ts_nop 0\n\tglobal_load_lds_dwordx4 %2, %5\n\ts_mov_b32 m0, %0"
               : "=&s"(keep) : "v"(off0), "v"(off1), "s"(lds_dst0), "s"(lds_dst1), "s"(sbase) : "memory"); }
template <int IMM>
__device__ __forceinline__ void glds16x2i(const void* sbase, unsigned off0, unsigned lds_dst0, unsigned lds_dst1) { unsigned keep;
  asm volatile("s_nop 4\n\ts_mov_b32 %0, m0\n\ts_mov_b32 m0, %2\n\ts_nop 0\n\tglobal_load_lds_dwordx4 %1, %4\n\ts_mov_b32 m0, %3\n\ts_nop 0\n\tglobal_load_lds_dwordx4 %1, %4 offset:%5\n\ts_mov_b32 m0, %0"
               : "=&s"(keep) : "v"(off0), "s"(lds_dst0), "s"(lds_dst1 - (unsigned)IMM), "s"(sbase), "i"(IMM) : "memory"); }
__device__ __forceinline__ void glds16s(const void* sbase, unsigned off0, unsigned lds_dst0) { unsigned keep;
  asm volatile("s_nop 4\n\ts_mov_b32 %0, m0\n\ts_mov_b32 m0, %2\n\ts_nop 0\n\tglobal_load_lds_dwordx4 %1, %3\n\ts_mov_b32 m0, %0" : "=&s"(keep) : "v"(off0), "s"(lds_dst0), "s"(sbase) : "memory"); }
__device__ __forceinline__ const char* uptr_(const char* p) { const unsigned long long v = (unsigned long long)p; const unsigned lo = (unsigned)__builtin_amdgcn_readfirstlane((int)(unsigned)v), hi = (unsigned)__builtin_amdgcn_readfirstlane((int)(unsigned)(v >> 32)); return (const char*)(((unsigned long long)hi << 32) | lo); }
#define WAIT_BAR() asm volatile("s_waitcnt vmcnt(0) lgkmcnt(0)\n\ts_barrier" ::: "memory")

template <int NQ, bool ROPEK, bool SWA>
__device__ __forceinline__ void attn_core(LAS char* lds, const bf16x8 (&qr)[NQ],
                                          const bf16* __restrict__ Kh, const bf16* __restrict__ Vh, const int ldk, const bf16* __restrict__ KRh, const int ldkr,
                                          const int NT, const float C, const float thr, const int kd0, const int qpos, const int kpos0,
                                          f32x16 (&o)[4], float& m_reg, float& l_reg, const int wv, const float kmax2 = -1.f, const float qx2 = 0.f) {
  const int tid = opq_tid(wv), lane = tid & 63, r32 = lane & 31, hi = lane >> 5;
  const int wid = __builtin_amdgcn_readfirstlane(tid >> 6);
  LAS char* V_lds = lds + OFF_V; LAS char* K_lds = lds + OFF_K; LAS char* KR_lds = lds + OFF_KR;
  LAS float* al_l = (LAS float*)(lds + OFF_WS) + wid * 64 + 32;
  const LAS char* QR_lds = lds + OFF_QR + wid * 4096 + lane * 16;
  const unsigned lds0 = (unsigned)(uintptr_t)lds;
  const int vb0 = (int)lds0 + OFF_V + v_rd_base(lane);
  unsigned kofs[2], vofs[2], krofs = 0u;
#pragma unroll
  for (int i = 0; i < 2; ++i) { const int p = wid * 2 + i;
    { const int row = p * 4 + (lane >> 4), ch = (lane & 15) ^ (row & KSW_MASK); kofs[i] = (unsigned)(row * ldk + ch * 8) * 2u; }
    { const int sub = 2 * p + (lane >> 5), kk = (sub >> 2) * 8 + ((lane & 31) >> 2), k = ATT_NOSWAP ? kk : ((kk & ~0xC) | ((kk & 4) << 1) | ((kk & 8) >> 1)), c = (sub & 3) * 32 + (lane & 3) * 8;
      vofs[i] = (unsigned)(k * ldk + c) * 2u; } }
  if constexpr (ROPEK) { const int row = wid * 8 + (lane >> 3), ch = (lane & 7) ^ ((row >> 1) & 7); krofs = (unsigned)(row * ldkr + ch * 8) * 2u; }
  const size_t tstepK = (size_t)KVBLK * ldk * 2, tstepKR = (size_t)KVBLK * ldkr * 2;
  const unsigned ldsK = RFLU(lds0 + OFF_K + (wid * 2) * 1024), ldsV = RFLU(lds0 + OFF_V + (wid * 2) * 1024), ldsKR = RFLU(lds0 + OFF_KR + wid * 1024);
#define RFL(x) ((unsigned)__builtin_amdgcn_readfirstlane((int)(x)))
#define DMA_K(t, b) do { const char* g_ = (const char*)Kh + (size_t)(t) * tstepK; \
    glds16x2(g_, kofs[0], kofs[1], ldsK + (b) * SHM_K, ldsK + (b) * SHM_K + 1024); \
    if constexpr (ROPEK) glds16s((const char*)KRh + (size_t)(t) * tstepKR, krofs, ldsKR + (b) * SHM_KR); } while (0)
#define DMA_V(t, b) do { const char* g_ = (const char*)Vh + (size_t)(t) * tstepK; \
    glds16x2i<128>(g_, vofs[0], ldsV + (b) * SHM_V, ldsV + (b) * SHM_V + 1024); } while (0)
#define RESC(a) do { if (__any((a) < 1.f)) { const int l_ = lane_id(), h_ = l_ >> 5; LAS float* alp = (LAS float*)(lds + OFF_WS) + wid * 64 + 32;     \
    if (h_ == 0) alp[l_ & 31] = (a); asm volatile("s_waitcnt lgkmcnt(0)" ::: "memory"); \
    _Pragma("unroll") for (int d = 0; d < 4; ++d) _Pragma("unroll") for (int r = 0; r < 16; ++r) o[d][r] *= alp[crow(r, h_)]; } } while (0)
#if ATT_NEGM
  f32x16 negm; _Pragma("unroll") for (int r = 0; r < 16; ++r) negm[r] = -m_reg;
#define QKT(P0, P1, b, tile) do { qkt_n<NQ, ROPEK>(P0, P1, negm, K_lds + (b) * SHM_K, KR_lds + (b) * SHM_KR, QR_lds, qr, r32, hi, kd0); \
    if constexpr (SWA) band_mask(P0, P1, kpos0 + (tile) * KVBLK, qpos, hi); } while (0)
#define PSM(P0, P1, MN, AL) partialSM_nn(P0, P1, negm, AL, l_reg, fast)
#else
#define QKT(P0, P1, b, tile) do { qkt<NQ, ROPEK>(P0, P1, K_lds + (b) * SHM_K, KR_lds + (b) * SHM_KR, QR_lds, qr, r32, hi, kd0); \
    if constexpr (SWA) band_mask(P0, P1, kpos0 + (tile) * KVBLK, qpos, hi); } while (0)
#define PSM(P0, P1, MN, AL) partialSM(P0, P1, m_reg, MN, AL, C, thr)
#endif
  f32x16 pA0, pA1, pB0, pB1; float mnA, mnB, alA, alB; bf16x8 pa0, pa1, pa2, pa3;
  DMA_K(0, 0); DMA_V(0, 0); DMA_K(1, 1);
  WAIT_BAR();
  bool fast = false;
  constexpr bool LMF = ATT_LMFMA && !SWA && (LMSEL) && (QKFSEL) && ATT_QKFIN && ATT_ILV;
  f32x16 Lacc = {};
#if ATT_NEGM && ATT_FASTREF
  if (!SWA && kmax2 >= 0.f) {
    float qn2 = qx2;
#pragma unroll
    for (int d0 = 0; d0 < NQ; ++d0) { f32x4 a, b; pg8::unpack8(__builtin_bit_cast(v4u, qr[d0]), a, b); qn2 += (a[0] * a[0] + a[1] * a[1]) + (a[2] * a[2] + a[3] * a[3]) + (b[0] * b[0] + b[1] * b[1]) + (b[2] * b[2] + b[3] * b[3]); }
    { auto rr = __builtin_amdgcn_permlane32_swap(__float_as_uint(qn2), __float_as_uint(qn2), false, false); qn2 = __uint_as_float(rr[0]) + __uint_as_float(rr[1]); }
    const float bnd = sqrtf(qn2 * kmax2) * 1.02f + 0.25f;
    fast = __all(bnd - m_reg <= 60.f && bnd + m_reg <= 100.f && (!(DUPSEL) || m_reg == 0.f)) != 0;
  }
#endif
#if ATT_NEGM && ATT_FASTREF && ATT_FASTDUP
  if constexpr (!SWA && (DUPSEL)) {
    if (fast) { qkt_n<NQ, ROPEK, true>(pA0, pA1, pA0, K_lds, KR_lds, QR_lds, qr, r32, hi, kd0); _Pragma("unroll") for (int r_ = 0; r_ < 16; ++r_) pA0[r_] = __builtin_amdgcn_exp2f(pA0[r_]); alA = 1.f;
      if constexpr (ATT_ILV2 != 0 && ATT_ILV != 0 && ATT_QKFIN && (QKFSEL)) { _Pragma("unroll") for (int r_ = 0; r_ < 16; ++r_) pA1[r_] = __builtin_amdgcn_exp2f(pA1[r_]); } }
    else { QKT(pA0, pA1, 0, 0); PSM(pA0, pA1, mnA, alA); }
  } else { QKT(pA0, pA1, 0, 0); PSM(pA0, pA1, mnA, alA); }
#else
  QKT(pA0, pA1, 0, 0); PSM(pA0, pA1, mnA, alA);
#endif
  WAIT_BAR();
  if (2 < NT) DMA_K(2, 0);
  DMA_V(1, 1);
#if ATT_NEGM
#define PSMF(FAST, P0, P1, AL) partialSM_nn(P0, P1, negm, AL, l_reg, FAST)
#else
#define PSMF(FAST, P0, P1, AL) PSM(P0, P1, mnA, AL)
#endif
#define RESCF(FAST, a) do { if (!(FAST)) RESC(a); } while (0)
#define PVPSM(ILV, BO, PN0, PN1, AL, FAST, PC0, PC1) do { if constexpr ((ILV) && ATT_ILV && ATT_ILV3 && !LMF && ATT_QKFIN && (QKFSEL)) { pv_d0_exp_sum<BO>(o, vb0, pa0, pa1, pa2, pa3, PN0, PC0, PC1, l_reg); AL = 1.f; } \
    else if constexpr ((ILV) && ATT_ILV) { pv_d0_exp<BO, LMF, (ATT_ILV2 != 0 && ATT_QKFIN && (QKFSEL))>(o, vb0, pa0, pa1, pa2, pa3, PN0, Lacc, PN1); AL = 1.f; } \
    else if constexpr (ILV) { pv_d0<BO>(o, vb0, pa0, pa1, pa2, pa3); _Pragma("unroll") for (int r_ = 0; r_ < 16; ++r_) PN0[r_] = __builtin_amdgcn_exp2f(PN0[r_]); AL = 1.f; } \
    else { pv_d0<BO>(o, vb0, pa0, pa1, pa2, pa3); PSMF(FAST, PN0, PN1, AL); } } while (0)
#define QKFIN(ILV, FAST, N0, N1, b, tile, P0, P1, AL) do { if constexpr ((ILV) && ATT_QKFIN && !SWA && (QKFSEL)) { \
      qkt_fin<NQ, ROPEK, (LMF || (ATT_ILV3 != 0 && ATT_ILV != 0)), (ATT_ILV2 != 0 && ATT_ILV != 0)>(N0, N1, K_lds + (b) * SHM_K, KR_lds + (b) * SHM_KR, QR_lds, qr, r32, hi, kd0, P0, P1, l_reg, pa0, pa1, pa2, pa3); } \
    else { if constexpr (ILV) { qkt_n<NQ, ROPEK, true>(N0, N1, pA0, K_lds + (b) * SHM_K, KR_lds + (b) * SHM_KR, QR_lds, qr, r32, hi, kd0); } else { QKT(N0, N1, b, tile); } \
      finishSM<ATT_LPART != 0>(P0, P1, (FAST) ? 1.f : AL, l_reg, pa0, pa1, pa2, pa3); } } while (0)
#define TILE_LOOP(FAST, ILV) do { \
  for (int j = 1; j + 1 < NT; j += 2) { \
      \
    SBAR(); QKFIN(ILV, FAST, pB0, pB1, 1, j, pA0, pA1, alA); SBAR(); \
    PVPSM(ILV, 0, pB0, pB1, alB, FAST, pA0, pA1); \
    WAIT_BAR(); \
    if (j + 2 < NT) DMA_K(j + 2, 1); \
    DMA_V(j + 1, 0);                                                \
    RESCF(FAST, alB); \
      \
    SBAR(); QKFIN(ILV, FAST, pA0, pA1, 0, j + 1, pB0, pB1, alB); SBAR(); \
    PVPSM(ILV, SHM_V, pA0, pA1, alA, FAST, pB0, pB1); \
    WAIT_BAR(); \
    if (j + 3 < NT) DMA_K(j + 3, 0); \
    if (j + 2 < NT) DMA_V(j + 2, 1); \
    RESCF(FAST, alA); \
  } \
    \
  SBAR(); QKFIN(ILV, FAST, pB0, pB1, 1, NT - 1, pA0, pA1, alA); SBAR(); \
  PVPSM(ILV, 0, pB0, pB1, alB, FAST, pA0, pA1); \
  WAIT_BAR(); RESCF(FAST, alB); \
  if constexpr ((ILV) && LMF) { finishSM<false, true, (ATT_ILV2 != 0 && ATT_ILV != 0)>(pB0, pB1, 1.f, l_reg, pa0, pa1, pa2, pa3); SBAR(); pv_d0_L<SHM_V>(o, vb0, pa0, pa1, pa2, pa3, Lacc); } \
  else if constexpr ((ILV) && ATT_ILV2 != 0 && ATT_ILV != 0 && ATT_QKFIN && (QKFSEL)) { finishSM<ATT_LPART != 0, false, true>(pB0, pB1, 1.f, l_reg, pa0, pa1, pa2, pa3); SBAR(); pv_d0<SHM_V>(o, vb0, pa0, pa1, pa2, pa3); } \
  else { finishSM<ATT_LPART != 0>(pB0, pB1, (FAST) ? 1.f : alB, l_reg, pa0, pa1, pa2, pa3); SBAR(); \
  pv_d0<SHM_V>(o, vb0, pa0, pa1, pa2, pa3); } } while (0)
  if (ATT_SPRIO && wid >= 4) __builtin_amdgcn_s_setprio(1);
#if ATT_NEGM && ATT_FASTREF && ATT_FASTDUP
  if constexpr (!SWA && (DUPSEL)) {
    if (fast) { TILE_LOOP(true, true);
      if constexpr (LMF) {
        LAS float* ll = (LAS float*)(lds + OFF_WS) + wid * 64 + 32;
        if (r32 == 0) { _Pragma("unroll") for (int r = 0; r < 16; ++r) ll[crow(r, hi)] = Lacc[r]; }
        asm volatile("s_waitcnt lgkmcnt(0)" ::: "memory");
        l_reg = ll[r32]; asm volatile("s_waitcnt lgkmcnt(0)" ::: "memory"); } }
    else { TILE_LOOP(false, false); m_reg = -negm[0]; } }
#ifdef PROBE_MLA_FASTONLY
  else { if constexpr (ROPEK) { TILE_LOOP(true, false); } else { TILE_LOOP(fast, false); } m_reg = -negm[0]; }
#else
  else { TILE_LOOP(fast, false); m_reg = -negm[0]; }
#endif
#else
  TILE_LOOP(fast, false); if (ATT_NEGM) m_reg = -negm[0];
#endif
#undef TILE_LOOP
#undef PVPSM
#undef QKFIN
#undef PSMF
#undef RESCF
  if (ATT_SPRIO) __builtin_amdgcn_s_setprio(0);
  if (ATT_LPART) { auto rr = __builtin_amdgcn_permlane32_swap(__float_as_uint(l_reg), __float_as_uint(l_reg), false, false); l_reg = __uint_as_float(rr[0]) + __uint_as_float(rr[1]); }
#undef RFL
#undef DMA_K
#undef DMA_V
#undef RESC
#undef QKT
#undef PSM
}

template <int NQ, bool ROPEK, bool SWA>
__device__ __forceinline__ void attn_core_stag(LAS char* lds, const bf16x8 (&qr)[NQ],
                                               const bf16* __restrict__ Kh, const bf16* __restrict__ Vh, const int ldk, const bf16* __restrict__ KRh, const int ldkr,
                                               const int NT, const float C, const float thr, const int kd0, const int qpos, const int kpos0,
                                               f32x16 (&o)[4], float& m_reg, float& l_reg, const int wv, unsigned* stamp = nullptr) {
  const int tid = opq_tid(wv), lane = tid & 63, r32 = lane & 31, hi = lane >> 5;
  const int wid = __builtin_amdgcn_readfirstlane(tid >> 6);
  const int half = wid >> 2;
#ifdef PROBE_STAMP
  unsigned long long tM = 0, tMb = 0, tV = 0, tVb = 0, t0_, t1_;
#define STAMP0() (t0_ = __builtin_amdgcn_s_memtime())
#define STAMP1(acc) do { t1_ = __builtin_amdgcn_s_memtime(); acc += t1_ - t0_; t0_ = t1_; } while (0)
#else
#define STAMP0() do {} while (0)
#define STAMP1(acc) do {} while (0)
#endif
  LAS char* K_lds = lds + OFF_K; LAS char* KR_lds = lds + OFF_KR;
  LAS float* al_l = (LAS float*)(lds + OFF_WS) + wid * 64 + 32;
  const LAS char* QR_lds = lds + OFF_QR + wid * 4096 + lane * 16;
  const unsigned lds0 = (unsigned)(uintptr_t)lds;
  const int vb0 = (int)lds0 + OFF_V + v_rd_base(lane);
  unsigned kofs[2], vofs[2], krofs = 0u;
#pragma unroll
  for (int i = 0; i < 2; ++i) { const int p = wid * 2 + i;
    { const int row = p * 4 + (lane >> 4), ch = (lane & 15) ^ (row & KSW_MASK); kofs[i] = (unsigned)(row * ldk + ch * 8) * 2u; }
    { const int sub = 2 * p + (lane >> 5), kk = (sub >> 2) * 8 + ((lane & 31) >> 2), k = ATT_NOSWAP ? kk : ((kk & ~0xC) | ((kk & 4) << 1) | ((kk & 8) >> 1)), c = (sub & 3) * 32 + (lane & 3) * 8;
      vofs[i] = (unsigned)(k * ldk + c) * 2u; } }
  if constexpr (ROPEK) { const int row = wid * 8 + (lane >> 3), ch = (lane & 7) ^ ((row >> 1) & 7); krofs = (unsigned)(row * ldkr + ch * 8) * 2u; }
  const size_t tstepK = (size_t)KVBLK * ldk * 2, tstepKR = (size_t)KVBLK * ldkr * 2;
  const unsigned ldsK = RFLU(lds0 + OFF_K + (wid * 2) * 1024), ldsV = RFLU(lds0 + OFF_V + (wid * 2) * 1024), ldsKR = RFLU(lds0 + OFF_KR + wid * 1024);
#define RFL(x) ((unsigned)__builtin_amdgcn_readfirstlane((int)(x)))
#define DMA_K(t, b) do { const char* g_ = (const char*)Kh + (size_t)(t) * tstepK; \
    glds16x2(g_, kofs[0], kofs[1], ldsK + (b) * SHM_K, ldsK + (b) * SHM_K + 1024); \
    if constexpr (ROPEK) glds16s((const char*)KRh + (size_t)(t) * tstepKR, krofs, ldsKR + (b) * SHM_KR); } while (0)
#define DMA_V(t, b) do { const char* g_ = (const char*)Vh + (size_t)(t) * tstepK; \
    glds16x2(g_, vofs[0], vofs[1], ldsV + (b) * SHM_V, ldsV + (b) * SHM_V + 1024); } while (0)
#define DMA_EVEN(j) do { if ((j) + 1 < NT) DMA_K((j) + 1, ((j) + 1) & 1); if ((j) < NT) DMA_V((j), (j) & 1); } while (0)
#define SEG_BAR() do { SBAR(); asm volatile("s_waitcnt lgkmcnt(0)\n\ts_barrier" ::: "memory"); SBAR(); } while (0)
#define SEG_WBAR() do { SBAR(); asm volatile("s_waitcnt vmcnt(0) lgkmcnt(0)\n\ts_barrier" ::: "memory"); SBAR(); } while (0)
  f32x16 s0, s1; float mn, al; bf16x8 pa0, pa1, pa2, pa3;
  DMA_K(0, 0); DMA_V(0, 0); if (1 < NT) DMA_K(1, 1);
  SEG_WBAR();
  if (half == 1) SEG_BAR();
  for (int k = 0; k < NT; ++k) {
    STAMP0();
    if (half == 0 && k >= 1) DMA_EVEN(k);
    { const int vbk = vb0 + ((k - 1) & 1) * SHM_V; s16x4 va[8], vc[8];
      if (k >= 1) trd8<0>(va, vbk);
      SBAR(); qkt<NQ, ROPEK>(s0, s1, K_lds + (k & 1) * SHM_K, KR_lds + (k & 1) * SHM_KR, QR_lds, qr, r32, hi, kd0); SBAR();
      if (k >= 1) { trd8<1>(vc, vbk); LGKM_WAIT(8); pv4(o[0], va, pa0, pa1, pa2, pa3); SBAR();
                    trd8<2>(va, vbk); LGKM_WAIT(8); pv4(o[1], vc, pa0, pa1, pa2, pa3); SBAR();
                    trd8<3>(vc, vbk); LGKM_WAIT(8); pv4(o[2], va, pa0, pa1, pa2, pa3); SBAR();
                    LGKM_WAIT(0); pv4(o[3], vc, pa0, pa1, pa2, pa3); } }
    asm volatile("s_nop 15\n\ts_nop 15" ::: "memory"); STAMP1(tM);
    if (half == 1) SEG_WBAR(); else SEG_BAR();
    STAMP1(tMb);
    if (half == 1) DMA_EVEN(k + 1);
    if constexpr (SWA) band_mask(s0, s1, kpos0 + k * KVBLK, qpos, hi);
    partialSM(s0, s1, m_reg, mn, al, C, thr);
    if (__any(al < 1.f)) { if (hi == 0) al_l[r32] = al; asm volatile("s_waitcnt lgkmcnt(0)" ::: "memory");
#pragma unroll
      for (int d = 0; d < 4; ++d)
#pragma unroll
        for (int r = 0; r < 16; ++r) o[d][r] *= al_l[crow(r, hi)]; }
    finishSM(s0, s1, al, l_reg, pa0, pa1, pa2, pa3);
    asm volatile("" : "+v"(pa0), "+v"(pa1), "+v"(pa2), "+v"(pa3)); STAMP1(tV);
    if (half == 0) SEG_WBAR(); else SEG_BAR();
    STAMP1(tVb);
  }
#ifdef PROBE_STAMP
  if (stamp && blockIdx.x == 0 && (wid == 0 || wid == 4) && lane == 0) { unsigned* q = stamp + (wid == 0 ? 0 : 4);
    atomicAdd(q + 0, (unsigned)(tM / NT)); atomicAdd(q + 1, (unsigned)(tMb / NT)); atomicAdd(q + 2, (unsigned)(tV / NT)); atomicAdd(q + 3, (unsigned)(tVb / NT)); }
#endif
  pv_d0(o, vb0 + ((NT - 1) & 1) * SHM_V, pa0, pa1, pa2, pa3);
  SEG_BAR();
  if (half == 0) SEG_BAR();
#undef RFL
#undef DMA_K
#undef DMA_V
#undef DMA_EVEN
#undef SEG_BAR
#undef SEG_WBAR
}

template <int NQ, bool ROPEK, bool SWA>
__device__ __forceinline__ void attn_core_hs(LAS char* lds, const bf16x8 (&qr)[NQ],
                                             const bf16* __restrict__ Kh, const bf16* __restrict__ Vh, const int ldk, const bf16* __restrict__ KRh, const int ldkr,
                                             const int NT, const float C, const float thr, const int kd0, const int qpos, const int kpos0,
                                             f32x16 (&o)[4], float& m_reg, float& l_reg, const int wv) {
  const int tid = opq_tid(wv), lane = tid & 63, r32 = lane & 31, hi = lane >> 5;
  const int wid = __builtin_amdgcn_readfirstlane(tid >> 6);
  const int half = wid >> 2;
  LAS char* K_lds = lds + OFF_K; LAS char* KR_lds = lds + OFF_KR;
  LAS float* al_l = (LAS float*)(lds + OFF_WS) + wid * 64 + 32;
  const LAS char* QR_lds = lds + OFF_QR + wid * 4096 + lane * 16;
  const unsigned lds0 = (unsigned)(uintptr_t)lds;
  const int vb0 = (int)lds0 + OFF_V + v_rd_base(lane);
  unsigned kofs[2], vofs[2], krofs = 0u;
#pragma unroll
  for (int i = 0; i < 2; ++i) { const int p = wid * 2 + i;
    { const int row = p * 4 + (lane >> 4), ch = (lane & 15) ^ (row & KSW_MASK); kofs[i] = (unsigned)(row * ldk + ch * 8) * 2u; }
    { const int sub = 2 * p + (lane >> 5), kk = (sub >> 2) * 8 + ((lane & 31) >> 2), k = ATT_NOSWAP ? kk : ((kk & ~0xC) | ((kk & 4) << 1) | ((kk & 8) >> 1)), c = (sub & 3) * 32 + (lane & 3) * 8;
      vofs[i] = (unsigned)(k * ldk + c) * 2u; } }
  if constexpr (ROPEK) { const int row = wid * 8 + (lane >> 3), ch = (lane & 7) ^ ((row >> 1) & 7); krofs = (unsigned)(row * ldkr + ch * 8) * 2u; }
  const size_t tstepK = (size_t)KVBLK * ldk * 2, tstepKR = (size_t)KVBLK * ldkr * 2;
  const unsigned ldsK = RFLU(lds0 + OFF_K + (wid * 2) * 1024), ldsV = RFLU(lds0 + OFF_V + (wid * 2) * 1024), ldsKR = RFLU(lds0 + OFF_KR + wid * 1024);
#define DMA_K(t, b) do { const char* g_ = (const char*)Kh + (size_t)(t) * tstepK; \
    glds16x2(g_, kofs[0], kofs[1], ldsK + (b) * SHM_K, ldsK + (b) * SHM_K + 1024); \
    if constexpr (ROPEK) glds16s((const char*)KRh + (size_t)(t) * tstepKR, krofs, ldsKR + (b) * SHM_KR); } while (0)
#define DMA_V(t, b) do { const char* g_ = (const char*)Vh + (size_t)(t) * tstepK; \
    glds16x2(g_, vofs[0], vofs[1], ldsV + (b) * SHM_V, ldsV + (b) * SHM_V + 1024); } while (0)
#define RESC(a) do { if (__any((a) < 1.f)) { if (hi == 0) al_l[r32] = (a); asm volatile("s_waitcnt lgkmcnt(0)" ::: "memory"); \
    _Pragma("unroll") for (int d = 0; d < 4; ++d) _Pragma("unroll") for (int r = 0; r < 16; ++r) o[d][r] *= al_l[crow(r, hi)]; } } while (0)
#define QKT(P0, P1, b, tile) do { qkt<NQ, ROPEK>(P0, P1, K_lds + (b) * SHM_K, KR_lds + (b) * SHM_KR, QR_lds, qr, r32, hi, kd0); \
    if constexpr (SWA) band_mask(P0, P1, kpos0 + (tile) * KVBLK, qpos, hi); } while (0)
#define BAR_ISSUE(j, vw) do { SBAR(); WAIT_BAR(); if ((j) + 2 < NT) DMA_K((j) + 2, (j) & 1); if ((j) + 1 < NT) DMA_V((j) + 1, (vw)); SBAR(); } while (0)
  f32x16 pA0, pA1, pB0, pB1; float mnA, mnB, alA, alB; bf16x8 pa0, pa1, pa2, pa3;
  DMA_K(0, 0); DMA_V(0, 0); DMA_K(1, 1);
  WAIT_BAR();
  QKT(pA0, pA1, 0, 0);
  if (half == 1) BAR_ISSUE(0, 1);
  partialSM(pA0, pA1, m_reg, mnA, alA, C, thr);
  if (half == 0) BAR_ISSUE(0, 1);
  int vr = 0;
  for (int j = 1; j + 1 < NT; j += 2) {
    { const int vw = vr == 0 ? 2 : vr - 1;
      SBAR(); QKT(pB0, pB1, 1, j);
      finishSM(pA0, pA1, alA, l_reg, pa0, pa1, pa2, pa3);
      if (half == 1) BAR_ISSUE(j, vw);
      SBAR(); pv_d0(o, vb0 + vr * SHM_V, pa0, pa1, pa2, pa3); partialSM(pB0, pB1, m_reg, mnB, alB, C, thr);
      if (half == 0) BAR_ISSUE(j, vw);
      RESC(alB); vr = vr == 2 ? 0 : vr + 1; }
    { const int vw = vr == 0 ? 2 : vr - 1;
      SBAR(); QKT(pA0, pA1, 0, j + 1);
      finishSM(pB0, pB1, alB, l_reg, pa0, pa1, pa2, pa3);
      if (half == 1) BAR_ISSUE(j + 1, vw);
      SBAR(); pv_d0(o, vb0 + vr * SHM_V, pa0, pa1, pa2, pa3); partialSM(pA0, pA1, m_reg, mnA, alA, C, thr);
      if (half == 0) BAR_ISSUE(j + 1, vw);
      RESC(alA); vr = vr == 2 ? 0 : vr + 1; }
  }
  { const int vw = vr == 0 ? 2 : vr - 1;
    SBAR(); QKT(pB0, pB1, 1, NT - 1);
    finishSM(pA0, pA1, alA, l_reg, pa0, pa1, pa2, pa3);
    if (half == 1) BAR_ISSUE(NT - 1, vw);
    SBAR(); pv_d0(o, vb0 + vr * SHM_V, pa0, pa1, pa2, pa3); partialSM(pB0, pB1, m_reg, mnB, alB, C, thr);
    if (half == 0) BAR_ISSUE(NT - 1, vw);
    RESC(alB); vr = vr == 2 ? 0 : vr + 1; }
  finishSM(pB0, pB1, alB, l_reg, pa0, pa1, pa2, pa3); SBAR();
  pv_d0(o, vb0 + vr * SHM_V, pa0, pa1, pa2, pa3);
  SBAR(); asm volatile("s_waitcnt lgkmcnt(0)\n\ts_barrier" ::: "memory"); SBAR();
#undef DMA_K
#undef DMA_V
#undef RESC
#undef QKT
#undef BAR_ISSUE
}

__device__ __forceinline__ void store_o(LAS char* lds, const f32x16 (&o)[4], float l_reg, bf16* Ow, const int ldo, const int wv) {
  const int tid = opq_tid(wv), lane = tid & 63, r32 = lane & 31, hi = lane >> 5; const int wid = __builtin_amdgcn_readfirstlane(tid >> 6);
  LAS float* li_l = (LAS float*)(lds + OFF_WS) + wid * 64;
  if (hi == 0) li_l[r32] = l_reg; asm volatile("s_waitcnt lgkmcnt(0)" ::: "memory");
  float rli[16];
#pragma unroll
  for (int r = 0; r < 16; ++r) rli[r] = __builtin_amdgcn_rcpf(li_l[crow(r, hi)]);
#pragma unroll
  for (int r = 0; r < 16; ++r) { const int orow = crow(r, hi);
#pragma unroll
    for (int d0 = 0; d0 < 4; ++d0) Ow[(long)orow * ldo + d0 * 32 + r32] = (bf16)f2bf(o[d0][r] * rli[r]); }
}
}
struct Frame {
    LAS unsigned char* lds;
    volatile LAS unsigned* MISC;
    gu32* ctl;
    int tid, lane, wave;
    int vcu, G;
};

struct WItem { const float* W; bf16* WT; int N, K, k0, n0, drow0; float* cm; };
struct WSrc { const float *w_in, *w_uq, *w_ukv, *w_br, *w_bg, *w_o, *w_fi, *w_fo, *w_ple, *w_pg; float* cm; };
constexpr int IT_IN = 146 * 32, IT_BG = 4 * 64 * 32, IT_UQ = 24 * 8, IT_UKV = 32 * 8, IT_BR = 4 * 64 * 8, IT_WO = 64 * 32, IT_FI = 352 * 32, IT_FO = 64 * 88, IT_PLE = 64 * 4, IT_PG = 64 * 32;
constexpr int IT_LAYER = IT_IN + IT_BG + IT_UQ + IT_UKV + IT_BR + IT_WO + IT_FI + IT_FO + IT_PLE + IT_PG;
__device__ __forceinline__ WItem witem(const WSrc& ws, bf16* WL, int L, int r) {
    if (r < IT_IN) { const int kb = r / 146, nb = r % 146; return WItem{ws.w_in + (size_t)L * D * ZC, WL + WL_W1, ZC, D, 64 * kb, 32 * nb, 32 * nb, nullptr}; } r -= IT_IN;
    if (r < IT_BG) { const int j = r / (64 * 32), q = r % (64 * 32), kb = q / 64, nb = q % 64; if (GATES_I8) return WItem{ws.w_bg + ((size_t)L * 4 + j) * D * D, WL + WL_W1 + (size_t)ZP * D, D, D, 64 * kb, 32 * nb, j * D + 32 * nb, ws.cm + (L * 5 + j) * D};
        return WItem{ws.w_bg + ((size_t)L * 4 + j) * D * D, WL + WL_W1, D, D, 64 * kb, 32 * nb, ZP + j * D + 32 * nb, nullptr}; } r -= IT_BG;
    if (r < IT_UQ) { const int kb = r / 24, nb = r % 24; return WItem{ws.w_uq + (size_t)L * 512 * 768, WL + WL_UQKV, 768, 512, 64 * kb, 32 * nb, 32 * nb, nullptr}; } r -= IT_UQ;
    if (r < IT_UKV) { const int kb = r / 32, nb = r % 32; return WItem{ws.w_ukv + (size_t)L * 512 * 1024, WL + WL_UQKV, 1024, 512, 64 * kb, 32 * nb, 768 + 32 * nb, nullptr}; } r -= IT_UKV;
    if (r < IT_BR) { const int j = r / (64 * 8), q = r % (64 * 8), kb = q / 64, nb = q % 64; return WItem{ws.w_br + ((size_t)L * 4 + j) * 512 * D, WL + WL_BR + (size_t)j * D * 512, D, 512, 64 * kb, 32 * nb, 32 * nb, nullptr}; } r -= IT_BR;
    if (r < IT_WO) { const int kb = r / 64, nb = r % 64; return WItem{ws.w_o + (size_t)L * D * D, WL + WL_WO, D, D, 64 * kb, 32 * nb, 32 * nb, nullptr}; } r -= IT_WO;
    if (r < IT_FI) { const int kb = r / 352, nb = r % 352; const int c0 = 32 * nb; const int up = c0 >= FF ? 1 : 0, cc = c0 - up * FF;
        return WItem{ws.w_fi + (size_t)L * D * 2 * FF, WL + WL_FI, 2 * FF, D, 64 * kb, c0, (cc >> 7) * 256 + up * 128 + (cc & 127), (GATES_I8 && FFN_I8) ? ws.cm + (CW_CMF - CW_CM) + L * 2 * FF : nullptr}; } r -= IT_FI;
    if (r < IT_FO) { const int kb = r / 64, nb = r % 64; return WItem{ws.w_fo + (size_t)L * FF * D, WL + WL_FO, D, FF, 64 * kb, 32 * nb, 32 * nb, nullptr}; } r -= IT_FO;
    if (r < IT_PLE) { const int kb = r / 64, nb = r % 64; return WItem{ws.w_ple + (size_t)L * PLE * D, WL + WL_PLE, D, PLE, 64 * kb, 32 * nb, 32 * nb, nullptr}; } r -= IT_PLE;
    { const int kb = r / 64, nb = r % 64; return WItem{ws.w_pg + (size_t)L * D * D, WL + WL_PG, D, D, 64 * kb, 32 * nb, 32 * nb, GATES_I8 ? ws.cm + (L * 5 + 4) * D : nullptr}; }
}
struct WRegs { f32x4 v[8]; };
__device__ __forceinline__ WRegs witem_load(const WItem& it, int lane) { WRegs r; const int lr = lane >> 3, lc = (lane & 7) * 4;
#pragma unroll
    for (int i = 0; i < 8; ++i) r.v[i] = *(const f32x4*)(it.W + (size_t)(it.k0 + 8 * i + lr) * it.N + it.n0 + lc);
    return r; }
__device__ __forceinline__ void witem_store(const WItem& it, const WRegs& r, LAS float* scr, int lane) {
    const int lr = lane >> 3, lc = (lane & 7) * 4;
#pragma unroll
    for (int i = 0; i < 8; ++i) { LAS float* s = scr + (8 * i + lr) * 33 + lc; s[0] = r.v[i][0]; s[1] = r.v[i][1]; s[2] = r.v[i][2]; s[3] = r.v[i][3]; }
    LDS_WAIT(); asm volatile("" ::: "memory");
    const int c = lane & 7;
    if (it.cm) {
        unsigned char* W8 = (unsigned char*)it.WT;
#pragma unroll
        for (int j = 0; j < 4; ++j) { const int n = (lane >> 3) + 8 * j; const LAS float* s = scr + (8 * c) * 33 + n; const float cmx = it.cm[it.n0 + n]; const float q = cmx > 0.f ? 127.0f / cmx : 0.f;
            v2u o; o.x = pk4_i8(q * s[0 * 33], q * s[1 * 33], q * s[2 * 33], q * s[3 * 33]); o.y = pk4_i8(q * s[4 * 33], q * s[5 * 33], q * s[6 * 33], q * s[7 * 33]);
            *(v2u*)(W8 + (size_t)(it.drow0 + n) * it.K + it.k0 + 8 * c) = o; }
    } else {
#pragma unroll
        for (int j = 0; j < 4; ++j) { const int n = (lane >> 3) + 8 * j; const LAS float* s = scr + (8 * c) * 33 + n;
            v4u o; o.x = pk2(s[0 * 33], s[1 * 33]); o.y = pk2(s[2 * 33], s[3 * 33]); o.z = pk2(s[4 * 33], s[5 * 33]); o.w = pk2(s[6 * 33], s[7 * 33]);
            *(v4u*)(it.WT + (size_t)(it.drow0 + n) * it.K + it.k0 + 8 * c) = o; }
    }
    LDS_WAIT(); asm volatile("" ::: "memory");
}
__device__ __forceinline__ void witem_colmax(const WItem& it, const WRegs& r, int lane) {
    f32x4 m = (f32x4){0.f, 0.f, 0.f, 0.f};
#pragma unroll
    for (int i = 0; i < 8; ++i) { m[0] = fmaxf(m[0], fabsf(r.v[i][0])); m[1] = fmaxf(m[1], fabsf(r.v[i][1])); m[2] = fmaxf(m[2], fabsf(r.v[i][2])); m[3] = fmaxf(m[3], fabsf(r.v[i][3])); }
#pragma unroll
    for (int e = 0; e < 4; ++e) { float v = m[e]; v = fmaxf(v, shx<8>(v)); v = fmaxf(v, shx<16>(v));
        auto rr = __builtin_amdgcn_permlane32_swap(__float_as_uint(v), __float_as_uint(v), false, false); m[e] = fmaxf(__uint_as_float(rr[0]), __uint_as_float(rr[1])); }
    if (lane < 8) {
#pragma unroll
        for (int e = 0; e < 4; ++e) atomicMax((unsigned*)it.cm + it.n0 + 4 * lane + e, __float_as_uint(m[e])); }
}

#ifndef THIN_XAL
#define THIN_XAL 0
#endif
#ifndef THIN_NT
#define THIN_NT 1
#endif
#if THIN_NT
#define XLD(p) __builtin_nontemporal_load(p)
#define XST(p, v) __builtin_nontemporal_store(v, p)
#else
#define XLD(p) (*(p))
#define XST(p, v) (*(p) = (v))
#endif
#ifndef THIN_NTH
#define THIN_NTH 0
#endif
#if THIN_NTH
#define HST(p, v) __builtin_nontemporal_store(v, p)
#else
#define HST(p, v) (*(p) = (v))
#endif
template <int MODE, bool Y2 = false>
__device__ __forceinline__ void thin_phase(Frame& F, const float* __restrict__ xin, const bf16* __restrict__ y, float* __restrict__ x, bf16* __restrict__ h,
                                           const float* __restrict__ gpost, const float* __restrict__ gpre, unsigned char* __restrict__ h8 = nullptr, float* __restrict__ sa8 = nullptr,
                                           const bool wx = true, const bf16* __restrict__ y2 = nullptr, const float* __restrict__ gpost2 = nullptr) {
    const int tid_ = opq_tid(F.wave), lane = tid_ & 63, wave_ = __builtin_amdgcn_readfirstlane(tid_ >> 6);
    const int gw = F.vcu * NWAVES + wave_, NGW = F.G * NWAVES;
    const bool xal = THIN_XAL && NGW == 2048 && S == 16384;
    const int rw0 = xal ? (gw >> 8) * 2048 + (gw & 255) : gw, rstep = xal ? 256 : NGW, rend = xal ? (gw >> 8) * 2048 + 2048 : S;
    f32x4 gp[8], gq[8];
#pragma unroll
    for (int j = 0; j < 8; ++j) { gp[j] = (MODE >= 1) ? *(const f32x4*)(gpost + 256 * j + 4 * lane) : (f32x4){0.f, 0.f, 0.f, 0.f};
                                  gq[j] = (MODE <= 1 || MODE == 4) ? *(const f32x4*)(gpre + 256 * j + 4 * lane) : (f32x4){0.f, 0.f, 0.f, 0.f}; }
    const float* const xsrc = (MODE == 0 || MODE == 4 || xin != nullptr) ? xin : x;
    f32x4 v[8]; v2u yw[8], yw2[8];
    if (rw0 < rend) {
#pragma unroll
        for (int j = 0; j < 8; ++j) v[j] = XLD((const f32x4*)(xsrc + (size_t)rw0 * D + 4 * lane + 256 * j));
        if constexpr (MODE >= 1) {
#pragma unroll
            for (int j = 0; j < 8; ++j) yw[j] = *(const v2u*)(y + (size_t)rw0 * D + 4 * lane + 256 * j); }
        if constexpr (Y2) {
#pragma unroll
            for (int j = 0; j < 8; ++j) yw2[j] = *(const v2u*)(y2 + (size_t)rw0 * D + 4 * lane + 256 * j); }
    }
    for (int row = rw0; row < rend; row += rstep) {
        const int nrow = row + rstep; const bool more = nrow < rend;
        f32x4 vn[8]; v2u ywn[8];
        if constexpr (!Y2) {
#pragma unroll
            for (int j = 0; j < 8; ++j) { vn[j] = v[j]; ywn[j] = (MODE >= 1) ? yw[j] : (v2u){0u, 0u}; }
            if (more) {
#pragma unroll
                for (int j = 0; j < 8; ++j) vn[j] = XLD((const f32x4*)(xsrc + (size_t)nrow * D + 4 * lane + 256 * j));
                if constexpr (MODE >= 1) {
#pragma unroll
                    for (int j = 0; j < 8; ++j) ywn[j] = *(const v2u*)(y + (size_t)nrow * D + 4 * lane + 256 * j); }
            }
        } else if (row != rw0) {
#pragma unroll
            for (int j = 0; j < 8; ++j) v[j] = XLD((const f32x4*)(xsrc + (size_t)row * D + 4 * lane + 256 * j));
#pragma unroll
            for (int j = 0; j < 8; ++j) yw[j] = *(const v2u*)(y + (size_t)row * D + 4 * lane + 256 * j);
#pragma unroll
            for (int j = 0; j < 8; ++j) yw2[j] = *(const v2u*)(y2 + (size_t)row * D + 4 * lane + 256 * j);
        }
        if constexpr (MODE >= 1) {
            f32x4 yv[8]; float s = 0.f;
#pragma unroll
            for (int j = 0; j < 8; ++j) { const v2u w = yw[j]; yv[j] = (f32x4){bflo(w.x), bfhi(w.x), bflo(w.y), bfhi(w.y)};
                s += (yv[j][0] * yv[j][0] + yv[j][1] * yv[j][1]) + (yv[j][2] * yv[j][2] + yv[j][3] * yv[j][3]); }
            const float rstd = 1.0f / sqrtf(wave_sum(s) * (1.0f / D) + RMS_EPS);
#pragma unroll
            for (int j = 0; j < 8; ++j) v[j] += yv[j] * rstd * gp[j];
        }
        if constexpr (Y2) {
            f32x4 yv[8]; float s = 0.f;
#pragma unroll
            for (int j = 0; j < 8; ++j) { const v2u w = yw2[j]; yv[j] = (f32x4){bflo(w.x), bfhi(w.x), bflo(w.y), bfhi(w.y)};
                s += (yv[j][0] * yv[j][0] + yv[j][1] * yv[j][1]) + (yv[j][2] * yv[j][2] + yv[j][3] * yv[j][3]); }
            const float rstd = 1.0f / sqrtf(wave_sum(s) * (1.0f / D) + RMS_EPS);
#pragma unroll
            for (int j = 0; j < 8; ++j) v[j] += yv[j] * rstd * *(const f32x4*)(gpost2 + 256 * j + 4 * lane);
        }
        if (wx) { float* xo = x + (size_t)row * D + 4 * lane;
#pragma unroll
            for (int j = 0; j < 8; ++j) XST((f32x4*)(xo + 256 * j), v[j]); }
        if constexpr (MODE <= 1 || MODE == 4) {
            float s = 0.f;
#pragma unroll
            for (int j = 0; j < 8; ++j) s += (v[j][0] * v[j][0] + v[j][1] * v[j][1]) + (v[j][2] * v[j][2] + v[j][3] * v[j][3]);
            const float rstd = 1.0f / sqrtf(wave_sum(s) * (1.0f / D) + RMS_EPS);
            bf16* hr = h + (size_t)row * D + 4 * lane;
            float amax = 0.f;
#pragma unroll
            for (int j = 0; j < 8; ++j) { const f32x4 t = v[j] * rstd * gq[j]; v[j] = t; if (h) { v2u w; w.x = pk2(t[0], t[1]); w.y = pk2(t[2], t[3]); HST((v2u*)(hr + 256 * j), w); }
                amax = fmaxf(fmaxf(amax, fmaxf(fabsf(t[0]), fabsf(t[1]))), fmaxf(fabsf(t[2]), fabsf(t[3]))); }
            if (h8) { amax = wave_max(amax); const float q = amax > 0.f ? 127.0f / amax : 0.f; if (lane == 0) sa8[row] = amax * (1.0f / 127.0f);
#pragma unroll
                for (int j = 0; j < 8; ++j) HST((unsigned*)(h8 + (size_t)row * D + 4 * lane + 256 * j), pk4_i8(q * v[j][0], q * v[j][1], q * v[j][2], q * v[j][3])); }
        }
        if constexpr (MODE == 2) {
            if (h8) { float amax = 0.f;
#pragma unroll
                for (int j = 0; j < 8; ++j) amax = fmaxf(fmaxf(amax, fmaxf(fabsf(v[j][0]), fabsf(v[j][1]))), fmaxf(fabsf(v[j][2]), fabsf(v[j][3])));
                amax = wave_max(amax); const float q = amax > 0.f ? 127.0f / amax : 0.f; if (lane == 0) sa8[row] = amax * (1.0f / 127.0f);
#pragma unroll
                for (int j = 0; j < 8; ++j) HST((unsigned*)(h8 + (size_t)row * D + 4 * lane + 256 * j), pk4_i8(q * v[j][0], q * v[j][1], q * v[j][2], q * v[j][3]));
            } else { bf16* hr = h + (size_t)row * D + 4 * lane;
#pragma unroll
                for (int j = 0; j < 8; ++j) { v2u w; w.x = pk2(v[j][0], v[j][1]); w.y = pk2(v[j][2], v[j][3]); *(v2u*)(hr + 256 * j) = w; } }
        }
#pragma unroll
        for (int j = 0; j < 8; ++j) { if constexpr (!Y2) { v[j] = vn[j]; if constexpr (MODE >= 1) yw[j] = ywn[j]; } }
    }
}

struct PrepP { bf16* Z; const float *c64, *s64, *c128, *s128; const float *qa, *kva, *axq, *axk; };
struct Sp2 { unsigned w1, w2; };
__device__ __forceinline__ Sp2 span64_load(const bf16* zr, int base, int lane, bool active) {
    const int col = base + (lane >> 4) * 64 + 2 * (lane & 15); Sp2 r{0u, 0u};
    if (active) { r.w1 = *(const unsigned*)(zr + col); r.w2 = *(const unsigned*)(zr + col + 32); } return r; }
template <bool NORM>
__device__ __forceinline__ void span64_apply(bf16* zr, int base, const Sp2 in, const float* c64, const float* s64, int pos_e, int pos_o, const float* g, int lane, bool active) {
    const int chunk = lane >> 4, jp = lane & 15, col = base + chunk * 64 + 2 * jp;
    float a0 = bflo(in.w1), a1 = bfhi(in.w1), b0 = bflo(in.w2), b1 = bfhi(in.w2);
    if constexpr (NORM) {
        const float s = sum32((a0 * a0 + a1 * a1) + (b0 * b0 + b1 * b1));
        const float rstd = 1.0f / sqrtf(s * (1.0f / 128.0f) + RMS_EPS);
        const int gi = (chunk & 1) * 64 + 2 * jp;
        a0 *= rstd * g[gi]; a1 *= rstd * g[gi + 1]; b0 *= rstd * g[gi + 32]; b1 *= rstd * g[gi + 33];
    }
    const int pos = (chunk & 1) ? pos_o : pos_e;
    const f32x2 c = *(const f32x2*)(c64 + (size_t)pos * 32 + 2 * jp), s = *(const f32x2*)(s64 + (size_t)pos * 32 + 2 * jp);
    const float n0 = a0 * c[0] - b0 * s[0], n1 = a1 * c[1] - b1 * s[1], m0 = b0 * c[0] + a0 * s[0], m1 = b1 * c[1] + a1 * s[1];
    if (active) { *(unsigned*)(zr + col) = pk2(n0, n1); *(unsigned*)(zr + col + 32) = pk2(m0, m1); }
}
__device__ __forceinline__ Sp2 span128_load(const bf16* zr, int base, int lane) { const int col = base + (lane >> 5) * 128 + 2 * (lane & 31); return Sp2{*(const unsigned*)(zr + col), *(const unsigned*)(zr + col + 64)}; }
__device__ __forceinline__ void span128_apply(bf16* zr, int base, const Sp2 in, const float* c128, const float* s128, int pos, int lane) {
    const int head = lane >> 5, jp = lane & 31, col = base + head * 128 + 2 * jp;
    const float a0 = bflo(in.w1), a1 = bfhi(in.w1), b0 = bflo(in.w2), b1 = bfhi(in.w2);
    const f32x2 c = *(const f32x2*)(c128 + (size_t)pos * 64 + 2 * jp), s = *(const f32x2*)(s128 + (size_t)pos * 64 + 2 * jp);
    *(unsigned*)(zr + col) = pk2(a0 * c[0] - b0 * s[0], a1 * c[1] - b1 * s[1]);
    *(unsigned*)(zr + col + 64) = pk2(b0 * c[0] + a0 * s[0], b1 * c[1] + a1 * s[1]);
}
__device__ __forceinline__ void latent_apply(bf16* zr, int base, const v4u w, const float* g, int lane) {
    f32x4 a, b; pg8::unpack8(w, a, b);
    float s = (a[0] * a[0] + a[1] * a[1]) + (a[2] * a[2] + a[3] * a[3]) + (b[0] * b[0] + b[1] * b[1]) + (b[2] * b[2] + b[3] * b[3]);
    const float rstd = 1.0f / sqrtf(wave_sum(s) * (1.0f / 512.0f) + RMS_EPS);
    const f32x4 g0 = *(const f32x4*)(g + 8 * lane), g1 = *(const f32x4*)(g + 8 * lane + 4);
    a = a * rstd * g0; b = b * rstd * g1;
    v4u o; o.x = pk2(a[0], a[1]); o.y = pk2(a[2], a[3]); o.z = pk2(b[0], b[1]); o.w = pk2(b[2], b[3]);
    *(v4u*)(zr + base + 8 * lane) = o;
}
__device__ __forceinline__ void prep_phase(Frame& F, const PrepP& P) {
    const int tid_ = opq_tid(F.wave), lane = tid_ & 63, wave_ = __builtin_amdgcn_readfirstlane(tid_ >> 6);
    const int gw = F.vcu * NWAVES + wave_, NGW = F.G * NWAVES;
    for (int t = gw; t < S; t += NGW) {
        bf16* zr = P.Z + (size_t)t * ZP;
        const v4u lq = *(const v4u*)(zr + Z_CQ + 8 * lane), lkv = *(const v4u*)(zr + Z_CKV + 8 * lane);
        const Sp2 kr = span64_load(zr, Z_KR, lane, lane < 16);
        const Sp2 dq0 = span64_load(zr, Z_DQ, lane, true), dq1 = span64_load(zr, Z_DQ + 256, lane, true), dk0 = span64_load(zr, Z_DK, lane, true), dk1 = span64_load(zr, Z_DK + 256, lane, true);
        const Sp2 sq0 = span128_load(zr, Z_SQ, lane), sq1 = span128_load(zr, Z_SQ + 256, lane), sk0 = span128_load(zr, Z_SK, lane);
        const Sp2 aq0 = span64_load(zr, Z_AQ, lane, true), aq1 = span64_load(zr, Z_AQ + 256, lane, true), ak0 = span64_load(zr, Z_AK, lane, true);
        asm volatile("" ::: "memory");
        latent_apply(zr, Z_CQ, lq, P.qa, lane);
        latent_apply(zr, Z_CKV, lkv, P.kva, lane);
        span64_apply<false>(zr, Z_KR, kr, P.c64, P.s64, t, t, nullptr, lane, lane < 16);
        span64_apply<false>(zr, Z_DQ, dq0, P.c64, P.s64, t, t, nullptr, lane, true);
        span64_apply<false>(zr, Z_DQ + 256, dq1, P.c64, P.s64, t, t, nullptr, lane, true);
        span64_apply<false>(zr, Z_DK, dk0, P.c64, P.s64, t, t, nullptr, lane, true);
        span64_apply<false>(zr, Z_DK + 256, dk1, P.c64, P.s64, t, t, nullptr, lane, true);
        span128_apply(zr, Z_SQ, sq0, P.c128, P.s128, t, lane);
        span128_apply(zr, Z_SQ + 256, sq1, P.c128, P.s128, t, lane);
        span128_apply(zr, Z_SK, sk0, P.c128, P.s128, t, lane);
        span64_apply<true>(zr, Z_AQ, aq0, P.c64, P.s64, t >> 6, t & 63, P.axq, lane, true);
        span64_apply<true>(zr, Z_AQ + 256, aq1, P.c64, P.s64, t >> 6, t & 63, P.axq, lane, true);
        span64_apply<true>(zr, Z_AK, ak0, P.c64, P.s64, t >> 6, t & 63, P.axk, lane, true);
        asm volatile("" ::: "memory");
    }
}

__device__ __forceinline__ void knorm_pass(Frame& F, const bf16* __restrict__ Z, unsigned* __restrict__ slot) {
    const int tid_ = opq_tid(F.wave), lane = tid_ & 63, wave_ = __builtin_amdgcn_readfirstlane(tid_ >> 6);
    const int gw = F.vcu * NWAVES + wave_, NGW = F.G * NWAVES;
    float md = 0.f, ma = 0.f, mr = 0.f;
    for (int t = gw; t < S; t += NGW) {
        const bf16* zr = Z + (size_t)t * ZP;
        const v4u dk = *(const v4u*)(zr + Z_DK + 8 * lane);
        const v4u ak = *(const v4u*)(zr + Z_AK + 8 * (lane & 31));
        const v4u kr = *(const v4u*)(zr + Z_KR + 8 * (lane & 7));
        f32x4 a, b; pg8::unpack8(dk, a, b);
        float sd = (a[0] * a[0] + a[1] * a[1]) + (a[2] * a[2] + a[3] * a[3]) + (b[0] * b[0] + b[1] * b[1]) + (b[2] * b[2] + b[3] * b[3]);
        pg8::unpack8(ak, a, b);
        float sa = (a[0] * a[0] + a[1] * a[1]) + (a[2] * a[2] + a[3] * a[3]) + (b[0] * b[0] + b[1] * b[1]) + (b[2] * b[2] + b[3] * b[3]);
        sd += shx<1>(sd); sd += shx<2>(sd); sd += shx<4>(sd);
        sa += shx<1>(sa); sa += shx<2>(sa); sa += shx<4>(sa); sa += shx<8>(sa);
        pg8::unpack8(kr, a, b);
        float sr = (a[0] * a[0] + a[1] * a[1]) + (a[2] * a[2] + a[3] * a[3]) + (b[0] * b[0] + b[1] * b[1]) + (b[2] * b[2] + b[3] * b[3]);
        sr += shx<1>(sr); sr += shx<2>(sr); sr += shx<4>(sr);
        md = fmaxf(md, sd); ma = fmaxf(ma, sa); mr = fmaxf(mr, sr);
    }
    md = wave_max(md); ma = wave_max(ma); mr = wave_max(mr);
    if (lane == 0) { atomicMax(slot + 0, __float_as_uint(md)); atomicMax(slot + 1, __float_as_uint(ma)); atomicMax(slot + 2, __float_as_uint(mr)); }
}

__device__ __forceinline__ bf16x8 qscale(const bf16x8 q, const float c) { if (!ATT_NEGM) return q; f32x4 a, b; pg8::unpack8(__builtin_bit_cast(v4u, q), a, b); return __builtin_bit_cast(bf16x8, pg8::pack8(a * c, b * c)); }
constexpr float M0 = ATT_NEGM ? 0.f : -1e30f;
#ifndef ATT_STAG
#define ATT_STAG 0
#endif
#if ATT_STAG
#define ATTN_CORE att::attn_core_stag
#elif ATT_HS
#define ATTN_CORE att::attn_core_hs
#else
#define ATTN_CORE att::attn_core
#endif
#ifndef SD_AX
#define SD_AX 2
#endif
#ifndef SD_SWA
#define SD_SWA 1
#endif
#ifndef SD_MLA
#define SD_MLA 1
#endif
#ifndef SD_DIFF
#define SD_DIFF 1
#endif
struct AttP { unsigned* stamp; const bf16* Z; const bf16* QM; const bf16* KVM; bf16* BR; const float *c64, *s64; const float* sink; const float* lam_p; const float* subln; float lam_init; const unsigned* kn; const unsigned* kn2; };
__device__ __forceinline__ float kn_load(const unsigned* p) { return ATT_FASTREF ? __uint_as_float(*p) : -1.f; }

__device__ __forceinline__ void unit_axial(Frame& F, const AttP& P, int h, int qb) {
    using namespace att;
    const int tid_ = opq_tid(F.wave), lane = tid_ & 63, r32 = lane & 31, hi = lane >> 5, wid = __builtin_amdgcn_readfirstlane(tid_ >> 6);
    LAS char* lds = (LAS char*)F.lds;
    const int row = qb * 256 + wid * 32 + r32;
    const bf16* Qw = P.Z + (size_t)row * ZP + Z_AQ + h * 128 + hi * 8;
    bf16x8 qr[8];
#pragma unroll
    for (int d0 = 0; d0 < 8; ++d0) qr[d0] = qscale(ld8(Qw + d0 * 16), 0.088388347648318440f * LOG2E);
    f32x16 o[4] = {}; float m_reg = M0, l_reg = 0.f;
    const float scale = 0.088388347648318440f;
#ifdef PROBE_STAMP
    ATTN_CORE<8, false, false>(lds, qr, P.Z + Z_AK + (h >> 1) * 128, P.Z + Z_AV + (h >> 1) * 128, ZP, nullptr, 0, S / KVBLK, scale * LOG2E, 8.f / scale, 0, 0, 0, o, m_reg, l_reg, F.wave, P.stamp);
#else
    ATTN_CORE<8, false, false>(lds, qr, P.Z + Z_AK + (h >> 1) * 128, P.Z + Z_AV + (h >> 1) * 128, ZP, nullptr, 0, S / KVBLK, scale * LOG2E, 8.f / scale, 0, 0, 0, o, m_reg, l_reg, F.wave, kn_load(P.kn + 1));
#endif
    store_o(lds, o, l_reg, P.BR + (size_t)(qb * 256 + wid * 32) * D + 1536 + h * 128, D, F.wave);
}
__device__ __forceinline__ void unit_swa(Frame& F, const AttP& P, int h, int qb) {
    using namespace att;
    const int tid_ = opq_tid(F.wave), lane = tid_ & 63, r32 = lane & 31, hi = lane >> 5, wid = __builtin_amdgcn_readfirstlane(tid_ >> 6);
    LAS char* lds = (LAS char*)F.lds;
    const int row = qb * 256 + wid * 32 + r32;
    const bf16* Qw = P.Z + (size_t)row * ZP + Z_SQ + h * 128 + hi * 8;
    bf16x8 qr[8];
#pragma unroll
    for (int d0 = 0; d0 < 8; ++d0) qr[d0] = qscale(ld8(Qw + d0 * 16), 0.088388347648318440f * LOG2E);
    f32x16 o[4] = {}; float m_reg = M0, l_reg = 0.f;
    const float scale = 0.088388347648318440f, C = scale * LOG2E;
    int k_lo = qb * 256 - 128; if (k_lo < 0) k_lo = 0; int k_hi = qb * 256 + 384; if (k_hi > S) k_hi = S;
    const int NT = (k_hi - k_lo) / KVBLK;
    ATTN_CORE<8, false, true>(lds, qr, P.Z + (size_t)k_lo * ZP + Z_SK + (h >> 1) * 128, P.Z + (size_t)k_lo * ZP + Z_SV + (h >> 1) * 128, ZP, nullptr, 0, NT, C, 8.f / scale, 0, row, k_lo, o, m_reg, l_reg, F.wave);
    l_reg += __builtin_amdgcn_exp2f(P.sink[h] * LOG2E - (ATT_NEGM ? m_reg : m_reg * C));
    store_o(lds, o, l_reg, P.BR + (size_t)(qb * 256 + wid * 32) * D + 1024 + h * 128, D, F.wave);
}
__device__ __forceinline__ void unit_mla(Frame& F, const AttP& P, int h, int qb) {
    using namespace att;
    const int tid_ = opq_tid(F.wave), lane = tid_ & 63, r32 = lane & 31, hi = lane >> 5, wid = __builtin_amdgcn_readfirstlane(tid_ >> 6);
    LAS char* lds = (LAS char*)F.lds;
    const int row = qb * 256 + wid * 32 + r32;
    const bf16* Qw = P.QM + (size_t)row * QM_P + h * 192 + hi * 8;
    bf16x8 qr[8];
    LAS char* QRw = lds + OFF_QR + wid * 4096 + lane * 16;
#pragma unroll
    for (int d0 = 0; d0 < 8; ++d0) qr[d0] = qscale(ld8(Qw + d0 * 16), 0.072168783648703220f * LOG2E);
    float qx2 = 0.f;
#pragma unroll
    for (int d = 0; d < 2; ++d) {
        const v4u wa = __builtin_bit_cast(v4u, ld8(Qw + 128 + d * 16)), wb = __builtin_bit_cast(v4u, ld8(Qw + 160 + d * 16));
        f32x4 a0, a1, b0, b1; pg8::unpack8(wa, a0, a1); pg8::unpack8(wb, b0, b1);
        const float* cp = P.c64 + (size_t)row * 32 + d * 16 + hi * 8; const float* sp = P.s64 + (size_t)row * 32 + d * 16 + hi * 8;
        const f32x4 c0 = *(const f32x4*)cp, c1 = *(const f32x4*)(cp + 4), s0 = *(const f32x4*)sp, s1 = *(const f32x4*)(sp + 4);
        const float qs_ = ATT_NEGM ? 0.072168783648703220f * LOG2E : 1.f;
        const f32x4 n0 = (a0 * c0 - b0 * s0) * qs_, n1 = (a1 * c1 - b1 * s1) * qs_, m0 = (b0 * c0 + a0 * s0) * qs_, m1 = (b1 * c1 + a1 * s1) * qs_;
        qx2 += (n0[0] * n0[0] + n0[1] * n0[1]) + (n0[2] * n0[2] + n0[3] * n0[3]) + (n1[0] * n1[0] + n1[1] * n1[1]) + (n1[2] * n1[2] + n1[3] * n1[3])
             + (m0[0] * m0[0] + m0[1] * m0[1]) + (m0[2] * m0[2] + m0[3] * m0[3]) + (m1[0] * m1[0] + m1[1] * m1[1]) + (m1[2] * m1[2] + m1[3] * m1[3]);
        v4u o1, o2; o1.x = pk2(n0[0], n0[1]); o1.y = pk2(n0[2], n0[3]); o1.z = pk2(n1[0], n1[1]); o1.w = pk2(n1[2], n1[3]);
        o2.x = pk2(m0[0], m0[1]); o2.y = pk2(m0[2], m0[3]); o2.z = pk2(m1[0], m1[1]); o2.w = pk2(m1[2], m1[3]);
        *(LAS v4u*)(QRw + d * 1024) = o1; *(LAS v4u*)(QRw + (2 + d) * 1024) = o2;
    }
    f32x16 o[4] = {}; float m_reg = M0, l_reg = 0.f;
    const float scale = 0.072168783648703220f;
    float kmax2 = -1.f;
    if (ATT_FASTREF) {
        const v4u* g4 = (const v4u*)(P.kn2 + h * 16); const v4u g0 = g4[0], g1 = g4[1], g2 = g4[2], g3 = g4[3];
        kmax2 = __uint_as_float(P.kn[2]) + ((__uint_as_float(g0.x) + __uint_as_float(g0.y)) + (__uint_as_float(g0.z) + __uint_as_float(g0.w))) + ((__uint_as_float(g1.x) + __uint_as_float(g1.y)) + (__uint_as_float(g1.z) + __uint_as_float(g1.w)))
              + ((__uint_as_float(g2.x) + __uint_as_float(g2.y)) + (__uint_as_float(g2.z) + __uint_as_float(g2.w))) + ((__uint_as_float(g3.x) + __uint_as_float(g3.y)) + (__uint_as_float(g3.z) + __uint_as_float(g3.w))); }
    ATTN_CORE<8, true, false>(lds, qr, P.KVM + h * 256, P.KVM + h * 256 + 128, KVM_P, P.Z + Z_KR, ZP, S / KVBLK, scale * LOG2E, 8.f / scale, 0, 0, 0, o, m_reg, l_reg, F.wave, kmax2, qx2);
    store_o(lds, o, l_reg, P.BR + (size_t)(qb * 256 + wid * 32) * D + 0 + h * 128, D, F.wave);
}
__device__ __forceinline__ void unit_diff(Frame& F, const AttP& P, int h, int qb128) {
    using namespace att;
    const int tid_ = opq_tid(F.wave), lane = tid_ & 63, r32 = lane & 31, hi = lane >> 5, wid = __builtin_amdgcn_readfirstlane(tid_ >> 6);
    LAS char* lds = (LAS char*)F.lds;
    const int comp = wid >> 2, wq = wid & 3;
    const int row = qb128 * 128 + wq * 32 + r32;
    const bf16* Qw = P.Z + (size_t)row * ZP + Z_DQ + (2 * h + comp) * 64 + hi * 8;
    bf16x8 qr[4];
#pragma unroll
    for (int d0 = 0; d0 < 4; ++d0) qr[d0] = qscale(ld8(Qw + d0 * 16), 0.125f * LOG2E);
    f32x16 o[4] = {}; float m_reg = M0, l_reg = 0.f;
    const float scale = 0.125f;
    ATTN_CORE<4, false, false>(lds, qr, P.Z + Z_DK + h * 128, P.Z + Z_DV + h * 128, ZP, nullptr, 0, S / KVBLK, scale * LOG2E, 8.f / scale, 4 * comp, 0, 0, o, m_reg, l_reg, F.wave, kn_load(P.kn + 0));
    const float la = wave_sum(P.lam_p[lane] * P.lam_p[64 + lane]), lb = wave_sum(P.lam_p[128 + lane] * P.lam_p[192 + lane]);
    const float lam = expf(la) - expf(lb) + P.lam_init;
    LAS float* li_l = (LAS float*)(lds + OFF_WS) + wid * 64;
    if (hi == 0) li_l[r32] = l_reg; asm volatile("s_waitcnt lgkmcnt(0)" ::: "memory");
#pragma unroll
    for (int r = 0; r < 16; ++r) { const float rl = __builtin_amdgcn_rcpf(li_l[crow(r, hi)]);
#pragma unroll
        for (int d = 0; d < 4; ++d) o[d][r] *= rl; }
    __syncthreads();
    LAS float* X = (LAS float*)lds + wq * 4096;
    if (comp == 1) {
#pragma unroll
        for (int d = 0; d < 4; ++d)
#pragma unroll
            for (int r = 0; r < 16; ++r) X[(d * 16 + r) * 64 + lane] = o[d][r];
    }
    __syncthreads();
    if (comp == 0) {
        float ss[16];
#pragma unroll
        for (int r = 0; r < 16; ++r) { float s = 0.f;
#pragma unroll
            for (int d = 0; d < 4; ++d) { const float v = o[d][r] - lam * X[(d * 16 + r) * 64 + lane]; o[d][r] = v; s += v * v; }
            ss[r] = s; }
#pragma unroll
        for (int r = 0; r < 16; ++r) { float s = sum32(ss[r]);
            ss[r] = (1.0f - P.lam_init) / sqrtf(s * (1.0f / 128.0f) + RMS_EPS); }
        float gn[4];
#pragma unroll
        for (int d = 0; d < 4; ++d) gn[d] = P.subln[d * 32 + r32];
        bf16* Ow = P.BR + (size_t)(qb128 * 128 + wq * 32) * D + 512 + h * 128;
#pragma unroll
        for (int r = 0; r < 16; ++r) { const int orow = crow(r, hi);
#pragma unroll
            for (int d = 0; d < 4; ++d) Ow[(long)orow * D + d * 32 + r32] = (bf16)f2bf(o[d][r] * ss[r] * gn[d]); }
    }
    __syncthreads();
}
__device__ const float INVF128[64] = {
1.000000000e+00f, 8.659643531e-01f, 7.498942018e-01f, 6.493816376e-01f, 5.623413324e-01f, 4.869675338e-01f, 4.216965139e-01f, 3.651741147e-01f, 3.162277639e-01f, 2.738419771e-01f, 2.371373773e-01f, 2.053525001e-01f, 1.778279394e-01f, 1.539926529e-01f, 1.333521456e-01f, 1.154781953e-01f, 1.000000015e-01f, 8.659642935e-02f, 7.498942316e-02f, 6.493816525e-02f, 5.623413250e-02f, 4.869675264e-02f, 4.216964915e-02f, 3.651741147e-02f, 3.162277490e-02f, 2.738419548e-02f, 2.371373773e-02f, 2.053525113e-02f, 1.778279431e-02f, 1.539926510e-02f, 1.333521400e-02f, 1.154781971e-02f, 9.999999776e-03f, 8.659643121e-03f, 7.498942316e-03f, 6.493816152e-03f, 5.623413250e-03f, 4.869675264e-03f, 4.216964822e-03f, 3.651741194e-03f, 3.162277630e-03f, 2.738419687e-03f, 2.371373819e-03f, 2.053525066e-03f, 1.778279431e-03f, 1.539926510e-03f, 1.333521446e-03f, 1.154782018e-03f, 1.000000047e-03f, 8.659643354e-04f, 7.498941850e-04f, 6.493816036e-04f, 5.623413017e-04f, 4.869675322e-04f, 4.216965172e-04f, 3.651741135e-04f, 3.162277571e-04f, 2.738419571e-04f, 2.371373703e-04f, 2.053525095e-04f, 1.778279402e-04f, 1.539926598e-04f, 1.333521504e-04f, 1.154782003e-04f };
__device__ __forceinline__ void sincos_d(double a, float& sn, float& cs) {
    const double k = rint(a * 0.63661977236758134308);
    const double r = (a - k * 1.57079632673412561417e+00) - k * 6.07710050650619224932e-11;
    const double r2 = r * r;
    double ps = -1.0 / 6227020800.0; ps = ps * r2 + 1.0 / 39916800.0; ps = ps * r2 - 1.0 / 362880.0; ps = ps * r2 + 1.0 / 5040.0; ps = ps * r2 - 1.0 / 120.0; ps = ps * r2 + 1.0 / 6.0;
    const double s = r - r * r2 * ps;
    double pc = 1.0 / 87178291200.0; pc = pc * r2 - 1.0 / 479001600.0; pc = pc * r2 + 1.0 / 3628800.0; pc = pc * r2 - 1.0 / 40320.0; pc = pc * r2 + 1.0 / 720.0; pc = pc * r2 - 1.0 / 24.0; pc = pc * r2 + 0.5;
    const double c = 1.0 - r2 * pc;
    const int q = (int)((long long)k & 3);
    const double so = (q == 0) ? s : (q == 1) ? c : (q == 2) ? -s : -c;
    const double co = (q == 0) ? c : (q == 1) ? -s : (q == 2) ? -c : s;
    sn = (float)so; cs = (float)co;
}

#ifndef PHMASK
#define PHMASK 0xFFFFFF
#endif
#define PHEN(i) (((PHMASK) >> (i)) & 1)
#ifndef FUSE_NORM
#define FUSE_NORM 0
#endif
#ifndef G3_HALF
#define G3_HALF 1
#endif
#ifndef I8_ALIGN
#define I8_ALIGN true
#endif
#ifndef GATE_ALIGN
#define GATE_ALIGN true
#endif
#ifndef G1_ALIGN
#define G1_ALIGN true
#endif
#ifndef G3_ALIGN
#define G3_ALIGN true
#endif
#ifndef LEAN_X
#define LEAN_X (GATES_I8 && !MK_DEBUG && !FUSE_NORM)
#endif
#ifndef REP_MASK
#define REP_MASK 0
#endif
#define REPN(i) (1 + (((REP_MASK) >> (i)) & 1))
#ifndef AMASK
#define AMASK 0xF
#endif
#define AEN(i) (((AMASK) >> (i)) & 1)
constexpr int NPH = 12;
constexpr int NPHASES = 1 + DEPTH * NPH;
struct Args { const float* in[24]; float* out; unsigned char* ws; int ph_lo, ph_hi, li, pad; float lam_init[4]; };

__global__ void __launch_bounds__(NWAVES * 64, 2) mk_fwd(Args args) {
    extern __shared__ __attribute__((aligned(16))) unsigned char lds[];
    Frame F;
    F.lds = (LAS unsigned char*)lds;
    F.MISC = (volatile LAS unsigned*)(F.lds + MISC_OFF);
    F.tid = threadIdx.x; F.lane = F.tid & 63; F.wave = __builtin_amdgcn_readfirstlane(F.tid >> 6);
    F.G = gridDim.x; { const int bx = blockIdx.x; F.vcu = (F.G % 8 == 0) ? (bx % 8) * (F.G / 8) + bx / 8 : bx; }
    unsigned char* ws = args.ws;
    F.ctl = (gu32*)(ws + WS_CTL);
    for (int u = F.tid; u < (LDS_BYTES - LDSCTL_OFF) / 4; u += NWAVES * 64) ((LAS unsigned*)(F.lds + LDSCTL_OFF))[u] = 0u;
    __syncthreads();
    XcdBarrier bar = xcd_barrier_post((unsigned*)(F.ctl + CW_BAR) + args.li * XCD_BAR_WORDS, F.MISC + 8, F.wave);
    const int lo = args.ph_lo, hi = args.ph_hi;
#define IN(k) (lo <= (k) && (k) < hi)
#ifdef PROBE_SEAM2
#define SEAM(k) do { if (IN(k) && (k) + 1 < hi && (k) + 1 < NPHASES) { xcd_barrier(bar); xcd_barrier(bar); } } while (0)
#else
#define SEAM(k) do { if (IN(k) && (k) + 1 < hi && (k) + 1 < NPHASES) xcd_barrier(bar); } while (0)
#endif
    float* const X = args.out;
    float* const c64 = (float*)(ws + WS_TAB64); float* const s64 = c64 + (size_t)S * 32;
    float* const c128 = (float*)(ws + WS_TAB128); float* const s128 = c128 + (size_t)S * 64;
    bf16* const Hb = (bf16*)(ws + WS_H); bf16* const Zb = (bf16*)(ws + WS_Z); bf16* const GTb = (bf16*)(ws + WS_GT);
    bf16* const QMb = (bf16*)(ws + WS_QM); bf16* const KVMb = (bf16*)(ws + WS_KVM); bf16* const BRb = (bf16*)(ws + WS_BR);
    bf16* const Yb = (bf16*)(ws + WS_Z); float* const MFf = (float*)(ws + WS_Z); bf16* const MGb = FUSE_NORM ? (bf16*)(ws + WS_Z + 64 * MiB) : Hb; bf16* const XBb = FUSE_NORM ? (bf16*)(ws + WS_Z) : Hb; bf16* const HIDb = GTb; bf16* const P2b = BRb;
    bf16* const PBb = (bf16*)(ws + WS_PB);
    unsigned char* const A8 = (GATES_FP8 || GATES_I8) ? (unsigned char*)(ws + WS_A8) : nullptr;
    float* const SA8 = (float*)(ws + WS_SA); float* const CMf = (float*)(F.ctl + CW_CM);

    if (PHEN(12) && IN(0)) for (int rep_ = 0; rep_ < REPN(12); ++rep_) {
        const int tid_ = opq_tid(F.wave), lane_ = tid_ & 63, wave_ = __builtin_amdgcn_readfirstlane(tid_ >> 6);
        const int gw = F.vcu * NWAVES + wave_, NGW = F.G * NWAVES;
        const int gt = F.vcu * (NWAVES * 64) + tid_, NGT = F.G * NWAVES * 64;
        {
            WSrc wsrc{args.in[7], args.in[9], args.in[11], args.in[17], args.in[18], args.in[19], args.in[20], args.in[21], args.in[22], args.in[23], CMf};
#if GATES_I8
            constexpr int IT_Q = IT_BG + IT_PG + (FFN_I8 ? IT_FI : 0);
            for (int it2 = gw; it2 < DEPTH * IT_Q; it2 += NGW) { const int L2 = DEPTH - 1 - it2 / IT_Q, q2 = it2 % IT_Q;
                const int r2 = q2 < IT_BG ? IT_IN + q2 : (q2 < IT_BG + IT_PG ? IT_LAYER - IT_PG + (q2 - IT_BG) : IT_IN + IT_BG + IT_UQ + IT_UKV + IT_BR + IT_WO + (q2 - IT_BG - IT_PG));
                const WItem wi = witem(wsrc, (bf16*)(ws + WS_W + (size_t)L2 * WL_BYTES), L2, r2); const WRegs rr2 = witem_load(wi, lane_); witem_colmax(wi, rr2, lane_); }
            xcd_barrier(bar);
#endif
            LAS float* scr = (LAS float*)(F.lds + RING_OFF + wave_ * 16384);
            int it = gw;
            if (it < DEPTH * IT_LAYER) {
                WItem cur = witem(wsrc, (bf16*)(ws + WS_W + (size_t)(it / IT_LAYER) * WL_BYTES), it / IT_LAYER, it % IT_LAYER); WRegs rv = witem_load(cur, lane_);
                for (;;) { const int nx = it + NGW; const bool more = nx < DEPTH * IT_LAYER;
                    WItem nxt = cur; WRegs rn = rv;
                    if (more) { nxt = witem(wsrc, (bf16*)(ws + WS_W + (size_t)(nx / IT_LAYER) * WL_BYTES), nx / IT_LAYER, nx % IT_LAYER); rn = witem_load(nxt, lane_); }
                    witem_store(cur, rv, scr, lane_);
                    if (!more) break;
                    cur = nxt; rv = rn; it = nx; }
            }
            for (int i = gt; i < DEPTH * 49152; i += NGT) { const int L = i / 49152, q = i - L * 49152;
                *(v4u*)((bf16*)(ws + WS_W + (size_t)L * WL_BYTES) + WL_W1 + (size_t)ZC * D + (size_t)q * 8) = (v4u){0u, 0u, 0u, 0u}; }
        }
        for (int i = gt; i < S * 32; i += NGT) { const int pos = i >> 5, j = i & 31; const float ang = (float)pos * INVF128[2 * j]; float sn, cs; sincos_d((double)ang, sn, cs); c64[i] = cs; s64[i] = sn; }
        for (int i = gt; i < S * 64; i += NGT) { const int pos = i >> 6, j = i & 63; const float ang = (float)pos * INVF128[j]; float sn, cs; sincos_d((double)ang, sn, cs); c128[i] = cs; s128[i] = sn; }
        { const float* p = args.in[1];
          for (int i = gt; i < DEPTH * S * PLE / 8; i += NGT) { const f32x4 a = *(const f32x4*)(p + (size_t)i * 8), b = *(const f32x4*)(p + (size_t)i * 8 + 4);
              v4u o; o.x = pk2(a[0], a[1]); o.y = pk2(a[2], a[3]); o.z = pk2(b[0], b[1]); o.w = pk2(b[2], b[3]); *(v4u*)(PBb + (size_t)i * 8) = o; } }
        thin_phase<0>(F, args.in[0], nullptr, X, Hb, nullptr, args.in[2], A8, SA8, !LEAN_X);
    }
    SEAM(0);

    for (int L = 0; L < DEPTH; ++L) {
        const int pb = 1 + L * NPH;
        const bf16* WL = (const bf16*)(ws + WS_W + (size_t)L * WL_BYTES);
        if (PHEN(0) && IN(pb + 0)) for (int rep_ = 0; rep_ < REPN(0); ++rep_) {
#if GATES_I8
            { pg8::StaticOrder So; So.init(Hb, D, WL + WL_W1, D, S, ZP, F.G, (int)blockIdx.x);
              pg8::EpiPlain E{Zb, ZP};
              pg8::gemm_phase<pg8::EpiPlain, pg8::StaticOrder>(F.lds + RING_OFF, F.wave, D, D, D, So, E); }
            { pg8::StaticOrder So; So.init((const bf16*)A8, D / 2, WL + WL_W1 + (size_t)ZP * D, D / 2, S, NG, F.G, (int)blockIdx.x);
              pg8::EpiGateI8 E{GTb, SA8, CMf + L * 5 * D};
              pg8::gemm_phase<pg8::EpiGateI8, pg8::StaticOrder, GATE_ALIGN, false, true>(F.lds + RING_OFF, F.wave, D / 2, D / 2, D / 2, So, E); }
#elif GATES_FP8
            { pg8::StaticOrder So; So.init(Hb, D, WL + WL_W1, D, S, ZP, F.G, (int)blockIdx.x);
              pg8::EpiPlain E{Zb, ZP};
              pg8::gemm_phase<pg8::EpiPlain, pg8::StaticOrder>(F.lds + RING_OFF, F.wave, D, D, D, So, E); }
            { pg8::StaticOrder So; So.init((const bf16*)A8, D / 2, WL + WL_W1 + (size_t)ZP * D, D / 2, S, NG, F.G, (int)blockIdx.x);
              pg8::EpiGate E{GTb};
              pg8::gemm_phase<pg8::EpiGate, pg8::StaticOrder, true, true>(F.lds + RING_OFF, F.wave, D, D, D, So, E); }
#else
            pg8::StaticOrder So; So.init(Hb, D, WL + WL_W1, D, S, N1, F.G, (int)blockIdx.x);
            pg8::EpiG1 E{Zb, GTb};
            pg8::gemm_phase<pg8::EpiG1, pg8::StaticOrder, G1_ALIGN>(F.lds + RING_OFF, F.wave, D, D, D, So, E);
#endif
        }
        SEAM(pb + 0);
        if (PHEN(1) && IN(pb + 1)) {
            PrepP P{Zb, c64, s64, c128, s128, args.in[8] + L * 512, args.in[10] + L * 512, args.in[15] + L * 128, args.in[16] + L * 128};
            prep_phase(F, P);
            if (REPN(1) > 1) { PrepP P2{(bf16*)(ws + WS_END), c64, s64, c128, s128, args.in[8] + L * 512, args.in[10] + L * 512, args.in[15] + L * 128, args.in[16] + L * 128}; prep_phase(F, P2); }
#ifdef REP_BARRIERS
            for (int rb_ = 0; rb_ < REP_BARRIERS; ++rb_) xcd_barrier(bar);
#endif
        }
        SEAM(pb + 1);
        if (PHEN(2) && IN(pb + 2)) for (int rep_ = 0; rep_ < REPN(2); ++rep_) {
            pg8::OrderG2 So{Zb, WL + WL_UQKV, F.G, (int)blockIdx.x};
            pg8::EpiG2 E{QMb, KVMb, (ATT_NEGM && ATT_FASTREF && rep_ == 0) ? (unsigned*)(F.ctl + CW_KN2) + L * 64 : nullptr};
            pg8::gemm_phase<pg8::EpiG2, pg8::OrderG2>(F.lds + RING_OFF, F.wave, 512, ZP, 512, So, E);
#if ATT_NEGM && ATT_FASTREF
            if (rep_ == 0) knorm_pass(F, Zb, (unsigned*)(F.ctl + CW_KN) + L * 4);
#endif
        }
        SEAM(pb + 2);
        if (PHEN(3) && IN(pb + 3)) for (int rep_ = 0; rep_ < REPN(3); ++rep_) {
            AttP P{(L == 0) ? (unsigned*)(F.ctl + 200) : nullptr, Zb, QMb, KVMb, BRb, c64, s64, args.in[14] + L * 4, args.in[12] + L * 256, args.in[13] + L * 128, args.lam_init[L], (const unsigned*)(F.ctl + CW_KN) + L * 4, (const unsigned*)(F.ctl + CW_KN2) + L * 64};
            if (AEN(0)) for (int u = F.vcu; u < 256; u += F.G) unit_mla(F, P, u >> 6, u & 63);
            __syncthreads();
#if defined(PROBE_MIDBAR) && PROBE_MIDBAR >= 2
            xcd_barrier(bar);
#endif
            if (AEN(1)) for (int u = F.vcu; u < 256; u += F.G) unit_axial(F, P, u >> 6, u & 63);
            __syncthreads();
#ifdef PROBE_MIDBAR
            xcd_barrier(bar);
#endif
            if (AEN(2)) for (int u = F.vcu; u < 256; u += F.G) {
_Pragma("unroll 1")
                for (int i2 = 0; i2 < 2; ++i2) { const int uu = 2 * u + i2; unit_diff(F, P, uu >> 7, uu & 127);
#if defined(PROBE_MIDBAR) && PROBE_MIDBAR >= 2
                    xcd_barrier(bar);
#endif
                } }
            if (AEN(3)) for (int u = F.vcu; u < 256; u += F.G) unit_swa(F, P, u >> 6, u & 63);
            __syncthreads();
        }
        SEAM(pb + 3);
        if (PHEN(4) && IN(pb + 4)) for (int rep_ = 0; rep_ < REPN(4); ++rep_) {
#if G3_HALF
            pg8::OrderG3h So{BRb, WL + WL_BR, F.G, (int)blockIdx.x};
            pg8::EpiG3h E{GTb, MGb};
            pg8::gemm_phase_h<pg8::EpiG3h, pg8::OrderG3h>(F.lds + RING_OFF, F.wave, 512, D, 512, So, E);
#else
            pg8::OrderG3 So{BRb, WL + WL_BR, F.G, (int)blockIdx.x};
            pg8::EpiG3 E{GTb, (bf16*)MFf, MGb};
            pg8::gemm_phase<pg8::EpiG3, pg8::OrderG3, G3_ALIGN>(F.lds + RING_OFF, F.wave, 512, D, 512, So, E);
#endif
        }
        SEAM(pb + 4);
#define XCHI(k) pg8::RmsXchg{(float*)(ws + WS_XCH + (size_t)(L * 6 + (k)) * 512 * 1024), (unsigned*)(F.ctl + CW_SEAM + (L * 6 + (k)) * SEAM_BANK), (unsigned*)(F.ctl + CW_TMO)}
        if (PHEN(5) && IN(pb + 5)) for (int rep_ = 0; rep_ < REPN(5); ++rep_) {
#if FUSE_NORM
            pg8::EpiNorm<0, 1> E{X, Hb, nullptr, args.in[3] + L * D, args.in[4] + L * D, XCHI(0), XCHI(1)};
            { pg8::PanelOrder So{MGb, WL + WL_WO, D, D, F.G, (int)blockIdx.x, 0}; pg8::gemm_phase<pg8::EpiNorm<0, 1>, pg8::PanelOrder>(F.lds + RING_OFF, F.wave, D, D, D, So, E); }
            { pg8::PanelOrder So{MGb, WL + WL_WO, D, D, F.G, (int)blockIdx.x, 1}; pg8::gemm_phase<pg8::EpiNorm<0, 1>, pg8::PanelOrder>(F.lds + RING_OFF, F.wave, D, D, D, So, E); }
#else
#ifdef PANEL_PLAIN
            pg8::EpiPlain E{Yb, D};
            { pg8::PanelOrder So{MGb, WL + WL_WO, D, D, F.G, (int)blockIdx.x, 0}; pg8::gemm_phase<pg8::EpiPlain, pg8::PanelOrder>(F.lds + RING_OFF, F.wave, D, D, D, So, E); }
            { pg8::PanelOrder So{MGb, WL + WL_WO, D, D, F.G, (int)blockIdx.x, 1}; pg8::gemm_phase<pg8::EpiPlain, pg8::PanelOrder>(F.lds + RING_OFF, F.wave, D, D, D, So, E); }
#else
            pg8::StaticOrder So; So.init(MGb, D, WL + WL_WO, D, S, D, F.G, (int)blockIdx.x);
            pg8::EpiPlain E{Yb, D};
            pg8::gemm_phase<pg8::EpiPlain, pg8::StaticOrder>(F.lds + RING_OFF, F.wave, D, D, D, So, E);
#endif
#endif
        }
        SEAM(pb + 5);
#if !FUSE_NORM
        if (PHEN(6) && IN(pb + 6)) { thin_phase<1>(F, (LEAN_X && L == 0) ? args.in[0] : nullptr, Yb, X, (GATES_I8 && FFN_I8 && !MK_DEBUG) ? nullptr : Hb, args.in[3] + L * D, args.in[4] + L * D, (GATES_I8 && FFN_I8) ? A8 : nullptr, SA8);
            if (REPN(6) > 1) thin_phase<4>(F, X, Yb, (float*)GTb, GTb + (size_t)S * D * 2, args.in[3] + L * D, args.in[4] + L * D); }
        SEAM(pb + 6);
#endif
        if (PHEN(7) && IN(pb + 7)) for (int rep_ = 0; rep_ < REPN(7); ++rep_) {
#if GATES_I8 && FFN_I8
            pg8::StaticOrder So; So.init((const bf16*)A8, D / 2, WL + WL_FI, D / 2, S, 2 * FF, F.G, (int)blockIdx.x);
            pg8::EpiSwiGLUI8 E{HIDb, SA8, CMf + (CW_CMF - CW_CM) + L * 2 * FF};
            pg8::gemm_phase<pg8::EpiSwiGLUI8, pg8::StaticOrder, I8_ALIGN, false, true>(F.lds + RING_OFF, F.wave, D / 2, D / 2, D / 2, So, E);
#else
            pg8::StaticOrder So; So.init(Hb, D, WL + WL_FI, D, S, 2 * FF, F.G, (int)blockIdx.x);
            pg8::EpiSwiGLU E{HIDb};
            pg8::gemm_phase<pg8::EpiSwiGLU, pg8::StaticOrder>(F.lds + RING_OFF, F.wave, D, D, D, So, E);
#endif
        }
        SEAM(pb + 7);
        if (PHEN(8) && IN(pb + 8)) for (int rep_ = 0; rep_ < REPN(8); ++rep_) {
#if FUSE_NORM
            { pg8::EpiNorm<0, 2> E{X, XBb, nullptr, args.in[5] + L * D, nullptr, XCHI(2), XCHI(2)};
              { pg8::PanelOrder So{HIDb, WL + WL_FO, FF, FF, F.G, (int)blockIdx.x, 0}; pg8::gemm_phase<pg8::EpiNorm<0, 2>, pg8::PanelOrder>(F.lds + RING_OFF, F.wave, FF, FF, FF, So, E); }
              { pg8::PanelOrder So{HIDb, WL + WL_FO, FF, FF, F.G, (int)blockIdx.x, 1}; pg8::gemm_phase<pg8::EpiNorm<0, 2>, pg8::PanelOrder>(F.lds + RING_OFF, F.wave, FF, FF, FF, So, E); } }
#else
#ifdef PANEL_PLAIN
            { pg8::EpiPlain E{Yb, D};
              { pg8::PanelOrder So{HIDb, WL + WL_FO, FF, FF, F.G, (int)blockIdx.x, 0}; pg8::gemm_phase<pg8::EpiPlain, pg8::PanelOrder>(F.lds + RING_OFF, F.wave, FF, FF, FF, So, E); }
              { pg8::PanelOrder So{HIDb, WL + WL_FO, FF, FF, F.G, (int)blockIdx.x, 1}; pg8::gemm_phase<pg8::EpiPlain, pg8::PanelOrder>(F.lds + RING_OFF, F.wave, FF, FF, FF, So, E); } }
#else
            { pg8::StaticOrder So; So.init(HIDb, FF, WL + WL_FO, FF, S, D, F.G, (int)blockIdx.x);
              pg8::EpiPlain E{Yb, D};
              pg8::gemm_phase<pg8::EpiPlain, pg8::StaticOrder>(F.lds + RING_OFF, F.wave, FF, FF, FF, So, E); }
#endif
#endif
            { pg8::StaticOrder So; So.init(PBb + (size_t)L * S * PLE, PLE, WL + WL_PLE, PLE, S, D, F.G, (int)blockIdx.x);
              pg8::EpiPlain E{P2b, D};
              pg8::gemm_phase<pg8::EpiPlain, pg8::StaticOrder>(F.lds + RING_OFF, F.wave, PLE, PLE, PLE, So, E); }
        }
        SEAM(pb + 8);
#if !FUSE_NORM
        if (PHEN(9) && IN(pb + 9)) { thin_phase<2>(F, nullptr, Yb, X, Hb, args.in[5] + L * D, nullptr, A8, SA8, !LEAN_X);
            if (REPN(9) > 1) thin_phase<4>(F, X, Yb, (float*)GTb, GTb + (size_t)S * D * 2, args.in[5] + L * D, args.in[5] + L * D); }
        SEAM(pb + 9);
#endif
        if (PHEN(10) && IN(pb + 10)) for (int rep_ = 0; rep_ < REPN(10); ++rep_) {
#if FUSE_NORM
            if (L + 1 < DEPTH) { pg8::EpiNorm<1, 1> E{X, Hb, P2b, args.in[6] + L * D, args.in[2] + (L + 1) * D, XCHI(3), XCHI(4)};
                { pg8::PanelOrder So{XBb, WL + WL_PG, D, D, F.G, (int)blockIdx.x, 0}; pg8::gemm_phase<pg8::EpiNorm<1, 1>, pg8::PanelOrder>(F.lds + RING_OFF, F.wave, D, D, D, So, E); }
                { pg8::PanelOrder So{XBb, WL + WL_PG, D, D, F.G, (int)blockIdx.x, 1}; pg8::gemm_phase<pg8::EpiNorm<1, 1>, pg8::PanelOrder>(F.lds + RING_OFF, F.wave, D, D, D, So, E); } }
            else { pg8::EpiNorm<1, 0> E{X, nullptr, P2b, args.in[6] + L * D, nullptr, XCHI(3), XCHI(3)};
                { pg8::PanelOrder So{XBb, WL + WL_PG, D, D, F.G, (int)blockIdx.x, 0}; pg8::gemm_phase<pg8::EpiNorm<1, 0>, pg8::PanelOrder>(F.lds + RING_OFF, F.wave, D, D, D, So, E); }
                { pg8::PanelOrder So{XBb, WL + WL_PG, D, D, F.G, (int)blockIdx.x, 1}; pg8::gemm_phase<pg8::EpiNorm<1, 0>, pg8::PanelOrder>(F.lds + RING_OFF, F.wave, D, D, D, So, E); } }
#else
#if GATES_I8
            pg8::EpiPleI8 E8{P2b, LEAN_X ? GTb : Yb, SA8, CMf + (L * 5 + 4) * D};
            pg8::StaticOrder So8; So8.init((const bf16*)A8, D / 2, WL + WL_PG, D / 2, S, D, F.G, (int)blockIdx.x);
            pg8::gemm_phase<pg8::EpiPleI8, pg8::StaticOrder, I8_ALIGN, false, true>(F.lds + RING_OFF, F.wave, D / 2, D / 2, D / 2, So8, E8);
#else
            pg8::EpiPle E{P2b, Yb};
#if GATES_FP8
            pg8::StaticOrder So; So.init((const bf16*)A8, D / 2, WL + WL_PG, D / 2, S, D, F.G, (int)blockIdx.x);
            pg8::gemm_phase<pg8::EpiPle, pg8::StaticOrder, true, true>(F.lds + RING_OFF, F.wave, D, D, D, So, E);
#else
            pg8::StaticOrder So; So.init(Hb, D, WL + WL_PG, D, S, D, F.G, (int)blockIdx.x);
            pg8::gemm_phase<pg8::EpiPle, pg8::StaticOrder>(F.lds + RING_OFF, F.wave, D, D, D, So, E);
#endif
#endif
#endif
        }
        SEAM(pb + 10);
#if !FUSE_NORM
        if (PHEN(11) && IN(pb + 11)) {
#if LEAN_X
            if (L + 1 < DEPTH) thin_phase<1, true>(F, nullptr, Yb, X, Hb, args.in[5] + L * D, args.in[2] + (L + 1) * D, A8, SA8, true, GTb, args.in[6] + L * D);
            else thin_phase<3, true>(F, nullptr, Yb, X, Hb, args.in[5] + L * D, nullptr, nullptr, nullptr, true, GTb, args.in[6] + L * D);
#else
            if (L + 1 < DEPTH) thin_phase<1>(F, nullptr, Yb, X, Hb, args.in[6] + L * D, args.in[2] + (L + 1) * D, A8, SA8);
            else thin_phase<3>(F, nullptr, Yb, X, Hb, args.in[6] + L * D, nullptr);
#endif
            if (REPN(11) > 1) thin_phase<4>(F, X, Yb, (float*)GTb, GTb + (size_t)S * D * 2, args.in[6] + L * D, args.in[6] + L * D);
        }
        SEAM(pb + 11);
#endif
    }
#undef IN
#undef SEAM
}
extern "C" void kernel_launch(void* const* d_in, const int* in_sizes, int n_in, void* d_out, int out_size, void* d_ws, size_t ws_size, hipStream_t stream) {
    static int grid = 0;
    if (grid == 0) {
        const size_t need = MK_DEBUG ? WS_DBG_END : WS_END4;
        if (n_in != 24 || in_sizes[0] != S * D || out_size != S * D || ws_size < need) {
            fprintf(stderr, "kernel_launch: built for 24 inputs, x and out of %d floats, >= %zu bytes of workspace; got n_in %d, in0 %d, out %d, ws %zu; nothing launched\n", S * D, need, n_in, n_in > 0 ? in_sizes[0] : -1, out_size, ws_size);
            grid = -1; return; }
        int dev = 0, cus = 0, per_cu = 0;
        if (hipGetDevice(&dev) != hipSuccess || hipDeviceGetAttribute(&cus, hipDeviceAttributeMultiprocessorCount, dev) != hipSuccess) { fprintf(stderr, "kernel_launch: hipGetDevice / hipDeviceGetAttribute failed\n"); grid = -1; return; }
        if (hipFuncSetAttribute((const void*)mk_fwd, hipFuncAttributeMaxDynamicSharedMemorySize, LDS_BYTES) != hipSuccess) { fprintf(stderr, "kernel_launch: hipFuncSetAttribute failed\n"); grid = -1; return; }
        if (hipOccupancyMaxActiveBlocksPerMultiprocessor(&per_cu, (const void*)mk_fwd, NWAVES * 64, LDS_BYTES) != hipSuccess || per_cu < 1)
            fprintf(stderr, "kernel_launch: note: the occupancy query reports %d workgroups per CU\n", per_cu);
        (void)hipGetLastError();
        grid = cus;
    }
    if (grid < 0) return;
    if (hipMemsetAsync((char*)d_ws + WS_CTL, 0, CTL_ZERO_BYTES, stream) != hipSuccess) { fprintf(stderr, "kernel_launch: hipMemsetAsync failed\n"); return; }
    Args a{};
    for (int i = 0; i < 24; ++i) a.in[i] = (const float*)d_in[i];
    a.out = (float*)d_out; a.ws = (unsigned char*)d_ws;
    for (int i = 0; i < DEPTH; ++i) a.lam_init[i] = (float)(0.8 - 0.6 * exp(-0.3 * (double)i));
#if MK_DEBUG
    for (int ph = 0; ph < NPHASES; ++ph) {
        a.ph_lo = ph; a.ph_hi = ph + 1; a.li = 0;
        dbg_pre(ph, a, stream);
        hipLaunchKernelGGL(mk_fwd, dim3(grid), dim3(NWAVES * 64), LDS_BYTES, stream, a);
        dbg_post(ph, a, stream);
    }
    dbg_final(a, stream);
#else
    a.ph_lo = 0; a.ph_hi = NPHASES; a.li = 0;
    hipLaunchKernelGGL(mk_fwd, dim3(grid), dim3(NWAVES * 64), LDS_BYTES, stream, a);
#endif
    const hipError_t le = hipPeekAtLastError();
    if (le != hipSuccess) fprintf(stderr, "kernel_launch: launch failed: %s (grid %d)\n", hipGetErrorName(le), grid);
}
```

```cpp
#include <hip/hip_runtime.h>
#include <cstdio>
#include <cstdint>
#include <cmath>

#ifndef MK_DEBUG
#define MK_DEBUG 0
#endif

#ifndef ATT_NEGM
#define ATT_NEGM 1
#endif
#ifndef ATT_HS
#define ATT_HS 0
#endif
#ifndef GATES_I8
#define GATES_I8 1
#endif
#ifndef FFN_I8
#define FFN_I8 1
#endif
#ifndef GATES_FP8
#define GATES_FP8 0
#endif
#define GAS __attribute__((address_space(1)))
#define LAS __attribute__((address_space(3)))
typedef unsigned short bf16;
typedef unsigned v4u __attribute__((ext_vector_type(4)));
typedef unsigned v2u __attribute__((ext_vector_type(2)));
typedef float f32x4 __attribute__((ext_vector_type(4)));
typedef float f32x2 __attribute__((ext_vector_type(2)));
typedef short bf16x8 __attribute__((ext_vector_type(8)));
typedef short s16x4 __attribute__((ext_vector_type(4)));
typedef float f32x16 __attribute__((ext_vector_type(16)));
typedef GAS unsigned gu32;
#define RLX_AGENT __ATOMIC_RELAXED, __HIP_MEMORY_SCOPE_AGENT
#define LDS_WAIT() asm volatile("s_waitcnt lgkmcnt(0)" ::: "memory")
#define VM_WAIT() asm volatile("s_waitcnt vmcnt(0)" ::: "memory")

constexpr int S = 16384, D = 2048, DEPTH = 4, FF = 5632, PLE = 256;
constexpr int ZC = 4672, ZP = 4864, NG = 8192, N1 = ZP + NG;
constexpr int Z_CQ = 0, Z_CKV = 512, Z_KR = 1024, Z_DQ = 1088, Z_DK = 1600, Z_DV = 2112, Z_SQ = 2624, Z_SK = 3136, Z_SV = 3392, Z_AQ = 3648, Z_AK = 4160, Z_AV = 4416;
constexpr int QM_P = 768, KVM_P = 1024;
constexpr float RMS_EPS = 1e-6f;
constexpr float LOG2E = 1.4426950408889634f;

constexpr size_t MiB = 1u << 20;
constexpr size_t WS_CTL = 0, CTL_ZERO_BYTES = 1 * MiB;
constexpr size_t WS_TAB64 = 1 * MiB;
constexpr size_t WS_TAB128 = 5 * MiB;
constexpr size_t WS_W = 13 * MiB;
constexpr size_t WL_W1 = 0;
constexpr size_t WL_UQKV = WL_W1 + (size_t)N1 * D;
constexpr size_t WL_BR = WL_UQKV + (size_t)1792 * 512;
constexpr size_t WL_WO = WL_BR + (size_t)4 * D * 512;
constexpr size_t WL_FI = WL_WO + (size_t)D * D;
constexpr size_t WL_FO = WL_FI + (size_t)2 * FF * D;
constexpr size_t WL_PLE = WL_FO + (size_t)D * FF;
constexpr size_t WL_PG = WL_PLE + (size_t)D * PLE;
constexpr size_t WL_ELEMS = WL_PG + (size_t)D * D;
constexpr size_t WL_BYTES = WL_ELEMS * 2;
constexpr size_t WS_PB = WS_W + ((4 * WL_BYTES + MiB - 1) / MiB) * MiB;
constexpr size_t WS_H = WS_PB + 32 * MiB;
constexpr size_t WS_Z = WS_H + 64 * MiB;
constexpr size_t WS_GT = WS_Z + 152 * MiB;
constexpr size_t WS_QM = WS_GT + 256 * MiB;
constexpr size_t WS_KVM = WS_QM + 24 * MiB;
constexpr size_t WS_BR = WS_KVM + 32 * MiB;
constexpr size_t WS_END = WS_BR + 64 * MiB;
constexpr size_t WS_XCH = WS_END;
constexpr size_t WS_END2 = WS_XCH + 12 * MiB;
constexpr size_t WS_A8 = WS_END2;
constexpr size_t WS_END3 = WS_A8 + 32 * MiB;
constexpr size_t WS_SA = WS_END3;
constexpr size_t WS_END4 = WS_SA + 1 * MiB;
constexpr size_t WS_DBG_ZCOPY = WS_QM;
constexpr size_t WS_DBG_END = WS_END4;

constexpr int CW_TMO = 0, CW_CODE = 1;
constexpr int CW_ERR = 64;
constexpr int CW_CM = 131072;
constexpr int CW_CMF = CW_CM + DEPTH * 5 * 2048;
constexpr int CW_KN2 = 230400;
constexpr int CW_KN = 230000;
#ifndef ATT_FASTDUP
#define ATT_FASTDUP 1
#endif
#ifndef ATT_QKFIN
#define ATT_QKFIN 1
#endif
#ifndef QKFSEL
#define QKFSEL (!ROPEK)
#endif
#ifndef ATT_ILV
#define ATT_ILV 1
#endif
#ifndef DUPSEL
#define DUPSEL (!ROPEK)
#endif
#ifndef ATT_LMFMA
#define ATT_LMFMA 0
#endif
#ifndef LMSEL
#define LMSEL (NQ == 4)
#endif
#ifndef ATT_PROWAIT
#define ATT_PROWAIT 1
#endif
#ifndef ATT_SPRIO
#define ATT_SPRIO 1
#endif
#ifndef ATT_ILV3
#define ATT_ILV3 0
#endif
#ifndef ATT_ILV2
#define ATT_ILV2 0
#endif
#ifndef ATT_NOSWAP
#define ATT_NOSWAP 1
#endif
#ifndef ATT_LPART
#define ATT_LPART 0
#endif
#ifndef ATT_FASTREF
#define ATT_FASTREF 1
#endif
constexpr int CW_BAR = 4096;
constexpr int CW_SEAM = 16384, SEAM_BANK = 64 * 64;

constexpr int NWAVES = 8;
constexpr int RING_OFF = 0, RING_BYTES = 131072;
constexpr int LDSCTL_OFF = 143360, MISC_OFF = LDSCTL_OFF + 320;
constexpr int LDS_BYTES = 147456;

__device__ __forceinline__ unsigned f2bf(float f) { unsigned u = __builtin_bit_cast(unsigned, f); return (u + 0x7fffu + ((u >> 16) & 1u)) >> 16; }
__device__ __forceinline__ unsigned pk2(float lo, float hi) { return f2bf(lo) | (f2bf(hi) << 16); }
__device__ __forceinline__ float bf2f(unsigned b) { return __builtin_bit_cast(float, b << 16); }
__device__ __forceinline__ float bflo(unsigned w) { return __builtin_bit_cast(float, w << 16); }
__device__ __forceinline__ float bfhi(unsigned w) { return __builtin_bit_cast(float, w & 0xffff0000u); }
typedef __bf16 bf16x2_t __attribute__((ext_vector_type(2)));
__device__ __forceinline__ unsigned cvt_pk_bf16(float lo, float hi) { const f32x2 v = {lo, hi}; const bf16x2_t b = __builtin_convertvector(v, bf16x2_t); return __builtin_bit_cast(unsigned, b); }
template <int M> __device__ __forceinline__ float shx(float v) { static_assert(M >= 1 && M <= 16, "shx: xor mask 1..16");
    return __builtin_bit_cast(float, __builtin_amdgcn_ds_swizzle(__builtin_bit_cast(int, v), 0x1F | (M << 10))); }
__device__ __forceinline__ float add32(float v) { auto rr = __builtin_amdgcn_permlane32_swap(__float_as_uint(v), __float_as_uint(v), false, false);
    return __uint_as_float(rr[0]) + __uint_as_float(rr[1]); }
__device__ __forceinline__ float sum32(float v) { v += shx<1>(v); v += shx<2>(v); v += shx<4>(v); v += shx<8>(v); v += shx<16>(v); return v; }
__device__ __forceinline__ float wave_sum(float v) { return add32(sum32(v)); }
__device__ __forceinline__ float wave_max(float v) { v = fmaxf(v, shx<1>(v)); v = fmaxf(v, shx<2>(v)); v = fmaxf(v, shx<4>(v)); v = fmaxf(v, shx<8>(v)); v = fmaxf(v, shx<16>(v));
    auto rr = __builtin_amdgcn_permlane32_swap(__float_as_uint(v), __float_as_uint(v), false, false); return fmaxf(__uint_as_float(rr[0]), __uint_as_float(rr[1])); }
__device__ __forceinline__ unsigned pk4_i8(float a, float b, float c, float d) { const int ia = (int)rintf(a), ib = (int)rintf(b), ic = (int)rintf(c), id = (int)rintf(d);
    return ((unsigned)ia & 0xffu) | (((unsigned)ib & 0xffu) << 8) | (((unsigned)ic & 0xffu) << 16) | ((unsigned)id << 24); }
__device__ __forceinline__ int lane_id() { unsigned z = 0u; asm volatile("" : "+v"(z)); return (int)__builtin_amdgcn_mbcnt_hi(~0u, __builtin_amdgcn_mbcnt_lo(~0u, z)); }
__device__ __forceinline__ int opq_tid(int wave) { int t = wave * 64 + lane_id(); asm volatile("" : "+v"(t)); return t; }
__device__ __forceinline__ unsigned pk4_fp8(float a, float b, float c, float d) { unsigned w = 0u; w = __builtin_amdgcn_cvt_pk_fp8_f32(a, b, w, false); w = __builtin_amdgcn_cvt_pk_fp8_f32(c, d, w, true); return w; }
__device__ __forceinline__ float sigmoidf_(float v) { return __builtin_amdgcn_rcpf(1.0f + __builtin_amdgcn_exp2f(-v * LOG2E)); }

#define XB_TMO      128
#define XB_XCNT(j)  (256  + 64 * (j))
#define XB_XSUB(j)  (1280 + 64 * (j))
#define XB_XGEN(j)  (2304 + 64 * (j))
#define XB_TOP      3328
#define XB_TOPGEN   3392
#define XCD_BAR_WORDS 3456
#define XB_SPIN_CAP (1u << 18)

__device__ __forceinline__ unsigned xb_ld(unsigned* p)              { return __hip_atomic_load(p, __ATOMIC_RELAXED, __HIP_MEMORY_SCOPE_AGENT); }
__device__ __forceinline__ unsigned xb_add(unsigned* p, unsigned v) { return __hip_atomic_fetch_add(p, v, __ATOMIC_RELAXED, __HIP_MEMORY_SCOPE_AGENT); }
__device__ __forceinline__ unsigned xb_xcc_id() { return (unsigned)__builtin_amdgcn_s_getreg((3 << 11) | 20) & 0xFu; }
#define XB_SPIN(cond, bar) do { unsigned _sp = 0; while (cond) { __builtin_amdgcn_s_sleep(1); \
    if ((++_sp & 255u) == 0u) { if (xb_ld(&(bar)[XB_TMO])) break; if (_sp > XB_SPIN_CAP) { atomicAdd(&(bar)[XB_TMO], 1u); break; } } } } while (0)

struct XcdBarrier {
    unsigned* bar; unsigned x; int wave;
    volatile LAS unsigned* st;
};
__device__ __forceinline__ XcdBarrier xcd_barrier_post(unsigned* bar, volatile LAS unsigned* st, int wave) {
    XcdBarrier b; b.bar = bar; b.x = xb_xcc_id(); b.st = st; b.wave = wave;
    if (threadIdx.x == 0) (void)xb_add(&bar[XB_XCNT(b.x)], 1u);
    return b;
}
__device__ __forceinline__ void xcd_barrier_complete(unsigned* bar, unsigned x, unsigned& nloc, unsigned& nx) {
    const unsigned G = gridDim.x * gridDim.y * gridDim.z;
    unsigned sum, cnt, mine, sp = 0u;
    for (;;) {
        sum = 0u; cnt = 0u; mine = 0u;
#pragma unroll
        for (unsigned j = 0; j < 16; ++j) { const unsigned c = xb_ld(&bar[XB_XCNT(j)]); sum += c; cnt += (c > 0u) ? 1u : 0u; mine = (j == x) ? c : mine; }
        if (sum == G) break;
        __builtin_amdgcn_s_sleep(1);
        if ((++sp & 255u) == 0u) { if (xb_ld(&bar[XB_TMO])) break; if (sp > XB_SPIN_CAP) { atomicAdd(&bar[XB_TMO], 1u); break; } }
    }
    nloc = mine > 0u ? mine : 1u; nx = cnt > 0u ? cnt : 1u;
}
__device__ __forceinline__ void xcd_barrier(const XcdBarrier& b) {
    asm volatile("s_waitcnt vmcnt(0)" ::: "memory");
    __syncthreads();
    if (b.wave == 0 && lane_id() == 0) {
        unsigned* bar = b.bar;
        __builtin_amdgcn_s_waitcnt(0);
        unsigned nloc = b.st[0], nx = b.st[1];
        if (nloc == 0u) { xcd_barrier_complete(bar, b.x, nloc, nx); b.st[0] = nloc; b.st[1] = nx; }
        const unsigned old = xb_add(&bar[XB_XSUB(b.x)], 1u);
        const unsigned gen = old / nloc;
        if (old + 1u == (gen + 1u) * nloc) {
            __builtin_amdgcn_fence(__ATOMIC_RELEASE, "agent");
            asm volatile("s_waitcnt vmcnt(0)" ::: "memory");
            const unsigned og = xb_add(&bar[XB_TOP], 1u);
            const unsigned tg = og / nx;
            if (og + 1u == (tg + 1u) * nx) xb_add(&bar[XB_TOPGEN], 1u);
            else XB_SPIN(xb_ld(&bar[XB_TOPGEN]) == tg, bar);
            __builtin_amdgcn_fence(__ATOMIC_ACQUIRE, "agent");
            xb_add(&bar[XB_XGEN(b.x)], 1u);
            asm volatile("s_waitcnt vmcnt(0)" ::: "memory");
        } else {
            XB_SPIN(xb_ld(&bar[XB_XGEN(b.x)]) == gen, bar);
            __builtin_amdgcn_fence(__ATOMIC_ACQUIRE, "agent");
            asm volatile("s_waitcnt vmcnt(0)" ::: "memory");
        }
    }
    __syncthreads();
}
namespace pg8 {
#define PG8_LAS __attribute__((address_space(3)))
typedef unsigned short bf16_t;
constexpr int BM = 256, BK = 64, HALF = 128, HTB = HALF * BK * 2  , STAGE_BYTES = 8 * HTB, NXCD = 8, WGM = 8;

__host__ __device__ __forceinline__ int lds_byte(int r, int c) { const int st = (r >> 4) * 2 + (c >> 5), rr = r & 15, cc = c & 31, ob = rr * 64 + cc * 2; return st * 1024 + (ob ^ (((ob >> 9) & 1) << 5)); }
__host__ __device__ __forceinline__ void stage_rc(int b, int& R, int& C) { const int st = b / 1024, sb = b % 1024, swz = sb ^ (((sb >> 9) & 1) << 5); R = (st >> 1) * 16 + swz / 64; C = (st & 1) * 32 + (swz % 64) / 2; }
__host__ __device__ __forceinline__ int perm32(int rho) { const int n = rho >> 4, i = rho & 15; return 8 * (i >> 2) + 4 * n + (i & 3); }

typedef int v8i_t __attribute__((ext_vector_type(8)));
typedef int v4i_t __attribute__((ext_vector_type(4)));
__device__ __forceinline__ v8i_t cat8(bf16x8 lo, bf16x8 hi) { const v4i_t a = __builtin_bit_cast(v4i_t, lo), b = __builtin_bit_cast(v4i_t, hi); return __builtin_shufflevector(a, b, 0, 1, 2, 3, 4, 5, 6, 7); }
__device__ __forceinline__ const char* uptr(const char* p) { const unsigned long long v = (unsigned long long)p; const unsigned lo = (unsigned)__builtin_amdgcn_readfirstlane((int)(unsigned)v), hi = (unsigned)__builtin_amdgcn_readfirstlane((int)(unsigned)(v >> 32)); return (const char*)(((unsigned long long)hi << 32) | lo); }
__device__ __forceinline__ void mx_mfma(f32x4& acc, const v8i_t a, const v8i_t b, const int sa, const int sb) {
    asm volatile("v_mfma_scale_f32_16x16x128_f8f6f4 %0, %1, %2, %0, %3, %4 op_sel_hi:[0,0,0]" : "+v"(acc) : "v"(a), "v"(b), "v"(sa), "v"(sb)); }
__device__ __forceinline__ void i8_mfma(f32x4& acc, const bf16x8 a, const bf16x8 b) {
    asm volatile("v_mfma_i32_16x16x64_i8 %0, %1, %2, %0" : "+v"(acc) : "v"(a), "v"(b)); }
__device__ __forceinline__ f32x4 i2f4(const f32x4 a) { const v4i_t i = __builtin_bit_cast(v4i_t, a); return (f32x4){(float)i[0], (float)i[1], (float)i[2], (float)i[3]}; }
struct Unit { int pm, pn, j; };

__device__ __forceinline__ void tile_of(int L, int nM, int nN, int& pm, int& pn) {
    const int nwg = nM * nN; int wgid = L;
    { const int q = nwg / NXCD, r = nwg % NXCD, xcd = wgid % NXCD, off = wgid / NXCD; wgid = (xcd < r ? xcd * (q + 1) : r * (q + 1) + (xcd - r) * q) + off; }
    const int nig = WGM * nN, gid = wgid / nig, fm = gid * WGM, gsz = (nM - fm) < WGM ? (nM - fm) : WGM;
    pm = fm + ((wgid % nig) % gsz); pn = (wgid % nig) / gsz;
}
struct StaticOrder {
    static constexpr bool SINGLE = false;
    const bf16_t* A; const bf16_t* Bt; int lda, ldb; int nM, nN, nwg, G, c;
    __device__ void init(const bf16_t* A_, int lda_, const bf16_t* Bt_, int ldb_, int M, int N, int G_, int c_) { A = A_; Bt = Bt_; lda = lda_; ldb = ldb_; nM = M / BM; nN = N / BM; nwg = nM * nN; G = G_; c = c_; }
    __device__ __forceinline__ bool next(int i, Unit& u) const { const long L = (long)i * G + c; if (L >= nwg) return false; tile_of((int)L, nM, nN, u.pm, u.pn); u.j = 0; return true; }
    __device__ __forceinline__ const char* pa(const Unit& u) const { return (const char*)(A + (size_t)u.pm * BM * lda); }
    __device__ __forceinline__ const char* pb(const Unit& u) const { return (const char*)(Bt + (size_t)u.pn * BM * ldb); }
    __device__ __forceinline__ void a_ready(const Unit&) const {}
    __device__ __forceinline__ void done(const Unit&) const {}
};
struct OrderG2 {
    static constexpr bool SINGLE = false;
    const bf16_t* A; const bf16_t* Bt; int G, c;
    __device__ __forceinline__ bool next(int i, Unit& u) const { const long L = (long)i * G + c; if (L >= 64 * 7) return false; tile_of((int)L, 64, 7, u.pm, u.pn); u.j = 0; return true; }
    __device__ __forceinline__ const char* pa(const Unit& u) const { return (const char*)(A + (size_t)u.pm * BM * ZP + (u.pn < 3 ? 0 : 512)); }
    __device__ __forceinline__ const char* pb(const Unit& u) const { return (const char*)(Bt + (size_t)u.pn * BM * 512); }
    __device__ __forceinline__ void a_ready(const Unit&) const {}
    __device__ __forceinline__ void done(const Unit&) const {}
};
struct OrderG3 {
    static constexpr bool SINGLE = false;
    const bf16_t* A; const bf16_t* Bt; int G, c;
    __device__ __forceinline__ bool next(int i, Unit& u) const { const long t = (long)(i >> 2) * G + c; if (t >= 512) return false; tile_of((int)t, 64, 8, u.pm, u.pn); u.j = i & 3; return true; }
    __device__ __forceinline__ const char* pa(const Unit& u) const { return (const char*)(A + (size_t)u.pm * BM * D + u.j * 512); }
    __device__ __forceinline__ const char* pb(const Unit& u) const { return (const char*)(Bt + (size_t)u.j * D * 512 + (size_t)u.pn * BM * 512); }
    __device__ __forceinline__ void a_ready(const Unit&) const {}
    __device__ __forceinline__ void done(const Unit&) const {}
};

__device__ __forceinline__ v4u pack8(const f32x4 v0, const f32x4 v1) { v4u w; w.x = cvt_pk_bf16(v0[0], v0[1]); w.y = cvt_pk_bf16(v0[2], v0[3]); w.z = cvt_pk_bf16(v1[0], v1[1]); w.w = cvt_pk_bf16(v1[2], v1[3]); return w; }
__device__ __forceinline__ f32x4 sig4(const f32x4 v) { f32x4 r; r[0] = sigmoidf_(v[0]); r[1] = sigmoidf_(v[1]); r[2] = sigmoidf_(v[2]); r[3] = sigmoidf_(v[3]); return r; }
__device__ __forceinline__ void unpack8(const v4u w, f32x4& a, f32x4& b) { a[0] = bflo(w.x); a[1] = bfhi(w.x); a[2] = bflo(w.y); a[3] = bfhi(w.y); b[0] = bflo(w.z); b[1] = bfhi(w.z); b[2] = bflo(w.w); b[3] = bfhi(w.w); }

struct EpiG1 {
    static constexpr bool XCHG = false;
    bf16_t* Z; bf16_t* GT;
    __device__ __forceinline__ void operator()(const f32x4 (&acc)[2][2][4][2], const Unit& u, int wr, int wc, int fr, int fq) const {
        const int row0 = u.pm * BM + wr * 64 + fr, cw = wc * 32 + 8 * fq;
        if (u.pn < 19) {
            bf16_t* base = Z + u.pn * BM + cw;
#pragma unroll
            for (int ai = 0; ai < 2; ++ai)
#pragma unroll
                for (int m = 0; m < 4; ++m) { bf16_t* rowp = base + (size_t)(row0 + ai * HALF + m * 16) * ZP;
#pragma unroll
                    for (int bj = 0; bj < 2; ++bj) *(v4u*)(rowp + bj * HALF) = pack8(acc[ai][bj][m][0], acc[ai][bj][m][1]); }
        } else {
            bf16_t* base = GT + (u.pn - 19) * BM + cw;
#pragma unroll
            for (int ai = 0; ai < 2; ++ai)
#pragma unroll
                for (int m = 0; m < 4; ++m) { bf16_t* rowp = base + (size_t)(row0 + ai * HALF + m * 16) * NG;
#pragma unroll
                    for (int bj = 0; bj < 2; ++bj) *(v4u*)(rowp + bj * HALF) = pack8(sig4(acc[ai][bj][m][0]), sig4(acc[ai][bj][m][1])); }
        }
    }
};
struct EpiGate {
    static constexpr bool XCHG = false;
    bf16_t* GT;
    __device__ __forceinline__ void operator()(const f32x4 (&acc)[2][2][4][2], const Unit& u, int wr, int wc, int fr, int fq) const {
        const int row0 = u.pm * BM + wr * 64 + fr; bf16_t* base = GT + u.pn * BM + wc * 32 + 8 * fq;
#pragma unroll
        for (int ai = 0; ai < 2; ++ai)
#pragma unroll
            for (int m = 0; m < 4; ++m) { bf16_t* rowp = base + (size_t)(row0 + ai * HALF + m * 16) * NG;
#pragma unroll
                for (int bj = 0; bj < 2; ++bj) *(v4u*)(rowp + bj * HALF) = pack8(sig4(acc[ai][bj][m][0]), sig4(acc[ai][bj][m][1])); }
    }
};
struct EpiGateI8 {
    static constexpr bool XCHG = false;
    bf16_t* GT; const float* SA; const float* CM;
    __device__ __forceinline__ void operator()(const f32x4 (&acc)[2][2][4][2], const Unit& u, int wr, int wc, int fr, int fq) const {
        const int row0 = u.pm * BM + wr * 64 + fr, c0 = u.pn * BM + wc * 32 + 8 * fq; bf16_t* base = GT + c0;
        f32x4 sw[2][2];
#pragma unroll
        for (int bj = 0; bj < 2; ++bj) { sw[bj][0] = *(const f32x4*)(CM + c0 + bj * HALF) * (1.0f / 127.0f); sw[bj][1] = *(const f32x4*)(CM + c0 + bj * HALF + 4) * (1.0f / 127.0f); }
#pragma unroll
        for (int ai = 0; ai < 2; ++ai)
#pragma unroll
            for (int m = 0; m < 4; ++m) { const int row = row0 + ai * HALF + m * 16; const float sa = SA[row]; bf16_t* rowp = base + (size_t)row * NG;
#pragma unroll
                for (int bj = 0; bj < 2; ++bj) *(v4u*)(rowp + bj * HALF) = pack8(sig4(i2f4(acc[ai][bj][m][0]) * sw[bj][0] * sa), sig4(i2f4(acc[ai][bj][m][1]) * sw[bj][1] * sa)); }
    }
};
struct EpiPleI8 {
    static constexpr bool XCHG = false;
    const bf16_t* P2; bf16_t* O; const float* SA; const float* CM;
    __device__ __forceinline__ void operator()(const f32x4 (&acc)[2][2][4][2], const Unit& u, int wr, int wc, int fr, int fq) const {
        const int row0 = u.pm * BM + wr * 64 + fr; const int c0 = u.pn * BM + wc * 32 + 8 * fq;
        f32x4 sw[2][2];
#pragma unroll
        for (int bj = 0; bj < 2; ++bj) { sw[bj][0] = *(const f32x4*)(CM + c0 + bj * HALF) * (1.0f / 127.0f); sw[bj][1] = *(const f32x4*)(CM + c0 + bj * HALF + 4) * (1.0f / 127.0f); }
#pragma unroll
        for (int ai = 0; ai < 2; ++ai)
#pragma unroll
            for (int m = 0; m < 4; ++m) { const int row = row0 + ai * HALF + m * 16; const float sa = SA[row]; const size_t ro = (size_t)row * D + c0;
#pragma unroll
                for (int bj = 0; bj < 2; ++bj) { f32x4 p0, p1; unpack8(*(const v4u*)(P2 + ro + bj * HALF), p0, p1);
                    *(v4u*)(O + ro + bj * HALF) = pack8(sig4(i2f4(acc[ai][bj][m][0]) * sw[bj][0] * sa) * p0, sig4(i2f4(acc[ai][bj][m][1]) * sw[bj][1] * sa) * p1); }
                asm volatile("" ::: "memory"); }
    }
};
struct EpiSwiGLUI8 {
    static constexpr bool XCHG = false;
    bf16_t* Hd; const float* SA; const float* CM;
    __device__ __forceinline__ void operator()(const f32x4 (&acc)[2][2][4][2], const Unit& u, int wr, int wc, int fr, int fq) const {
        const int row0 = u.pm * BM + wr * 64 + fr; const int c0 = u.pn * HALF + wc * 32 + 8 * fq; bf16_t* base = Hd + c0;
        const f32x4 sg0 = *(const f32x4*)(CM + c0) * (1.0f / 127.0f), sg1 = *(const f32x4*)(CM + c0 + 4) * (1.0f / 127.0f);
        const f32x4 su0 = *(const f32x4*)(CM + FF + c0) * (1.0f / 127.0f), su1 = *(const f32x4*)(CM + FF + c0 + 4) * (1.0f / 127.0f);
#pragma unroll
        for (int ai = 0; ai < 2; ++ai)
#pragma unroll
            for (int m = 0; m < 4; ++m) { const int row = row0 + ai * HALF + m * 16; const float sa = SA[row]; bf16_t* rowp = base + (size_t)row * FF;
                const f32x4 g0 = i2f4(acc[ai][0][m][0]) * sg0 * sa, g1 = i2f4(acc[ai][0][m][1]) * sg1 * sa;
                const f32x4 v0 = g0 * sig4(g0) * (i2f4(acc[ai][1][m][0]) * su0 * sa), v1 = g1 * sig4(g1) * (i2f4(acc[ai][1][m][1]) * su1 * sa);
                *(v4u*)rowp = pack8(v0, v1); }
    }
};
struct EpiG2 {
    static constexpr bool XCHG = false;
    bf16_t* QM; bf16_t* KVM; unsigned* KN2;
    __device__ __forceinline__ void operator()(const f32x4 (&acc)[2][2][4][2], const Unit& u, int wr, int wc, int fr, int fq) const {
        const int row0 = u.pm * BM + wr * 64 + fr, cw = wc * 32 + 8 * fq;
        const int ldc = u.pn < 3 ? QM_P : KVM_P; bf16_t* base = (u.pn < 3 ? QM + u.pn * BM : KVM + (u.pn - 3) * BM) + cw;
        if (KN2 != nullptr && u.pn >= 3) {
            float mx = 0.f;
#pragma unroll
            for (int ai = 0; ai < 2; ++ai)
#pragma unroll
                for (int m = 0; m < 4; ++m) { const f32x4 a = acc[ai][0][m][0], b = acc[ai][0][m][1];
                    mx = fmaxf(mx, (a[0] * a[0] + a[1] * a[1]) + (a[2] * a[2] + a[3] * a[3]) + (b[0] * b[0] + b[1] * b[1]) + (b[2] * b[2] + b[3] * b[3])); }
            mx = fmaxf(mx, shx<1>(mx)); mx = fmaxf(mx, shx<2>(mx)); mx = fmaxf(mx, shx<4>(mx)); mx = fmaxf(mx, shx<8>(mx));
            if (fr == 0) atomicMax(KN2 + (u.pn - 3) * 16 + wc * 4 + fq, __float_as_uint(mx));
        }
#pragma unroll
        for (int ai = 0; ai < 2; ++ai)
#pragma unroll
            for (int m = 0; m < 4; ++m) { bf16_t* rowp = base + (size_t)(row0 + ai * HALF + m * 16) * ldc;
#pragma unroll
                for (int bj = 0; bj < 2; ++bj) *(v4u*)(rowp + bj * HALF) = pack8(acc[ai][bj][m][0], acc[ai][bj][m][1]); }
    }
};
struct EpiPlain {
    static constexpr bool XCHG = false;
    bf16_t* O; int ldc;
    __device__ __forceinline__ void operator()(const f32x4 (&acc)[2][2][4][2], const Unit& u, int wr, int wc, int fr, int fq) const {
        const int row0 = u.pm * BM + wr * 64 + fr; bf16_t* base = O + u.pn * BM + wc * 32 + 8 * fq;
#pragma unroll
        for (int ai = 0; ai < 2; ++ai)
#pragma unroll
            for (int m = 0; m < 4; ++m) { bf16_t* rowp = base + (size_t)(row0 + ai * HALF + m * 16) * ldc;
#pragma unroll
                for (int bj = 0; bj < 2; ++bj) *(v4u*)(rowp + bj * HALF) = pack8(acc[ai][bj][m][0], acc[ai][bj][m][1]); }
    }
};
struct EpiSwiGLU {
    static constexpr bool XCHG = false;
    bf16_t* Hd;
    __device__ __forceinline__ void operator()(const f32x4 (&acc)[2][2][4][2], const Unit& u, int wr, int wc, int fr, int fq) const {
        const int row0 = u.pm * BM + wr * 64 + fr; bf16_t* base = Hd + u.pn * HALF + wc * 32 + 8 * fq;
#pragma unroll
        for (int ai = 0; ai < 2; ++ai)
#pragma unroll
            for (int m = 0; m < 4; ++m) { bf16_t* rowp = base + (size_t)(row0 + ai * HALF + m * 16) * FF;
                const f32x4 g0 = acc[ai][0][m][0], g1 = acc[ai][0][m][1];
                const f32x4 v0 = g0 * sig4(g0) * acc[ai][1][m][0], v1 = g1 * sig4(g1) * acc[ai][1][m][1];
                *(v4u*)rowp = pack8(v0, v1); }
    }
};
struct EpiPle {
    static constexpr bool XCHG = false;
    const bf16_t* P2; bf16_t* O;
    __device__ __forceinline__ void operator()(const f32x4 (&acc)[2][2][4][2], const Unit& u, int wr, int wc, int fr, int fq) const {
        const int row0 = u.pm * BM + wr * 64 + fr; const int c0 = u.pn * BM + wc * 32 + 8 * fq;
#pragma unroll
        for (int ai = 0; ai < 2; ++ai)
#pragma unroll
            for (int m = 0; m < 4; ++m) { const size_t ro = (size_t)(row0 + ai * HALF + m * 16) * D + c0;
#pragma unroll
                for (int bj = 0; bj < 2; ++bj) { f32x4 p0, p1; unpack8(*(const v4u*)(P2 + ro + bj * HALF), p0, p1);
                    *(v4u*)(O + ro + bj * HALF) = pack8(sig4(acc[ai][bj][m][0]) * p0, sig4(acc[ai][bj][m][1]) * p1); }
                asm volatile("" ::: "memory"); }
    }
};
struct EpiG3 {
    static constexpr bool XCHG = false;
    const bf16_t* GT; bf16_t* MF; bf16_t* MG;
    __device__ __forceinline__ void operator()(const f32x4 (&acc)[2][2][4][2], const Unit& u, int wr, int wc, int fr, int fq) const {
        const int row0 = u.pm * BM + wr * 64 + fr; const int c0 = u.pn * BM + wc * 32 + 8 * fq; const int j = u.j;
        bf16_t* const dst = (j < 3) ? MF : MG;
#pragma unroll
        for (int ai = 0; ai < 2; ++ai)
#pragma unroll
            for (int m = 0; m < 4; ++m) { const size_t row = (size_t)(row0 + ai * HALF + m * 16);
#pragma unroll
                for (int bj = 0; bj < 2; ++bj) { const int c = c0 + bj * HALF;
                    f32x4 g0, g1; unpack8(*(const v4u*)(GT + row * NG + j * D + c), g0, g1);
                    f32x4 v0 = g0 * acc[ai][bj][m][0], v1 = g1 * acc[ai][bj][m][1];
                    if (j > 0) { f32x4 p0, p1; unpack8(*(const v4u*)(MF + row * D + c), p0, p1); v0 += p0; v1 += p1; }
                    *(v4u*)(dst + row * D + c) = pack8(v0, v1); }
                asm volatile("" ::: "memory"); }
    }
};


struct PanelOrder {
    static constexpr bool SINGLE = true;
    const bf16_t* A; const bf16_t* Bt; int lda, ldb, G, c, round;
    __device__ __forceinline__ bool next(int i, Unit& u) const { if (i >= 1 || G != 256) return false; const int k = c >> 3; u.pm = round * 32 + (c & 7) * 4 + (k >> 3); u.pn = k & 7; u.j = round; return true; }
    __device__ __forceinline__ const char* pa(const Unit& u) const { return (const char*)(A + (size_t)u.pm * BM * lda); }
    __device__ __forceinline__ const char* pb(const Unit& u) const { return (const char*)(Bt + (size_t)u.pn * BM * ldb); }
    __device__ __forceinline__ void a_ready(const Unit&) const {}
    __device__ __forceinline__ void done(const Unit&) const {}
};
constexpr int XCH_LDS_OFF = 131072 + 1024;
struct RmsXchg {
    float* xbuf;
    unsigned* cnt;
    unsigned* tmo;
    __device__ __forceinline__ void run(const f32x4 (&v)[2][2][4][2], const Unit& u, int wr, int wc, int fr, int fq, PG8_LAS unsigned char* lds, int wid, int lane) const {
        PG8_LAS float* P = (PG8_LAS float*)(lds + XCH_LDS_OFF);
        PG8_LAS float* Sx = (PG8_LAS float*)(lds + XCH_LDS_OFF + 4096);
        PG8_LAS unsigned* flag = (PG8_LAS unsigned*)(lds + XCH_LDS_OFF + 4096 + 1024);
#pragma unroll
        for (int ai = 0; ai < 2; ++ai)
#pragma unroll
            for (int m = 0; m < 4; ++m) { float s = 0.f;
#pragma unroll
                for (int bj = 0; bj < 2; ++bj)
#pragma unroll
                    for (int n = 0; n < 2; ++n) { const f32x4 x = v[ai][bj][m][n]; s += (x[0] * x[0] + x[1] * x[1]) + (x[2] * x[2] + x[3] * x[3]); }
                s += shx<16>(s); s = add32(s);
                if (fq == 0) P[(ai * HALF + wr * 64 + m * 16 + fr) * 4 + wc] = s; }
        asm volatile("s_waitcnt lgkmcnt(0)" ::: "memory"); __builtin_amdgcn_s_barrier(); asm volatile("" ::: "memory");
        const int row = wid * 32 + (lane & 31);
        if (lane < 32) { const float t = (P[row * 4 + 0] + P[row * 4 + 1]) + (P[row * 4 + 2] + P[row * 4 + 3]);
            __hip_atomic_store(xbuf + ((size_t)u.pm * BM + row) * 8 + u.pn, t, __ATOMIC_RELAXED, __HIP_MEMORY_SCOPE_AGENT); }
        asm volatile("s_waitcnt vmcnt(0)" ::: "memory");
        if (lane == 0) __hip_atomic_fetch_add(cnt + 64 * u.pm, 1u, __ATOMIC_RELAXED, __HIP_MEMORY_SCOPE_AGENT);
        if (wid == 0) {
            const unsigned long long t0 = __builtin_amdgcn_s_memrealtime(); unsigned polls = 0;
            for (;;) {
                if ((unsigned)__builtin_amdgcn_readfirstlane(__hip_atomic_load(cnt + 64 * u.pm, __ATOMIC_RELAXED, __HIP_MEMORY_SCOPE_AGENT)) >= 64u) break;
                if ((++polls & 63u) == 0u) { if (__builtin_amdgcn_readfirstlane(__hip_atomic_load(tmo, __ATOMIC_RELAXED, __HIP_MEMORY_SCOPE_AGENT)) != 0u) break;
                    if (__builtin_amdgcn_s_memrealtime() - t0 > 2000000ull) { if (lane == 0) __hip_atomic_store(tmo, 1u, __ATOMIC_RELAXED, __HIP_MEMORY_SCOPE_AGENT); break; } }
                __builtin_amdgcn_s_sleep(2);
            }
            __builtin_amdgcn_fence(__ATOMIC_ACQUIRE, "agent");
            if (lane == 0) flag[0] = 0u;
        }
        asm volatile("s_waitcnt vmcnt(0) lgkmcnt(0)" ::: "memory"); __builtin_amdgcn_s_barrier(); asm volatile("" ::: "memory");
        if (lane < 32) { const float* slot = xbuf + ((size_t)u.pm * BM + row) * 8; float t = 0.f;
#pragma unroll
            for (int q = 0; q < 8; ++q) t += __hip_atomic_load(slot + q, __ATOMIC_RELAXED, __HIP_MEMORY_SCOPE_AGENT);
            Sx[row] = 1.0f / sqrtf(t * (1.0f / 2048.0f) + 1e-6f); }
        asm volatile("s_waitcnt lgkmcnt(0)" ::: "memory"); __builtin_amdgcn_s_barrier(); asm volatile("" ::: "memory");
    }
};
template <int PRE, int POST> struct EpiNorm {
    static constexpr bool XCHG = true;
    float* X; bf16_t* Hout; const bf16_t* P2; const float* gpost; const float* gpre; RmsXchg st1, st2;
    __device__ __forceinline__ void fused(f32x4 (&acc)[2][2][4][2], const Unit& u, int wr, int wc, int fr, int fq, PG8_LAS unsigned char* lds, int wid, int lane) const {
        const PG8_LAS float* Sx = (const PG8_LAS float*)(lds + XCH_LDS_OFF + 4096);
        const int row0 = u.pm * BM + wr * 64 + fr, c0 = u.pn * BM + wc * 32 + 8 * fq;
        if constexpr (PRE == 1) {
#pragma unroll
            for (int ai = 0; ai < 2; ++ai)
#pragma unroll
                for (int m = 0; m < 4; ++m) { const size_t ro = (size_t)(row0 + ai * HALF + m * 16) * D + c0;
#pragma unroll
                    for (int bj = 0; bj < 2; ++bj) { f32x4 p0, p1; unpack8(*(const v4u*)(P2 + ro + bj * HALF), p0, p1);
                        acc[ai][bj][m][0] = sig4(acc[ai][bj][m][0]) * p0; acc[ai][bj][m][1] = sig4(acc[ai][bj][m][1]) * p1;
                        asm volatile("" : "+v"(acc[ai][bj][m][0]), "+v"(acc[ai][bj][m][1])); asm volatile("" ::: "memory"); }
                    asm volatile("" : "+v"(acc[ai][0][m][0]), "+v"(acc[ai][0][m][1]), "+v"(acc[ai][1][m][0]), "+v"(acc[ai][1][m][1])); asm volatile("" ::: "memory"); }
        }
        st1.run(acc, u, wr, wc, fr, fq, lds, wid, lane);
#pragma unroll
        for (int ai = 0; ai < 2; ++ai)
#pragma unroll
            for (int m = 0; m < 4; ++m) { const int r = ai * HALF + wr * 64 + m * 16 + fr; const float rs = Sx[r]; const size_t ro = (size_t)(u.pm * BM + r) * D + c0;
#pragma unroll
                for (int bj = 0; bj < 2; ++bj) { float* xp = X + ro + bj * HALF; const float* gp = gpost + c0 + bj * HALF;
                    const f32x4 x0 = *(const f32x4*)xp, x1 = *(const f32x4*)(xp + 4), g0 = *(const f32x4*)gp, g1 = *(const f32x4*)(gp + 4);
                    const f32x4 n0 = x0 + acc[ai][bj][m][0] * rs * g0, n1 = x1 + acc[ai][bj][m][1] * rs * g1;
                    *(f32x4*)xp = n0; *(f32x4*)(xp + 4) = n1; acc[ai][bj][m][0] = n0; acc[ai][bj][m][1] = n1;
                    if constexpr (POST == 2) *(v4u*)(Hout + ro + bj * HALF) = pack8(n0, n1);
                    asm volatile("" : "+v"(acc[ai][bj][m][0]), "+v"(acc[ai][bj][m][1])); asm volatile("" ::: "memory"); }
                asm volatile("" : "+v"(acc[ai][0][m][0]), "+v"(acc[ai][0][m][1]), "+v"(acc[ai][1][m][0]), "+v"(acc[ai][1][m][1])); asm volatile("" ::: "memory"); }
        if constexpr (POST == 1) {
            st2.run(acc, u, wr, wc, fr, fq, lds, wid, lane);
#pragma unroll
            for (int ai = 0; ai < 2; ++ai)
#pragma unroll
                for (int m = 0; m < 4; ++m) { const int r = ai * HALF + wr * 64 + m * 16 + fr; const float rs = Sx[r]; const size_t ro = (size_t)(u.pm * BM + r) * D + c0;
#pragma unroll
                    for (int bj = 0; bj < 2; ++bj) { const float* gp = gpre + c0 + bj * HALF; const f32x4 g0 = *(const f32x4*)gp, g1 = *(const f32x4*)(gp + 4);
                        *(v4u*)(Hout + ro + bj * HALF) = pack8(acc[ai][bj][m][0] * rs * g0, acc[ai][bj][m][1] * rs * g1); asm volatile("" ::: "memory"); }
                    }
        }
    }
};

template <class Epi, class Sched, bool ALIGN_EPI = true, bool FP8 = false, bool I8 = false>
__device__ __forceinline__ void gemm_phase(PG8_LAS unsigned char* lds, const int wv, const int K, const int lda, const int ldb, const Sched& S, const Epi& E) {
    const int tid = opq_tid(wv), wid = __builtin_amdgcn_readfirstlane(tid >> 6), lane = tid & 63, wr = wid >> 2, wc = wid & 3, fr = lane & 15, fq = lane >> 4;
    const int nt = FP8 ? K / 128 : K / BK;
    unsigned voffA[2], voffB[2];
#pragma unroll
    for (int i = 0; i < 2; ++i) { int R, C; stage_rc(tid * 16 + i * 8192, R, C); const int Rb = (R & ~31) + perm32(R & 31);
        if constexpr (FP8) { const int p_ = C >> 3, g_ = (p_ < 4) ? 2 * p_ : 2 * (p_ - 4) + 1; voffA[i] = (unsigned)(R * lda + g_ * 16); voffB[i] = (unsigned)(Rb * ldb + g_ * 16); }
        else { voffA[i] = (unsigned)(R * lda + C) * 2u; voffB[i] = (unsigned)(Rb * ldb + C) * 2u; } }
    const size_t kstep = (size_t)(BK * 2);
    const size_t hstepA = (size_t)HALF * lda * (FP8 ? 1 : 2), hstepB = (size_t)HALF * ldb * (FP8 ? 1 : 2);
    const unsigned ldsw = (unsigned)wid * 1024u;
    const int aoff = lds_byte(wr * 64 + fr, fq * 8), boff = lds_byte(wc * 32 + fr, fq * 8);
#define PG8_SA(b, h) (((b) * 2 + (h)) * HTB)
#define PG8_SB(b, h) ((4 + (b) * 2 + (h)) * HTB)
#define PG8_STAGE(bufoff, gbase, voff) do { const char* gb_ = uptr((const char*)(gbase)); _Pragma("unroll") for (int _i = 0; _i < 2; ++_i) \
        __builtin_amdgcn_global_load_lds((const unsigned*)(gb_ + (voff)[_i]), (PG8_LAS unsigned*)(lds + (bufoff) + ldsw + _i * 8192), 16, 0, 0); } while (0)
#define PG8_LDA(dst, b, h) do { _Pragma("unroll") for (int m = 0; m < 4; ++m) _Pragma("unroll") for (int k = 0; k < 2; ++k) dst[m][k] = *(const PG8_LAS bf16x8*)(lds + PG8_SA(b, h) + aoff + m * 2048 + k * 1024); } while (0)
#define PG8_LDB(dst, b, h) do { _Pragma("unroll") for (int n = 0; n < 2; ++n) _Pragma("unroll") for (int k = 0; k < 2; ++k) dst[n][k] = *(const PG8_LAS bf16x8*)(lds + PG8_SB(b, h) + boff + n * 2048 + k * 1024); } while (0)
#define PG8_MMA(ai, bj, At, Bt) do { __builtin_amdgcn_s_setprio(1); \
        if constexpr (FP8) { _Pragma("unroll") for (int m = 0; m < 4; ++m) _Pragma("unroll") for (int n = 0; n < 2; ++n) \
            mx_mfma(acc[ai][bj][m][n], cat8(Bt[n][0], Bt[n][1]), cat8(At[m][0], At[m][1]), sc_w, sc_a); } \
        else if constexpr (I8) { _Pragma("unroll") for (int m = 0; m < 4; ++m) _Pragma("unroll") for (int n = 0; n < 2; ++n) _Pragma("unroll") for (int k = 0; k < 2; ++k) \
            i8_mfma(acc[ai][bj][m][n], Bt[n][k], At[m][k]); } \
        else { _Pragma("unroll") for (int m = 0; m < 4; ++m) _Pragma("unroll") for (int n = 0; n < 2; ++n) _Pragma("unroll") for (int k = 0; k < 2; ++k) \
            acc[ai][bj][m][n] = __builtin_amdgcn_mfma_f32_16x16x32_bf16(Bt[n][k], At[m][k], acc[ai][bj][m][n], 0, 0, 0); } \
        __builtin_amdgcn_s_setprio(0); } while (0)
#define PG8_WAIT_V(n) asm volatile("s_waitcnt vmcnt(" #n ")" ::: "memory")
#define PG8_WAIT_L(n) asm volatile("s_waitcnt lgkmcnt(" #n ")" ::: "memory")
#define PG8_BAR __builtin_amdgcn_s_barrier()
#define PG8_SCHED __builtin_amdgcn_sched_barrier(0)
    Unit cur, nxt; int ui = 0;
    if (!S.next(0, cur)) return;
    f32x4 acc[2][2][4][2];
#pragma unroll
    for (int a = 0; a < 2; ++a)
#pragma unroll
        for (int b = 0; b < 2; ++b)
#pragma unroll
            for (int m = 0; m < 4; ++m)
#pragma unroll
                for (int n = 0; n < 2; ++n) acc[a][b][m][n] = (f32x4){0.f, 0.f, 0.f, 0.f};
    bf16x8 At[4][2], B0[2][2], B1[2][2];
    int sc_w = 0x79797979, sc_a = 0x7f7f7f7f; if constexpr (FP8) asm volatile("" : "+v"(sc_w), "+v"(sc_a));
    const char* cA = S.pa(cur); const char* cB = S.pb(cur);
    S.a_ready(cur);
    PG8_STAGE(PG8_SB(0, 0), cB, voffB); PG8_STAGE(PG8_SB(0, 1), cB + hstepB, voffB); PG8_STAGE(PG8_SA(0, 0), cA, voffA); PG8_STAGE(PG8_SA(0, 1), cA + hstepA, voffA);
    if (wr == 1) PG8_BAR;
    PG8_WAIT_V(2); PG8_BAR;
    PG8_STAGE(PG8_SB(1, 0), cB + kstep, voffB); PG8_STAGE(PG8_SA(1, 0), cA + kstep, voffA); PG8_STAGE(PG8_SB(1, 1), cB + hstepB + kstep, voffB);
    PG8_WAIT_V(6); PG8_BAR;
    for (;;) {
        const bool has_next = Sched::SINGLE ? false : S.next(ui + 1, nxt);
        const char* nA = has_next ? S.pa(nxt) : cA; const char* nB = has_next ? S.pb(nxt) : cB;
#pragma unroll 1
        for (int t = 0; t < nt; t += 2) {
            const bool last = (t == nt - 2);
            const char* a1 = cA + (size_t)(t + 1) * kstep;
            const char* a2 = last ? nA : cA + (size_t)(t + 2) * kstep; const char* b2 = last ? nB : cB + (size_t)(t + 2) * kstep;
            const char* a3 = a2 + kstep; const char* b3 = b2 + kstep;
            if (last && has_next) S.a_ready(nxt);
            PG8_LDB(B0, 0, 0); PG8_LDB(B1, 0, 1); PG8_SCHED; PG8_LDA(At, 0, 0); PG8_STAGE(PG8_SA(1, 1), a1 + hstepA, voffA);
            PG8_WAIT_V(8); PG8_WAIT_L(0); PG8_BAR; PG8_MMA(0, 0, At, B0); PG8_MMA(0, 1, At, B1); PG8_BAR; PG8_SCHED;
            PG8_LDA(At, 0, 1); PG8_STAGE(PG8_SB(0, 0), b2, voffB); PG8_STAGE(PG8_SB(0, 1), b2 + hstepB, voffB); PG8_STAGE(PG8_SA(0, 0), a2, voffA);
            PG8_WAIT_V(8); PG8_WAIT_L(0); PG8_BAR; PG8_MMA(1, 0, At, B0); PG8_MMA(1, 1, At, B1); PG8_BAR; PG8_SCHED;
            PG8_LDB(B0, 1, 0); PG8_LDB(B1, 1, 1); PG8_SCHED; PG8_LDA(At, 1, 0); PG8_STAGE(PG8_SA(0, 1), a2 + hstepA, voffA);
            PG8_WAIT_V(8); PG8_WAIT_L(0); PG8_BAR; PG8_MMA(0, 0, At, B0); PG8_MMA(0, 1, At, B1); PG8_BAR; PG8_SCHED;
            PG8_LDA(At, 1, 1); PG8_STAGE(PG8_SB(1, 0), b3, voffB); PG8_STAGE(PG8_SB(1, 1), b3 + hstepB, voffB); PG8_STAGE(PG8_SA(1, 0), a3, voffA);
            PG8_WAIT_V(8); PG8_WAIT_L(0); PG8_BAR; PG8_MMA(1, 0, At, B0); PG8_MMA(1, 1, At, B1); PG8_BAR; PG8_SCHED;
        }
        if constexpr (FP8 || I8) asm volatile("s_nop 15\n\ts_nop 15" ::: "memory");
        if constexpr (ALIGN_EPI) { if (wr == 0) PG8_BAR; }
        if constexpr (Epi::XCHG) E.fused(acc, cur, wr, wc, fr, fq, lds, wid, lane); else E(acc, cur, wr, wc, fr, fq);
        S.done(cur);
        if (!has_next) break;
#pragma unroll
        for (int a = 0; a < 2; ++a)
#pragma unroll
            for (int b = 0; b < 2; ++b)
#pragma unroll
                for (int m = 0; m < 4; ++m)
#pragma unroll
                    for (int n = 0; n < 2; ++n) acc[a][b][m][n] = (f32x4){0.f, 0.f, 0.f, 0.f};
        cur = nxt; cA = nA; cB = nB; ++ui;
        if constexpr (ALIGN_EPI) { if (wr == 1) PG8_BAR; }
    }
    PG8_WAIT_V(0);
    if constexpr (!ALIGN_EPI) { if (wr == 0) PG8_BAR; }
    PG8_BAR;
#undef PG8_SA
#undef PG8_SB
#undef PG8_STAGE
#undef PG8_LDA
#undef PG8_LDB
#undef PG8_MMA
#undef PG8_WAIT_V
#undef PG8_WAIT_L
#undef PG8_BAR
#undef PG8_SCHED
}

struct OrderG3h {
    static constexpr bool SINGLE = false;
    const bf16_t* A; const bf16_t* Bt; int G, c;
    __device__ __forceinline__ bool next(int i, Unit& u) const { const long t = (long)(i >> 2) * G + c; if (t >= 1024) return false; tile_of((int)t, 64, 16, u.pm, u.pn); u.j = i & 3; return true; }
    __device__ __forceinline__ const char* pa(const Unit& u) const { return (const char*)(A + (size_t)u.pm * BM * D + u.j * 512); }
    __device__ __forceinline__ const char* pb(const Unit& u) const { return (const char*)(Bt + (size_t)u.j * D * 512 + (size_t)u.pn * HALF * 512); }
};
struct EpiG3h {
    const bf16_t* GT; bf16_t* MG;
    __device__ __forceinline__ void operator()(const f32x4 (&acc)[2][4][2], f32x4 (&mg)[2][4][2], const Unit& u, int wr, int wc, int fr, int fq) const {
        const int row0 = u.pm * BM + wr * 64 + fr; const int c0 = u.pn * HALF + wc * 32 + 8 * fq; const int j = u.j;
#pragma unroll
        for (int ai = 0; ai < 2; ++ai)
#pragma unroll
            for (int m = 0; m < 4; ++m) { const size_t row = (size_t)(row0 + ai * HALF + m * 16);
                f32x4 g0, g1; unpack8(*(const v4u*)(GT + row * NG + j * D + c0), g0, g1);
                f32x4 v0 = g0 * acc[ai][m][0], v1 = g1 * acc[ai][m][1];
                if (j > 0) { v0 += mg[ai][m][0]; v1 += mg[ai][m][1]; }
                mg[ai][m][0] = v0; mg[ai][m][1] = v1;
                if (j == 3) *(v4u*)(MG + row * D + c0) = pack8(v0, v1); }
    }
};
template <class Epi, class Sched>
__device__ __forceinline__ void gemm_phase_h(PG8_LAS unsigned char* lds, const int wv, const int K, const int lda, const int ldb, const Sched& S, const Epi& E) {
    const int tid = opq_tid(wv), wid = __builtin_amdgcn_readfirstlane(tid >> 6), lane = tid & 63, wr = wid >> 2, wc = wid & 3, fr = lane & 15, fq = lane >> 4;
    const int nt = K / BK;
    unsigned voffA[2], voffB[2];
#pragma unroll
    for (int i = 0; i < 2; ++i) { int R, C; stage_rc(tid * 16 + i * 8192, R, C); const int Rb = (R & ~31) + perm32(R & 31);
        voffA[i] = (unsigned)(R * lda + C) * 2u; voffB[i] = (unsigned)(Rb * ldb + C) * 2u; }
    const size_t kstep = (size_t)(BK * 2);
    const size_t hstepA = (size_t)HALF * lda * 2;
    const unsigned ldsw = (unsigned)wid * 1024u;
    const int aoff = lds_byte(wr * 64 + fr, fq * 8), boff = lds_byte(wc * 32 + fr, fq * 8);
#define PG8_SA(b, h) (((b) * 2 + (h)) * HTB)
#define PG8_SB(b) ((4 + (b) * 2) * HTB)
#define PG8_STAGE(bufoff, gbase, voff) do { const char* gb_ = uptr((const char*)(gbase)); _Pragma("unroll") for (int _i = 0; _i < 2; ++_i) \
        __builtin_amdgcn_global_load_lds((const unsigned*)(gb_ + (voff)[_i]), (PG8_LAS unsigned*)(lds + (bufoff) + ldsw + _i * 8192), 16, 0, 0); } while (0)
#define PG8_LDA(dst, b, h) do { _Pragma("unroll") for (int m = 0; m < 4; ++m) _Pragma("unroll") for (int k = 0; k < 2; ++k) dst[m][k] = *(const PG8_LAS bf16x8*)(lds + PG8_SA(b, h) + aoff + m * 2048 + k * 1024); } while (0)
#define PG8_LDB(dst, b) do { _Pragma("unroll") for (int n = 0; n < 2; ++n) _Pragma("unroll") for (int k = 0; k < 2; ++k) dst[n][k] = *(const PG8_LAS bf16x8*)(lds + PG8_SB(b) + boff + n * 2048 + k * 1024); } while (0)
#define PG8_MMA(ai, At, Bt) do { __builtin_amdgcn_s_setprio(1); _Pragma("unroll") for (int m = 0; m < 4; ++m) _Pragma("unroll") for (int n = 0; n < 2; ++n) _Pragma("unroll") for (int k = 0; k < 2; ++k) \
        acc[ai][m][n] = __builtin_amdgcn_mfma_f32_16x16x32_bf16(Bt[n][k], At[m][k], acc[ai][m][n], 0, 0, 0); __builtin_amdgcn_s_setprio(0); } while (0)
#define PG8_WAIT_V(n) asm volatile("s_waitcnt vmcnt(" #n ")" ::: "memory")
#define PG8_WAIT_L(n) asm volatile("s_waitcnt lgkmcnt(" #n ")" ::: "memory")
#define PG8_BAR __builtin_amdgcn_s_barrier()
#define PG8_SCHED __builtin_amdgcn_sched_barrier(0)
    Unit cur, nxt; int ui = 0;
    if (!S.next(0, cur)) return;
    f32x4 acc[2][4][2], mg[2][4][2];
#pragma unroll
    for (int a = 0; a < 2; ++a)
#pragma unroll
        for (int m = 0; m < 4; ++m)
#pragma unroll
            for (int n = 0; n < 2; ++n) { acc[a][m][n] = (f32x4){0.f, 0.f, 0.f, 0.f}; mg[a][m][n] = (f32x4){0.f, 0.f, 0.f, 0.f}; }
    bf16x8 At[4][2], B0[2][2];
    const char* cA = S.pa(cur); const char* cB = S.pb(cur);
    PG8_STAGE(PG8_SB(0), cB, voffB); PG8_STAGE(PG8_SA(0, 0), cA, voffA); PG8_STAGE(PG8_SA(0, 1), cA + hstepA, voffA);
    if (wr == 1) PG8_BAR;
    PG8_WAIT_V(2); PG8_BAR;
    PG8_STAGE(PG8_SB(1), cB + kstep, voffB); PG8_STAGE(PG8_SA(1, 0), cA + kstep, voffA);
    PG8_WAIT_V(4); PG8_BAR;
    for (;;) {
        const bool has_next = S.next(ui + 1, nxt);
        const char* nA = has_next ? S.pa(nxt) : cA; const char* nB = has_next ? S.pb(nxt) : cB;
#pragma unroll 1
        for (int t = 0; t < nt; t += 2) {
            const bool last = (t == nt - 2);
            const char* a1 = cA + (size_t)(t + 1) * kstep;
            const char* a2 = last ? nA : cA + (size_t)(t + 2) * kstep; const char* b2 = last ? nB : cB + (size_t)(t + 2) * kstep;
            const char* a3 = a2 + kstep; const char* b3 = b2 + kstep;
            PG8_LDB(B0, 0); PG8_SCHED; PG8_LDA(At, 0, 0); PG8_STAGE(PG8_SA(1, 1), a1 + hstepA, voffA);
            PG8_WAIT_V(6); PG8_WAIT_L(0); PG8_BAR; PG8_MMA(0, At, B0); PG8_BAR; PG8_SCHED;
            PG8_LDA(At, 0, 1); PG8_STAGE(PG8_SB(0), b2, voffB); PG8_STAGE(PG8_SA(0, 0), a2, voffA);
            PG8_WAIT_V(6); PG8_WAIT_L(0); PG8_BAR; PG8_MMA(1, At, B0); PG8_BAR; PG8_SCHED;
            PG8_LDB(B0, 1); PG8_SCHED; PG8_LDA(At, 1, 0); PG8_STAGE(PG8_SA(0, 1), a2 + hstepA, voffA);
            PG8_WAIT_V(6); PG8_WAIT_L(0); PG8_BAR; PG8_MMA(0, At, B0); PG8_BAR; PG8_SCHED;
            PG8_LDA(At, 1, 1); PG8_STAGE(PG8_SB(1), b3, voffB); PG8_STAGE(PG8_SA(1, 0), a3, voffA);
            PG8_WAIT_V(6); PG8_WAIT_L(0); PG8_BAR; PG8_MMA(1, At, B0); PG8_BAR; PG8_SCHED;
        }
        if (wr == 0) PG8_BAR;
        E(acc, mg, cur, wr, wc, fr, fq);
        if (!has_next) break;
#pragma unroll
        for (int a = 0; a < 2; ++a)
#pragma unroll
            for (int m = 0; m < 4; ++m)
#pragma unroll
                for (int n = 0; n < 2; ++n) acc[a][m][n] = (f32x4){0.f, 0.f, 0.f, 0.f};
        cur = nxt; cA = nA; cB = nB; ++ui;
        if (wr == 1) PG8_BAR;
    }
    PG8_WAIT_V(0);
    PG8_BAR;
#undef PG8_SA
#undef PG8_SB
#undef PG8_STAGE
#undef PG8_LDA
#undef PG8_LDB
#undef PG8_MMA
#undef PG8_WAIT_V
#undef PG8_WAIT_L
#undef PG8_BAR
#undef PG8_SCHED
}
}
namespace att {
constexpr int KVBLK = 64;
constexpr int SHM_V = 16384, SHM_K = 16384, SHM_KR = 8192;
constexpr int NVB = ATT_HS ? 3 : 2;
constexpr int OFF_V = 0, OFF_K = NVB * SHM_V, OFF_KR = OFF_K + 2 * SHM_K, OFF_WS = OFF_KR + 2 * SHM_KR, OFF_QR = OFF_WS + 8 * 64 * 4, LDS_ATT = OFF_QR + 8 * 4096;
#define RFLU(x) ((unsigned)__builtin_amdgcn_readfirstlane((int)(x)))
#ifndef KSW_MASK
#define KSW_MASK 7
#endif
#define KSWZ(row, colB) ((row) * 256 + ((colB) ^ (((row) & KSW_MASK) << 4)))
#define KRSWZ(row, chunk) ((row) * 128 + ((((chunk) ^ (((row) >> 1) & 7))) << 4))
#define SBAR() __builtin_amdgcn_sched_barrier(0)
__device__ __forceinline__ int crow(int r, int hi) { return (r & 3) + 8 * (r >> 2) + 4 * hi; }
__device__ __forceinline__ unsigned cvtpk(float lo, float hi) { return cvt_pk_bf16(lo, hi); }

__device__ __forceinline__ void partialSM(f32x16& p0, f32x16& p1, float& m_reg, float& mn, float& alpha, const float C, const float thr) {
  float pmax = p0[0];
#pragma unroll
  for (int r = 1; r < 16; ++r) pmax = fmaxf(pmax, p0[r]);
#pragma unroll
  for (int r = 0; r < 16; ++r) pmax = fmaxf(pmax, p1[r]);
  { auto rr = __builtin_amdgcn_permlane32_swap(__float_as_uint(pmax), __float_as_uint(pmax), false, false);
    pmax = fmaxf(__uint_as_float(rr[0]), __uint_as_float(rr[1])); }
  if (__builtin_expect(__all(pmax - m_reg <= thr), 1)) { mn = m_reg; alpha = 1.f; }
  else { mn = fmaxf(m_reg, pmax); alpha = __builtin_amdgcn_exp2f((m_reg - mn) * C); m_reg = mn; }
  const float mnC = -mn * C;
#ifdef PROBE_VALU
  { float dz = mnC; _Pragma("unroll") for (int r = 0; r < PROBE_VALU; ++r) asm volatile("v_fma_f32 %0, %1, %2, %0" : "+v"(dz) : "v"(C), "v"(mn)); asm volatile("" :: "v"(dz)); }
#endif
#pragma unroll
  for (int r = 0; r < 16; ++r) p0[r] = fmaf(p0[r], C, mnC);
#pragma unroll
  for (int r = 0; r < 16; ++r) p1[r] = fmaf(p1[r], C, mnC);
#pragma unroll
  for (int r = 0; r < 16; ++r) p0[r] = __builtin_amdgcn_exp2f(p0[r]);
}
template <bool LPART = false, bool NOSUM = false, bool P1X = false>
__device__ __forceinline__ void finishSM(f32x16& p0, f32x16& p1, float alpha, float& l_reg, bf16x8& pa0, bf16x8& pa1, bf16x8& pa2, bf16x8& pa3) {
  if constexpr (!P1X) {
#pragma unroll
  for (int r = 0; r < 16; ++r) p1[r] = __builtin_amdgcn_exp2f(p1[r]); }
  if constexpr (!NOSUM) {
  float ps = 0;
#pragma unroll
  for (int r = 0; r < 16; ++r) ps += p0[r];
#pragma unroll
  for (int r = 0; r < 16; ++r) ps += p1[r];
  if constexpr (!LPART) { auto rr = __builtin_amdgcn_permlane32_swap(__float_as_uint(ps), __float_as_uint(ps), false, false);
    ps = __uint_as_float(rr[0]) + __uint_as_float(rr[1]); }
  l_reg = l_reg * alpha + ps; }
#define PK4(P, BASE, OUT) do { unsigned a0 = cvtpk(P[BASE + 0], P[BASE + 1]), a1 = cvtpk(P[BASE + 2], P[BASE + 3]);   \
    unsigned b0 = cvtpk(P[BASE + 4], P[BASE + 5]), b1 = cvtpk(P[BASE + 6], P[BASE + 7]);                              \
    if (ATT_NOSWAP) { v4u w = {a0, a1, b0, b1}; OUT = __builtin_bit_cast(bf16x8, w); } else { \
    auto r0 = __builtin_amdgcn_permlane32_swap(a0, b0, false, false); auto r1 = __builtin_amdgcn_permlane32_swap(a1, b1, false, false); \
    v4u w = {r0[0], r1[0], r0[1], r1[1]}; OUT = __builtin_bit_cast(bf16x8, w); } } while (0)
  PK4(p0, 0, pa0); PK4(p0, 8, pa1); PK4(p1, 0, pa2); PK4(p1, 8, pa3);
#undef PK4
}
template <int NQ, bool ROPEK>
__device__ __forceinline__ void qkt(f32x16& p0, f32x16& p1, const LAS char* Ks, const LAS char* KRs, const LAS char* QRs, const bf16x8 (&qr)[NQ], int r32, int hi, int kd0) {
  p0 = f32x16{}; p1 = f32x16{};
#pragma unroll
  for (int d0 = 0; d0 < NQ; ++d0) { const int cb = ((kd0 + d0) * 16 + hi * 8) * 2;
    const bf16x8 b0 = *(const LAS bf16x8*)(Ks + KSWZ(r32, cb));
    const bf16x8 b1 = *(const LAS bf16x8*)(Ks + KSWZ(32 + r32, cb));
    p0 = __builtin_amdgcn_mfma_f32_32x32x16_bf16(b0, qr[d0], p0, 0, 0, 0);
    p1 = __builtin_amdgcn_mfma_f32_32x32x16_bf16(b1, qr[d0], p1, 0, 0, 0); }
  if constexpr (ROPEK) {
#pragma unroll
    for (int d0 = 0; d0 < 4; ++d0) { const int ch = d0 * 2 + hi;
      const bf16x8 b0 = *(const LAS bf16x8*)(KRs + KRSWZ(r32, ch));
      const bf16x8 b1 = *(const LAS bf16x8*)(KRs + KRSWZ(32 + r32, ch));
      const bf16x8 qq = *(const LAS bf16x8*)(QRs + d0 * 1024);
      p0 = __builtin_amdgcn_mfma_f32_32x32x16_bf16(b0, qq, p0, 0, 0, 0);
      p1 = __builtin_amdgcn_mfma_f32_32x32x16_bf16(b1, qq, p1, 0, 0, 0); }
  }
}
constexpr float THRL = 11.5415603f;
__device__ __forceinline__ void partialSM_nn(f32x16& p0, f32x16& p1, f32x16& negm, float& alpha, const float l_reg, const bool fast = false) {
  alpha = 1.f;
  if (!fast) {
  float pmax = p0[0]; asm volatile("" : "+v"(pmax));
#pragma unroll
  for (int r = 1; r < 16; ++r) pmax = fmaxf(pmax, p0[r]);
#pragma unroll
  for (int r = 0; r < 16; ++r) pmax = fmaxf(pmax, p1[r]);
  { auto rr = __builtin_amdgcn_permlane32_swap(__float_as_uint(pmax), __float_as_uint(pmax), false, false);
    pmax = fmaxf(__uint_as_float(rr[0]), __uint_as_float(rr[1])); }
  if (__builtin_expect(!__all(pmax <= THRL && pmax >= -64.f), 0)) {
    float lc = l_reg;
    if (ATT_LPART) { auto rr = __builtin_amdgcn_permlane32_swap(__float_as_uint(lc), __float_as_uint(lc), false, false); lc = __uint_as_float(rr[0]) + __uint_as_float(rr[1]); }
    const float dl = (pmax > THRL) ? pmax : ((lc == 0.f && pmax < -64.f && pmax > -1e30f) ? pmax : 0.f);
#pragma unroll
    for (int r = 0; r < 16; ++r) { p0[r] -= dl; p1[r] -= dl; }
#pragma unroll
    for (int r = 0; r < 16; ++r) negm[r] -= dl;
    alpha = (dl > 0.f) ? __builtin_amdgcn_exp2f(-dl) : 1.f;
  }
  }
#pragma unroll
  for (int r = 0; r < 16; ++r) p0[r] = __builtin_amdgcn_exp2f(p0[r]);
}
__device__ __forceinline__ void partialSM_n(f32x16& p0, f32x16& p1, float& mref, f32x16& negm, float& alpha, const float l_reg, const bool fast = false) {
  partialSM_nn(p0, p1, negm, alpha, l_reg, fast); mref = -negm[0];
}
template <int NQ, bool ROPEK, bool ZC = false>
__device__ __forceinline__ void qkt_n(f32x16& p0, f32x16& p1, const f32x16& negm, const LAS char* Ks, const LAS char* KRs, const LAS char* QRs, const bf16x8 (&qr)[NQ], int r32, int hi, int kd0) {
#pragma unroll
  for (int d0 = 0; d0 < NQ; ++d0) { const int cb = ((kd0 + d0) * 16 + hi * 8) * 2;
    const bf16x8 b0 = *(const LAS bf16x8*)(Ks + KSWZ(r32, cb));
    const bf16x8 b1 = *(const LAS bf16x8*)(Ks + KSWZ(32 + r32, cb));
    if (d0 == 0 && ZC) { p0 = __builtin_amdgcn_mfma_f32_32x32x16_bf16(b0, qr[0], f32x16{}, 0, 0, 0); p1 = __builtin_amdgcn_mfma_f32_32x32x16_bf16(b1, qr[0], f32x16{}, 0, 0, 0); }
    else if (d0 == 0) { p0 = __builtin_amdgcn_mfma_f32_32x32x16_bf16(b0, qr[0], negm, 0, 0, 0); p1 = __builtin_amdgcn_mfma_f32_32x32x16_bf16(b1, qr[0], negm, 0, 0, 0); }
    else { p0 = __builtin_amdgcn_mfma_f32_32x32x16_bf16(b0, qr[d0], p0, 0, 0, 0); p1 = __builtin_amdgcn_mfma_f32_32x32x16_bf16(b1, qr[d0], p1, 0, 0, 0); } }
  if constexpr (ROPEK) {
#pragma unroll
    for (int d0 = 0; d0 < 4; ++d0) { const int ch = d0 * 2 + hi;
      const bf16x8 b0 = *(const LAS bf16x8*)(KRs + KRSWZ(r32, ch));
      const bf16x8 b1 = *(const LAS bf16x8*)(KRs + KRSWZ(32 + r32, ch));
      const bf16x8 qq = *(const LAS bf16x8*)(QRs + d0 * 1024);
      p0 = __builtin_amdgcn_mfma_f32_32x32x16_bf16(b0, qq, p0, 0, 0, 0);
      p1 = __builtin_amdgcn_mfma_f32_32x32x16_bf16(b1, qq, p1, 0, 0, 0); }
  }
}
template <int BASE> __device__ __forceinline__ bf16x8 pk4f(const f32x16& P) {
  const unsigned a0 = cvtpk(P[BASE + 0], P[BASE + 1]), a1 = cvtpk(P[BASE + 2], P[BASE + 3]), b0 = cvtpk(P[BASE + 4], P[BASE + 5]), b1 = cvtpk(P[BASE + 6], P[BASE + 7]);
  if (ATT_NOSWAP) { const v4u w = {a0, a1, b0, b1}; return __builtin_bit_cast(bf16x8, w); }
  auto r0 = __builtin_amdgcn_permlane32_swap(a0, b0, false, false); auto r1 = __builtin_amdgcn_permlane32_swap(a1, b1, false, false);
  const v4u w = {r0[0], r1[0], r0[1], r1[1]}; return __builtin_bit_cast(bf16x8, w); }
template <int NQ, bool ROPEK, bool NOSUM = false, bool P1X = false>
__device__ __forceinline__ void qkt_fin(f32x16& n0, f32x16& n1, const LAS char* Ks, const LAS char* KRs, const LAS char* QRs, const bf16x8 (&qr)[NQ], int r32, int hi, int kd0,
                                        f32x16& p0, f32x16& p1, float& l_reg, bf16x8& pa0, bf16x8& pa1, bf16x8& pa2, bf16x8& pa3) {
  constexpr int NS = NQ + (ROPEK ? 4 : 0), CPS = (NQ >= 8) ? 1 : 8 / NQ;
  bf16x8 b0, b1, c0, c1, qq = qr[0], qn = qr[0];
  { const int cb = (kd0 * 16 + hi * 8) * 2; b0 = *(const LAS bf16x8*)(Ks + KSWZ(r32, cb)); b1 = *(const LAS bf16x8*)(Ks + KSWZ(32 + r32, cb)); }
  float ps = 0.f;
#pragma unroll
  for (int s_ = 0; s_ < NS; ++s_) {
    if (s_ + 1 < NS) {
      if (s_ + 1 < NQ) { const int cb = ((kd0 + s_ + 1) * 16 + hi * 8) * 2; c0 = *(const LAS bf16x8*)(Ks + KSWZ(r32, cb)); c1 = *(const LAS bf16x8*)(Ks + KSWZ(32 + r32, cb)); qn = qr[(s_ + 1 < NQ) ? s_ + 1 : 0]; }
      else { const int d0 = s_ + 1 - NQ, ch = d0 * 2 + hi; c0 = *(const LAS bf16x8*)(KRs + KRSWZ(r32, ch)); c1 = *(const LAS bf16x8*)(KRs + KRSWZ(32 + r32, ch)); qn = *(const LAS bf16x8*)(QRs + d0 * 1024); }
    }
    if (s_ == 0) { n0 = __builtin_amdgcn_mfma_f32_32x32x16_bf16(b0, qq, f32x16{}, 0, 0, 0); n1 = __builtin_amdgcn_mfma_f32_32x32x16_bf16(b1, qq, f32x16{}, 0, 0, 0); }
    else { n0 = __builtin_amdgcn_mfma_f32_32x32x16_bf16(b0, qq, n0, 0, 0, 0); n1 = __builtin_amdgcn_mfma_f32_32x32x16_bf16(b1, qq, n1, 0, 0, 0); }
#pragma unroll
    for (int c_ = 0; c_ < CPS; ++c_) { const int i = s_ * CPS + c_;
      if (i < 8) { if constexpr (!P1X) { p1[2 * i] = __builtin_amdgcn_exp2f(p1[2 * i]); p1[2 * i + 1] = __builtin_amdgcn_exp2f(p1[2 * i + 1]); }
        if constexpr (!NOSUM) { ps += p0[2 * i]; ps += p0[2 * i + 1];
          if (i >= 1) { ps += p1[2 * i - 2]; ps += p1[2 * i - 1]; } }
        if (i == 1) pa0 = pk4f<0>(p0);
        if (i == 3) pa1 = pk4f<8>(p0);
        if (i == 5) pa2 = pk4f<0>(p1); } }
    __builtin_amdgcn_sched_barrier(0);
    b0 = c0; b1 = c1; qq = qn;
  }
  pa3 = pk4f<8>(p1);
  if constexpr (!NOSUM) { ps += p1[14]; ps += p1[15];
    { auto rr = __builtin_amdgcn_permlane32_swap(__float_as_uint(ps), __float_as_uint(ps), false, false); ps = __uint_as_float(rr[0]) + __uint_as_float(rr[1]); }
    l_reg += ps; }
}
__device__ __forceinline__ void band_mask(f32x16& p0, f32x16& p1, int kb, int qpos, int hi) {
  const float NEG = -INFINITY;
#pragma unroll
  for (int r = 0; r < 16; ++r) { const int d = kb + crow(r, hi) - qpos; if (d > 128 || d < -128) p0[r] = NEG; if (d + 32 > 128 || d + 32 < -128) p1[r] = NEG; }
}
__device__ __forceinline__ int v_st(int k, int c) { const int kk = (k & ~0xC) | ((k & 4) << 1) | ((k & 8) >> 1); return ((kk >> 3) * 4 + (c >> 5)) * 512 + ((kk & 7) * 32 + (c & 31)) * 2; }
__device__ __forceinline__ int v_rd_base(int lane) { return ((lane & 3) << 3) | (((lane >> 2) & 3) << 6) | (((lane >> 4) & 1) << 5) | (((lane >> 5) & 1) << 8); }
constexpr int v_rd_off(int d0, int ks, int half) { return d0 * 512 + ks * 4096 + half * 2048; }
template <int OFF> __device__ __forceinline__ s16x4 tr_read(int vb) {
  s16x4 r; asm volatile("ds_read_b64_tr_b16 %0, %1 offset:%2" : "=&v"(r) : "v"(vb), "i"(OFF) : "memory"); return r;
}
template <int D0, int BO = 0> __device__ __forceinline__ void pv_one(f32x16& od, int vb, bf16x8 pa0, bf16x8 pa1, bf16x8 pa2, bf16x8 pa3) {
  const s16x4 l0 = tr_read<BO + v_rd_off(D0, 0, 0)>(vb), h0 = tr_read<BO + v_rd_off(D0, 0, 1)>(vb), l1 = tr_read<BO + v_rd_off(D0, 1, 0)>(vb), h1 = tr_read<BO + v_rd_off(D0, 1, 1)>(vb);
  const s16x4 l2 = tr_read<BO + v_rd_off(D0, 2, 0)>(vb), h2 = tr_read<BO + v_rd_off(D0, 2, 1)>(vb), l3 = tr_read<BO + v_rd_off(D0, 3, 0)>(vb), h3 = tr_read<BO + v_rd_off(D0, 3, 1)>(vb);
  asm volatile("s_waitcnt lgkmcnt(0)" ::: "memory"); SBAR();
#define PK(L, H) (bf16x8){L[0], L[1], L[2], L[3], H[0], H[1], H[2], H[3]}
#ifdef ATT_PRIO
  __builtin_amdgcn_s_setprio(1);
#endif
  od = __builtin_amdgcn_mfma_f32_32x32x16_bf16(pa0, PK(l0, h0), od, 0, 0, 0);
  od = __builtin_amdgcn_mfma_f32_32x32x16_bf16(pa1, PK(l1, h1), od, 0, 0, 0);
  od = __builtin_amdgcn_mfma_f32_32x32x16_bf16(pa2, PK(l2, h2), od, 0, 0, 0);
  od = __builtin_amdgcn_mfma_f32_32x32x16_bf16(pa3, PK(l3, h3), od, 0, 0, 0);
#ifdef ATT_PRIO
  __builtin_amdgcn_s_setprio(0);
#endif
#undef PK
}
template <int BO = 0>
__device__ __forceinline__ void pv_d0(f32x16 (&o)[4], int vb, bf16x8 pa0, bf16x8 pa1, bf16x8 pa2, bf16x8 pa3) {
  pv_one<0, BO>(o[0], vb, pa0, pa1, pa2, pa3); pv_one<1, BO>(o[1], vb, pa0, pa1, pa2, pa3); pv_one<2, BO>(o[2], vb, pa0, pa1, pa2, pa3); pv_one<3, BO>(o[3], vb, pa0, pa1, pa2, pa3);
}
__device__ __forceinline__ bf16x8 ones8() { const v4u w = {0x3F803F80u, 0x3F803F80u, 0x3F803F80u, 0x3F803F80u}; return __builtin_bit_cast(bf16x8, w); }
template <int BO, bool LM = false, bool BOTH = false>
__device__ __forceinline__ void pv_d0_exp(f32x16 (&o)[4], int vb, bf16x8 pa0, bf16x8 pa1, bf16x8 pa2, bf16x8 pa3, f32x16& pn, f32x16& L, f32x16& pn1);
template <int BO>
__device__ __forceinline__ void pv_d0_exp_sum(f32x16 (&o)[4], int vb, bf16x8 pa0, bf16x8 pa1, bf16x8 pa2, bf16x8 pa3, f32x16& pn, const f32x16& pc0, const f32x16& pc1, float& l_reg) {
  float ps = 0.f;
  pv_one<0, BO>(o[0], vb, pa0, pa1, pa2, pa3);
#pragma unroll
  for (int r = 0; r < 4; ++r) pn[r] = __builtin_amdgcn_exp2f(pn[r]);
#pragma unroll
  for (int r = 0; r < 8; ++r) ps += pc0[r];
  pv_one<1, BO>(o[1], vb, pa0, pa1, pa2, pa3);
#pragma unroll
  for (int r = 4; r < 8; ++r) pn[r] = __builtin_amdgcn_exp2f(pn[r]);
#pragma unroll
  for (int r = 8; r < 16; ++r) ps += pc0[r];
  pv_one<2, BO>(o[2], vb, pa0, pa1, pa2, pa3);
#pragma unroll
  for (int r = 8; r < 12; ++r) pn[r] = __builtin_amdgcn_exp2f(pn[r]);
#pragma unroll
  for (int r = 0; r < 8; ++r) ps += pc1[r];
  pv_one<3, BO>(o[3], vb, pa0, pa1, pa2, pa3);
#pragma unroll
  for (int r = 12; r < 16; ++r) pn[r] = __builtin_amdgcn_exp2f(pn[r]);
#pragma unroll
  for (int r = 8; r < 16; ++r) ps += pc1[r];
  { auto rr = __builtin_amdgcn_permlane32_swap(__float_as_uint(ps), __float_as_uint(ps), false, false); ps = __uint_as_float(rr[0]) + __uint_as_float(rr[1]); }
  l_reg += ps;
}
template <int BO, bool LM, bool BOTH>
__device__ __forceinline__ void pv_d0_exp(f32x16 (&o)[4], int vb, bf16x8 pa0, bf16x8 pa1, bf16x8 pa2, bf16x8 pa3, f32x16& pn, f32x16& L, f32x16& pn1) {
  pv_one<0, BO>(o[0], vb, pa0, pa1, pa2, pa3);
  if constexpr (LM) L = __builtin_amdgcn_mfma_f32_32x32x16_bf16(pa0, ones8(), L, 0, 0, 0);
#pragma unroll
  for (int r = 0; r < 4; ++r) { pn[r] = __builtin_amdgcn_exp2f(pn[r]); if constexpr (BOTH) pn1[r] = __builtin_amdgcn_exp2f(pn1[r]); }
  pv_one<1, BO>(o[1], vb, pa0, pa1, pa2, pa3);
  if constexpr (LM) L = __builtin_amdgcn_mfma_f32_32x32x16_bf16(pa1, ones8(), L, 0, 0, 0);
#pragma unroll
  for (int r = 4; r < 8; ++r) { pn[r] = __builtin_amdgcn_exp2f(pn[r]); if constexpr (BOTH) pn1[r] = __builtin_amdgcn_exp2f(pn1[r]); }
  pv_one<2, BO>(o[2], vb, pa0, pa1, pa2, pa3);
  if constexpr (LM) L = __builtin_amdgcn_mfma_f32_32x32x16_bf16(pa2, ones8(), L, 0, 0, 0);
#pragma unroll
  for (int r = 8; r < 12; ++r) { pn[r] = __builtin_amdgcn_exp2f(pn[r]); if constexpr (BOTH) pn1[r] = __builtin_amdgcn_exp2f(pn1[r]); }
  pv_one<3, BO>(o[3], vb, pa0, pa1, pa2, pa3);
  if constexpr (LM) L = __builtin_amdgcn_mfma_f32_32x32x16_bf16(pa3, ones8(), L, 0, 0, 0);
#pragma unroll
  for (int r = 12; r < 16; ++r) { pn[r] = __builtin_amdgcn_exp2f(pn[r]); if constexpr (BOTH) pn1[r] = __builtin_amdgcn_exp2f(pn1[r]); }
}
template <int BO>
__device__ __forceinline__ void pv_d0_L(f32x16 (&o)[4], int vb, bf16x8 pa0, bf16x8 pa1, bf16x8 pa2, bf16x8 pa3, f32x16& L) {
  pv_one<0, BO>(o[0], vb, pa0, pa1, pa2, pa3); L = __builtin_amdgcn_mfma_f32_32x32x16_bf16(pa0, ones8(), L, 0, 0, 0);
  pv_one<1, BO>(o[1], vb, pa0, pa1, pa2, pa3); L = __builtin_amdgcn_mfma_f32_32x32x16_bf16(pa1, ones8(), L, 0, 0, 0);
  pv_one<2, BO>(o[2], vb, pa0, pa1, pa2, pa3); L = __builtin_amdgcn_mfma_f32_32x32x16_bf16(pa2, ones8(), L, 0, 0, 0);
  pv_one<3, BO>(o[3], vb, pa0, pa1, pa2, pa3); L = __builtin_amdgcn_mfma_f32_32x32x16_bf16(pa3, ones8(), L, 0, 0, 0);
}
__device__ __forceinline__ bf16x8 ld8(const bf16* p) { return *reinterpret_cast<const bf16x8*>(p); }

template <int D0> __device__ __forceinline__ void trd8(s16x4 (&v)[8], int vb) {
  v[0] = tr_read<v_rd_off(D0, 0, 0)>(vb); v[1] = tr_read<v_rd_off(D0, 0, 1)>(vb); v[2] = tr_read<v_rd_off(D0, 1, 0)>(vb); v[3] = tr_read<v_rd_off(D0, 1, 1)>(vb);
  v[4] = tr_read<v_rd_off(D0, 2, 0)>(vb); v[5] = tr_read<v_rd_off(D0, 2, 1)>(vb); v[6] = tr_read<v_rd_off(D0, 3, 0)>(vb); v[7] = tr_read<v_rd_off(D0, 3, 1)>(vb);
}
__device__ __forceinline__ void pv4(f32x16& od, const s16x4 (&v)[8], bf16x8 pa0, bf16x8 pa1, bf16x8 pa2, bf16x8 pa3) {
#define PK(L, H) (bf16x8){L[0], L[1], L[2], L[3], H[0], H[1], H[2], H[3]}
  od = __builtin_amdgcn_mfma_f32_32x32x16_bf16(pa0, PK(v[0], v[1]), od, 0, 0, 0);
  od = __builtin_amdgcn_mfma_f32_32x32x16_bf16(pa1, PK(v[2], v[3]), od, 0, 0, 0);
  od = __builtin_amdgcn_mfma_f32_32x32x16_bf16(pa2, PK(v[4], v[5]), od, 0, 0, 0);
  od = __builtin_amdgcn_mfma_f32_32x32x16_bf16(pa3, PK(v[6], v[7]), od, 0, 0, 0);
#undef PK
}
#define LGKM_WAIT(N) do { asm volatile("s_waitcnt lgkmcnt(" #N ")" ::: "memory"); SBAR(); } while (0)
__device__ __forceinline__ void pv_pipe(f32x16 (&o)[4], int vbk, bf16x8 pa0, bf16x8 pa1, bf16x8 pa2, bf16x8 pa3) {
  s16x4 va[8], vc[8];
  SBAR(); asm volatile("s_waitcnt lgkmcnt(0)" ::: "memory");
  trd8<0>(va, vbk);
  trd8<1>(vc, vbk); LGKM_WAIT(8); pv4(o[0], va, pa0, pa1, pa2, pa3); SBAR();
  trd8<2>(va, vbk); LGKM_WAIT(8); pv4(o[1], vc, pa0, pa1, pa2, pa3); SBAR();
  trd8<3>(vc, vbk); LGKM_WAIT(8); pv4(o[2], va, pa0, pa1, pa2, pa3); SBAR();
  LGKM_WAIT(0); pv4(o[3], vc, pa0, pa1, pa2, pa3); SBAR();
}
#ifdef ATT_PVPIPE
#define PV_D0 pv_pipe
#else
#define PV_D0 pv_d0<0>
#endif
__device__ __forceinline__ void glds16(const void* gsrc, unsigned lds_dst) { unsigned keep;
  asm volatile("s_mov_b32 %0, m0\n\ts_mov_b32 m0, %2\n\ts_nop 0\n\tglobal_load_lds_dwordx4 %1, off\n\ts_mov_b32 m0, %0" : "=&s"(keep) : "v"(gsrc), "s"(lds_dst) : "memory"); }
__device__ __forceinline__ void glds16x2(const void* sbase, unsigned off0, unsigned off1, unsigned lds_dst0, unsigned lds_dst1) { unsigned keep;
  asm volatile("s_nop 4\n\ts_mov_b32 %0, m0\n\ts_mov_b32 m0, %3\n\ts_nop 0\n\tglobal_load_lds_dwordx4 %1, %5\n\ts_mov_b32 m0, %4\n\ts_nop 0\n\tglobal_load_lds_dwordx4 %2, %5\n\ts_mov_b32 m0, %0"
               : "=&s"(keep) : "v"(off0), "v"(off1), "s"(lds_dst0), "s"(lds_dst1), "s"(sbase) : "memory"); }
template <int IMM>
__device__ __forceinline__ void glds16x2i(const void* sbase, unsigned off0, unsigned lds_dst0, unsigned lds_dst1) { unsigned keep;
  asm volatile("s_nop 4\n\ts_mov_b32 %0, m0\n\ts_mov_b32 m0, %2\n\ts_nop 0\n\tglobal_load_lds_dwordx4 %1, %4\n\ts_mov_b32 m0, %3\n\ts_nop 0\n\tglobal_load_lds_dwordx4 %1, %4 offset:%5\n\ts_mov_b32 m0, %0"
               : "=&s"(keep) : "v"(off0), "s"(lds_dst0), "s"(lds_dst1 - (unsigned)IMM), "s"(sbase), "i"(IMM) : "memory"); }
__device__ __forceinline__ void glds16s(const void* sbase, unsigned off0, unsigned lds_dst0) { unsigned keep;
  asm volatile("s_nop 4\n\ts_mov_b32 %0, m0\n\ts_mov_b32 m0, %2\n\ts_nop 0\n\tglobal_load_lds_dwordx4 %1, %3\n\ts_mov_b32 m0, %0" : "=&s"(keep) : "v"(off0), "s"(lds_dst0), "s"(sbase) : "memory"); }
__device__ __forceinline__ const char* uptr_(const char* p) { const unsigned long long v = (unsigned long long)p; const unsigned lo = (unsigned)__builtin_amdgcn_readfirstlane((int)(unsigned)v), hi = (unsigned)__builtin_amdgcn_readfirstlane((int)(unsigned)(v >> 32)); return (const char*)(((unsigned long long)hi << 32) | lo); }
#define WAIT_BAR() asm volatile("s_waitcnt vmcnt(0) lgkmcnt(0)\n\ts_barrier" ::: "memory")

template <int NQ, bool ROPEK, bool SWA>
__device__ __forceinline__ void attn_core(LAS char* lds, const bf16x8 (&qr)[NQ],
                                          const bf16* __restrict__ Kh, const bf16* __restrict__ Vh, const int ldk, const bf16* __restrict__ KRh, const int ldkr,
                                          const int NT, const float C, const float thr, const int kd0, const int qpos, const int kpos0,
                                          f32x16 (&o)[4], float& m_reg, float& l_reg, const int wv, const float kmax2 = -1.f, const float qx2 = 0.f) {
  const int tid = opq_tid(wv), lane = tid & 63, r32 = lane & 31, hi = lane >> 5;
  const int wid = __builtin_amdgcn_readfirstlane(tid >> 6);
  LAS char* V_lds = lds + OFF_V; LAS char* K_lds = lds + OFF_K; LAS char* KR_lds = lds + OFF_KR;
  LAS float* al_l = (LAS float*)(lds + OFF_WS) + wid * 64 + 32;
  const LAS char* QR_lds = lds + OFF_QR + wid * 4096 + lane * 16;
  const unsigned lds0 = (unsigned)(uintptr_t)lds;
  const int vb0 = (int)lds0 + OFF_V + v_rd_base(lane);
  unsigned kofs[2], vofs[2], krofs = 0u;
#pragma unroll
  for (int i = 0; i < 2; ++i) { const int p = wid * 2 + i;
    { const int row = p * 4 + (lane >> 4), ch = (lane & 15) ^ (row & KSW_MASK); kofs[i] = (unsigned)(row * ldk + ch * 8) * 2u; }
    { const int sub = 2 * p + (lane >> 5), kk = (sub >> 2) * 8 + ((lane & 31) >> 2), k = ATT_NOSWAP ? kk : ((kk & ~0xC) | ((kk & 4) << 1) | ((kk & 8) >> 1)), c = (sub & 3) * 32 + (lane & 3) * 8;
      vofs[i] = (unsigned)(k * ldk + c) * 2u; } }
  if constexpr (ROPEK) { const int row = wid * 8 + (lane >> 3), ch = (lane & 7) ^ ((row >> 1) & 7); krofs = (unsigned)(row * ldkr + ch * 8) * 2u; }
  const size_t tstepK = (size_t)KVBLK * ldk * 2, tstepKR = (size_t)KVBLK * ldkr * 2;
  const unsigned ldsK = RFLU(lds0 + OFF_K + (wid * 2) * 1024), ldsV = RFLU(lds0 + OFF_V + (wid * 2) * 1024), ldsKR = RFLU(lds0 + OFF_KR + wid * 1024);
#define RFL(x) ((unsigned)__builtin_amdgcn_readfirstlane((int)(x)))
#define DMA_K(t, b) do { const char* g_ = (const char*)Kh + (size_t)(t) * tstepK; \
    glds16x2(g_, kofs[0], kofs[1], ldsK + (b) * SHM_K, ldsK + (b) * SHM_K + 1024); \
    if constexpr (ROPEK) glds16s((const char*)KRh + (size_t)(t) * tstepKR, krofs, ldsKR + (b) * SHM_KR); } while (0)
#define DMA_V(t, b) do { const char* g_ = (const char*)Vh + (size_t)(t) * tstepK; \
    glds16x2i<128>(g_, vofs[0], ldsV + (b) * SHM_V, ldsV + (b) * SHM_V + 1024); } while (0)
#define RESC(a) do { if (__any((a) < 1.f)) { const int l_ = lane_id(), h_ = l_ >> 5; LAS float* alp = (LAS float*)(lds + OFF_WS) + wid * 64 + 32;     \
    if (h_ == 0) alp[l_ & 31] = (a); asm volatile("s_waitcnt lgkmcnt(0)" ::: "memory"); \
    _Pragma("unroll") for (int d = 0; d < 4; ++d) _Pragma("unroll") for (int r = 0; r < 16; ++r) o[d][r] *= alp[crow(r, h_)]; } } while (0)
#if ATT_NEGM
  f32x16 negm; _Pragma("unroll") for (int r = 0; r < 16; ++r) negm[r] = -m_reg;
#define QKT(P0, P1, b, tile) do { qkt_n<NQ, ROPEK>(P0, P1, negm, K_lds + (b) * SHM_K, KR_lds + (b) * SHM_KR, QR_lds, qr, r32, hi, kd0); \
    if constexpr (SWA) band_mask(P0, P1, kpos0 + (tile) * KVBLK, qpos, hi); } while (0)
#define PSM(P0, P1, MN, AL) partialSM_nn(P0, P1, negm, AL, l_reg, fast)
#else
#define QKT(P0, P1, b, tile) do { qkt<NQ, ROPEK>(P0, P1, K_lds + (b) * SHM_K, KR_lds + (b) * SHM_KR, QR_lds, qr, r32, hi, kd0); \
    if constexpr (SWA) band_mask(P0, P1, kpos0 + (tile) * KVBLK, qpos, hi); } while (0)
#define PSM(P0, P1, MN, AL) partialSM(P0, P1, m_reg, MN, AL, C, thr)
#endif
  f32x16 pA0, pA1, pB0, pB1; float mnA, mnB, alA, alB; bf16x8 pa0, pa1, pa2, pa3;
  DMA_K(0, 0); DMA_V(0, 0); DMA_K(1, 1);
#if ATT_PROWAIT
  if constexpr (ROPEK) asm volatile("s_waitcnt vmcnt(5) lgkmcnt(0)\n\ts_barrier" ::: "memory"); else asm volatile("s_waitcnt vmcnt(4) lgkmcnt(0)\n\ts_barrier" ::: "memory");
#else
  WAIT_BAR();
#endif
  bool fast = false;
  constexpr bool LMF = ATT_LMFMA && !SWA && (LMSEL) && (QKFSEL) && ATT_QKFIN && ATT_ILV;
  f32x16 Lacc = {};
#if ATT_NEGM && ATT_FASTREF
  if (!SWA && kmax2 >= 0.f) {
    float qn2 = qx2;
#pragma unroll
    for (int d0 = 0; d0 < NQ; ++d0) { f32x4 a, b; pg8::unpack8(__builtin_bit_cast(v4u, qr[d0]), a, b); qn2 += (a[0] * a[0] + a[1] * a[1]) + (a[2] * a[2] + a[3] * a[3]) + (b[0] * b[0] + b[1] * b[1]) + (b[2] * b[2] + b[3] * b[3]); }
    { auto rr = __builtin_amdgcn_permlane32_swap(__float_as_uint(qn2), __float_as_uint(qn2), false, false); qn2 = __uint_as_float(rr[0]) + __uint_as_float(rr[1]); }
    const float bnd = sqrtf(qn2 * kmax2) * 1.02f + 0.25f;
    fast = __all(bnd - m_reg <= 60.f && bnd + m_reg <= 100.f && (!(DUPSEL) || m_reg == 0.f)) != 0;
  }
#endif
#if ATT_NEGM && ATT_FASTREF && ATT_FASTDUP
  if constexpr (!SWA && (DUPSEL)) {
    if (fast) { qkt_n<NQ, ROPEK, true>(pA0, pA1, pA0, K_lds, KR_lds, QR_lds, qr, r32, hi, kd0); _Pragma("unroll") for (int r_ = 0; r_ < 16; ++r_) pA0[r_] = __builtin_amdgcn_exp2f(pA0[r_]); alA = 1.f;
      if constexpr (ATT_ILV2 != 0 && ATT_ILV != 0 && ATT_QKFIN && (QKFSEL)) { _Pragma("unroll") for (int r_ = 0; r_ < 16; ++r_) pA1[r_] = __builtin_amdgcn_exp2f(pA1[r_]); } }
    else { QKT(pA0, pA1, 0, 0); PSM(pA0, pA1, mnA, alA); }
  } else { QKT(pA0, pA1, 0, 0); PSM(pA0, pA1, mnA, alA); }
#else
  QKT(pA0, pA1, 0, 0); PSM(pA0, pA1, mnA, alA);
#endif
  WAIT_BAR();
  if (2 < NT) DMA_K(2, 0);
  DMA_V(1, 1);
#if ATT_NEGM
#define PSMF(FAST, P0, P1, AL) partialSM_nn(P0, P1, negm, AL, l_reg, FAST)
#else
#define PSMF(FAST, P0, P1, AL) PSM(P0, P1, mnA, AL)
#endif
#define RESCF(FAST, a) do { if (!(FAST)) RESC(a); } while (0)
#define PVPSM(ILV, BO, PN0, PN1, AL, FAST, PC0, PC1) do { if constexpr ((ILV) && ATT_ILV && ATT_ILV3 && !LMF && ATT_QKFIN && (QKFSEL)) { pv_d0_exp_sum<BO>(o, vb0, pa0, pa1, pa2, pa3, PN0, PC0, PC1, l_reg); AL = 1.f; } \
    else if constexpr ((ILV) && ATT_ILV) { pv_d0_exp<BO, LMF, (ATT_ILV2 != 0 && ATT_QKFIN && (QKFSEL))>(o, vb0, pa0, pa1, pa2, pa3, PN0, Lacc, PN1); AL = 1.f; } \
    else if constexpr (ILV) { pv_d0<BO>(o, vb0, pa0, pa1, pa2, pa3); _Pragma("unroll") for (int r_ = 0; r_ < 16; ++r_) PN0[r_] = __builtin_amdgcn_exp2f(PN0[r_]); AL = 1.f; } \
    else { pv_d0<BO>(o, vb0, pa0, pa1, pa2, pa3); PSMF(FAST, PN0, PN1, AL); } } while (0)
#define QKFIN(ILV, FAST, N0, N1, b, tile, P0, P1, AL) do { if constexpr ((ILV) && ATT_QKFIN && !SWA && (QKFSEL)) { \
      qkt_fin<NQ, ROPEK, (LMF || (ATT_ILV3 != 0 && ATT_ILV != 0)), (ATT_ILV2 != 0 && ATT_ILV != 0)>(N0, N1, K_lds + (b) * SHM_K, KR_lds + (b) * SHM_KR, QR_lds, qr, r32, hi, kd0, P0, P1, l_reg, pa0, pa1, pa2, pa3); } \
    else { if constexpr (ILV) { qkt_n<NQ, ROPEK, true>(N0, N1, pA0, K_lds + (b) * SHM_K, KR_lds + (b) * SHM_KR, QR_lds, qr, r32, hi, kd0); } else { QKT(N0, N1, b, tile); } \
      finishSM<ATT_LPART != 0>(P0, P1, (FAST) ? 1.f : AL, l_reg, pa0, pa1, pa2, pa3); } } while (0)
#define TILE_LOOP(FAST, ILV) do { \
  for (int j = 1; j + 1 < NT; j += 2) { \
      \
    SBAR(); QKFIN(ILV, FAST, pB0, pB1, 1, j, pA0, pA1, alA); SBAR(); \
    PVPSM(ILV, 0, pB0, pB1, alB, FAST, pA0, pA1); \
    WAIT_BAR(); \
    if (j + 2 < NT) DMA_K(j + 2, 1); \
    DMA_V(j + 1, 0);                                                \
    RESCF(FAST, alB); \
      \
    SBAR(); QKFIN(ILV, FAST, pA0, pA1, 0, j + 1, pB0, pB1, alB); SBAR(); \
    PVPSM(ILV, SHM_V, pA0, pA1, alA, FAST, pB0, pB1); \
    WAIT_BAR(); \
    if (j + 3 < NT) DMA_K(j + 3, 0); \
    if (j + 2 < NT) DMA_V(j + 2, 1); \
    RESCF(FAST, alA); \
  } \
    \
  SBAR(); QKFIN(ILV, FAST, pB0, pB1, 1, NT - 1, pA0, pA1, alA); SBAR(); \
  PVPSM(ILV, 0, pB0, pB1, alB, FAST, pA0, pA1); \
  WAIT_BAR(); RESCF(FAST, alB); \
  if constexpr ((ILV) && LMF) { finishSM<false, true, (ATT_ILV2 != 0 && ATT_ILV != 0)>(pB0, pB1, 1.f, l_reg, pa0, pa1, pa2, pa3); SBAR(); pv_d0_L<SHM_V>(o, vb0, pa0, pa1, pa2, pa3, Lacc); } \
  else if constexpr ((ILV) && ATT_ILV2 != 0 && ATT_ILV != 0 && ATT_QKFIN && (QKFSEL)) { finishSM<ATT_LPART != 0, false, true>(pB0, pB1, 1.f, l_reg, pa0, pa1, pa2, pa3); SBAR(); pv_d0<SHM_V>(o, vb0, pa0, pa1, pa2, pa3); } \
  else { finishSM<ATT_LPART != 0>(pB0, pB1, (FAST) ? 1.f : alB, l_reg, pa0, pa1, pa2, pa3); SBAR(); \
  pv_d0<SHM_V>(o, vb0, pa0, pa1, pa2, pa3); } } while (0)
  if (ATT_SPRIO && wid >= 4) __builtin_amdgcn_s_setprio(1);
#if ATT_NEGM && ATT_FASTREF && ATT_FASTDUP
  if constexpr (!SWA && (DUPSEL)) {
    if (fast) { TILE_LOOP(true, true);
      if constexpr (LMF) {
        LAS float* ll = (LAS float*)(lds + OFF_WS) + wid * 64 + 32;
        if (r32 == 0) { _Pragma("unroll") for (int r = 0; r < 16; ++r) ll[crow(r, hi)] = Lacc[r]; }
        asm volatile("s_waitcnt lgkmcnt(0)" ::: "memory");
        l_reg = ll[r32]; asm volatile("s_waitcnt lgkmcnt(0)" ::: "memory"); } }
    else { TILE_LOOP(false, false); m_reg = -negm[0]; } }
#ifdef PROBE_MLA_FASTONLY
  else { if constexpr (ROPEK) { TILE_LOOP(true, false); } else { TILE_LOOP(fast, false); } m_reg = -negm[0]; }
#else
  else { TILE_LOOP(fast, false); m_reg = -negm[0]; }
#endif
#else
  TILE_LOOP(fast, false); if (ATT_NEGM) m_reg = -negm[0];
#endif
#undef TILE_LOOP
#undef PVPSM
#undef QKFIN
#undef PSMF
#undef RESCF
  if (ATT_SPRIO) __builtin_amdgcn_s_setprio(0);
  if (ATT_LPART) { auto rr = __builtin_amdgcn_permlane32_swap(__float_as_uint(l_reg), __float_as_uint(l_reg), false, false); l_reg = __uint_as_float(rr[0]) + __uint_as_float(rr[1]); }
#undef RFL
#undef DMA_K
#undef DMA_V
#undef RESC
#undef QKT
#undef PSM
}

template <int NQ, bool ROPEK, bool SWA>
__device__ __forceinline__ void attn_core_stag(LAS char* lds, const bf16x8 (&qr)[NQ],
                                               const bf16* __restrict__ Kh, const bf16* __restrict__ Vh, const int ldk, const bf16* __restrict__ KRh, const int ldkr,
                                               const int NT, const float C, const float thr, const int kd0, const int qpos, const int kpos0,
                                               f32x16 (&o)[4], float& m_reg, float& l_reg, const int wv, unsigned* stamp = nullptr) {
  const int tid = opq_tid(wv), lane = tid & 63, r32 = lane & 31, hi = lane >> 5;
  const int wid = __builtin_amdgcn_readfirstlane(tid >> 6);
  const int half = wid >> 2;
#ifdef PROBE_STAMP
  unsigned long long tM = 0, tMb = 0, tV = 0, tVb = 0, t0_, t1_;
#define STAMP0() (t0_ = __builtin_amdgcn_s_memtime())
#define STAMP1(acc) do { t1_ = __builtin_amdgcn_s_memtime(); acc += t1_ - t0_; t0_ = t1_; } while (0)
#else
#define STAMP0() do {} while (0)
#define STAMP1(acc) do {} while (0)
#endif
  LAS char* K_lds = lds + OFF_K; LAS char* KR_lds = lds + OFF_KR;
  LAS float* al_l = (LAS float*)(lds + OFF_WS) + wid * 64 + 32;
  const LAS char* QR_lds = lds + OFF_QR + wid * 4096 + lane * 16;
  const unsigned lds0 = (unsigned)(uintptr_t)lds;
  const int vb0 = (int)lds0 + OFF_V + v_rd_base(lane);
  unsigned kofs[2], vofs[2], krofs = 0u;
#pragma unroll
  for (int i = 0; i < 2; ++i) { const int p = wid * 2 + i;
    { const int row = p * 4 + (lane >> 4), ch = (lane & 15) ^ (row & KSW_MASK); kofs[i] = (unsigned)(row * ldk + ch * 8) * 2u; }
    { const int sub = 2 * p + (lane >> 5), kk = (sub >> 2) * 8 + ((lane & 31) >> 2), k = ATT_NOSWAP ? kk : ((kk & ~0xC) | ((kk & 4) << 1) | ((kk & 8) >> 1)), c = (sub & 3) * 32 + (lane & 3) * 8;
      vofs[i] = (unsigned)(k * ldk + c) * 2u; } }
  if constexpr (ROPEK) { const int row = wid * 8 + (lane >> 3), ch = (lane & 7) ^ ((row >> 1) & 7); krofs = (unsigned)(row * ldkr + ch * 8) * 2u; }
  const size_t tstepK = (size_t)KVBLK * ldk * 2, tstepKR = (size_t)KVBLK * ldkr * 2;
  const unsigned ldsK = RFLU(lds0 + OFF_K + (wid * 2) * 1024), ldsV = RFLU(lds0 + OFF_V + (wid * 2) * 1024), ldsKR = RFLU(lds0 + OFF_KR + wid * 1024);
#define RFL(x) ((unsigned)__builtin_amdgcn_readfirstlane((int)(x)))
#define DMA_K(t, b) do { const char* g_ = (const char*)Kh + (size_t)(t) * tstepK; \
    glds16x2(g_, kofs[0], kofs[1], ldsK + (b) * SHM_K, ldsK + (b) * SHM_K + 1024); \
    if constexpr (ROPEK) glds16s((const char*)KRh + (size_t)(t) * tstepKR, krofs, ldsKR + (b) * SHM_KR); } while (0)
#define DMA_V(t, b) do { const char* g_ = (const char*)Vh + (size_t)(t) * tstepK; \
    glds16x2(g_, vofs[0], vofs[1], ldsV + (b) * SHM_V, ldsV + (b) * SHM_V + 1024); } while (0)
#define DMA_EVEN(j) do { if ((j) + 1 < NT) DMA_K((j) + 1, ((j) + 1) & 1); if ((j) < NT) DMA_V((j), (j) & 1); } while (0)
#define SEG_BAR() do { SBAR(); asm volatile("s_waitcnt lgkmcnt(0)\n\ts_barrier" ::: "memory"); SBAR(); } while (0)
#define SEG_WBAR() do { SBAR(); asm volatile("s_waitcnt vmcnt(0) lgkmcnt(0)\n\ts_barrier" ::: "memory"); SBAR(); } while (0)
  f32x16 s0, s1; float mn, al; bf16x8 pa0, pa1, pa2, pa3;
  DMA_K(0, 0); DMA_V(0, 0); if (1 < NT) DMA_K(1, 1);
  SEG_WBAR();
  if (half == 1) SEG_BAR();
  for (int k = 0; k < NT; ++k) {
    STAMP0();
    if (half == 0 && k >= 1) DMA_EVEN(k);
    { const int vbk = vb0 + ((k - 1) & 1) * SHM_V; s16x4 va[8], vc[8];
      if (k >= 1) trd8<0>(va, vbk);
      SBAR(); qkt<NQ, ROPEK>(s0, s1, K_lds + (k & 1) * SHM_K, KR_lds + (k & 1) * SHM_KR, QR_lds, qr, r32, hi, kd0); SBAR();
      if (k >= 1) { trd8<1>(vc, vbk); LGKM_WAIT(8); pv4(o[0], va, pa0, pa1, pa2, pa3); SBAR();
                    trd8<2>(va, vbk); LGKM_WAIT(8); pv4(o[1], vc, pa0, pa1, pa2, pa3); SBAR();
                    trd8<3>(vc, vbk); LGKM_WAIT(8); pv4(o[2], va, pa0, pa1, pa2, pa3); SBAR();
                    LGKM_WAIT(0); pv4(o[3], vc, pa0, pa1, pa2, pa3); } }
    asm volatile("s_nop 15\n\ts_nop 15" ::: "memory"); STAMP1(tM);
    if (half == 1) SEG_WBAR(); else SEG_BAR();
    STAMP1(tMb);
    if (half == 1) DMA_EVEN(k + 1);
    if constexpr (SWA) band_mask(s0, s1, kpos0 + k * KVBLK, qpos, hi);
    partialSM(s0, s1, m_reg, mn, al, C, thr);
    if (__any(al < 1.f)) { if (hi == 0) al_l[r32] = al; asm volatile("s_waitcnt lgkmcnt(0)" ::: "memory");
#pragma unroll
      for (int d = 0; d < 4; ++d)
#pragma unroll
        for (int r = 0; r < 16; ++r) o[d][r] *= al_l[crow(r, hi)]; }
    finishSM(s0, s1, al, l_reg, pa0, pa1, pa2, pa3);
    asm volatile("" : "+v"(pa0), "+v"(pa1), "+v"(pa2), "+v"(pa3)); STAMP1(tV);
    if (half == 0) SEG_WBAR(); else SEG_BAR();
    STAMP1(tVb);
  }
#ifdef PROBE_STAMP
  if (stamp && blockIdx.x == 0 && (wid == 0 || wid == 4) && lane == 0) { unsigned* q = stamp + (wid == 0 ? 0 : 4);
    atomicAdd(q + 0, (unsigned)(tM / NT)); atomicAdd(q + 1, (unsigned)(tMb / NT)); atomicAdd(q + 2, (unsigned)(tV / NT)); atomicAdd(q + 3, (unsigned)(tVb / NT)); }
#endif
  pv_d0(o, vb0 + ((NT - 1) & 1) * SHM_V, pa0, pa1, pa2, pa3);
  SEG_BAR();
  if (half == 0) SEG_BAR();
#undef RFL
#undef DMA_K
#undef DMA_V
#undef DMA_EVEN
#undef SEG_BAR
#undef SEG_WBAR
}

template <int NQ, bool ROPEK, bool SWA>
__device__ __forceinline__ void attn_core_hs(LAS char* lds, const bf16x8 (&qr)[NQ],
                                             const bf16* __restrict__ Kh, const bf16* __restrict__ Vh, const int ldk, const bf16* __restrict__ KRh, const int ldkr,
                                             const int NT, const float C, const float thr, const int kd0, const int qpos, const int kpos0,
                                             f32x16 (&o)[4], float& m_reg, float& l_reg, const int wv) {
  const int tid = opq_tid(wv), lane = tid & 63, r32 = lane & 31, hi = lane >> 5;
  const int wid = __builtin_amdgcn_readfirstlane(tid >> 6);
  const int half = wid >> 2;
  LAS char* K_lds = lds + OFF_K; LAS char* KR_lds = lds + OFF_KR;
  LAS float* al_l = (LAS float*)(lds + OFF_WS) + wid * 64 + 32;
  const LAS char* QR_lds = lds + OFF_QR + wid * 4096 + lane * 16;
  const unsigned lds0 = (unsigned)(uintptr_t)lds;
  const int vb0 = (int)lds0 + OFF_V + v_rd_base(lane);
  unsigned kofs[2], vofs[2], krofs = 0u;
#pragma unroll
  for (int i = 0; i < 2; ++i) { const int p = wid * 2 + i;
    { const int row = p * 4 + (lane >> 4), ch = (lane & 15) ^ (row & KSW_MASK); kofs[i] = (unsigned)(row * ldk + ch * 8) * 2u; }
    { const int sub = 2 * p + (lane >> 5), kk = (sub >> 2) * 8 + ((lane & 31) >> 2), k = ATT_NOSWAP ? kk : ((kk & ~0xC) | ((kk & 4) << 1) | ((kk & 8) >> 1)), c = (sub & 3) * 32 + (lane & 3) * 8;
      vofs[i] = (unsigned)(k * ldk + c) * 2u; } }
  if constexpr (ROPEK) { const int row = wid * 8 + (lane >> 3), ch = (lane & 7) ^ ((row >> 1) & 7); krofs = (unsigned)(row * ldkr + ch * 8) * 2u; }
  const size_t tstepK = (size_t)KVBLK * ldk * 2, tstepKR = (size_t)KVBLK * ldkr * 2;
  const unsigned ldsK = RFLU(lds0 + OFF_K + (wid * 2) * 1024), ldsV = RFLU(lds0 + OFF_V + (wid * 2) * 1024), ldsKR = RFLU(lds0 + OFF_KR + wid * 1024);
#define DMA_K(t, b) do { const char* g_ = (const char*)Kh + (size_t)(t) * tstepK; \
    glds16x2(g_, kofs[0], kofs[1], ldsK + (b) * SHM_K, ldsK + (b) * SHM_K + 1024); \
    if constexpr (ROPEK) glds16s((const char*)KRh + (size_t)(t) * tstepKR, krofs, ldsKR + (b) * SHM_KR); } while (0)
#define DMA_V(t, b) do { const char* g_ = (const char*)Vh + (size_t)(t) * tstepK; \
    glds16x2(g_, vofs[0], vofs[1], ldsV + (b) * SHM_V, ldsV + (b) * SHM_V + 1024); } while (0)
#define RESC(a) do { if (__any((a) < 1.f)) { if (hi == 0) al_l[r32] = (a); asm volatile("s_waitcnt lgkmcnt(0)" ::: "memory"); \
    _Pragma("unroll") for (int d = 0; d < 4; ++d) _Pragma("unroll") for (int r = 0; r < 16; ++r) o[d][r] *= al_l[crow(r, hi)]; } } while (0)
#define QKT(P0, P1, b, tile) do { qkt<NQ, ROPEK>(P0, P1, K_lds + (b) * SHM_K, KR_lds + (b) * SHM_KR, QR_lds, qr, r32, hi, kd0); \
    if constexpr (SWA) band_mask(P0, P1, kpos0 + (tile) * KVBLK, qpos, hi); } while (0)
#define BAR_ISSUE(j, vw) do { SBAR(); WAIT_BAR(); if ((j) + 2 < NT) DMA_K((j) + 2, (j) & 1); if ((j) + 1 < NT) DMA_V((j) + 1, (vw)); SBAR(); } while (0)
  f32x16 pA0, pA1, pB0, pB1; float mnA, mnB, alA, alB; bf16x8 pa0, pa1, pa2, pa3;
  DMA_K(0, 0); DMA_V(0, 0); DMA_K(1, 1);
  WAIT_BAR();
  QKT(pA0, pA1, 0, 0);
  if (half == 1) BAR_ISSUE(0, 1);
  partialSM(pA0, pA1, m_reg, mnA, alA, C, thr);
  if (half == 0) BAR_ISSUE(0, 1);
  int vr = 0;
  for (int j = 1; j + 1 < NT; j += 2) {
    { const int vw = vr == 0 ? 2 : vr - 1;
      SBAR(); QKT(pB0, pB1, 1, j);
      finishSM(pA0, pA1, alA, l_reg, pa0, pa1, pa2, pa3);
      if (half == 1) BAR_ISSUE(j, vw);
      SBAR(); pv_d0(o, vb0 + vr * SHM_V, pa0, pa1, pa2, pa3); partialSM(pB0, pB1, m_reg, mnB, alB, C, thr);
      if (half == 0) BAR_ISSUE(j, vw);
      RESC(alB); vr = vr == 2 ? 0 : vr + 1; }
    { const int vw = vr == 0 ? 2 : vr - 1;
      SBAR(); QKT(pA0, pA1, 0, j + 1);
      finishSM(pB0, pB1, alB, l_reg, pa0, pa1, pa2, pa3);
      if (half == 1) BAR_ISSUE(j + 1, vw);
      SBAR(); pv_d0(o, vb0 + vr * SHM_V, pa0, pa1, pa2, pa3); partialSM(pA0, pA1, m_reg, mnA, alA, C, thr);
      if (half == 0) BAR_ISSUE(j + 1, vw);
      RESC(alA); vr = vr == 2 ? 0 : vr + 1; }
  }
  { const int vw = vr == 0 ? 2 : vr - 1;
    SBAR(); QKT(pB0, pB1, 1, NT - 1);
    finishSM(pA0, pA1, alA, l_reg, pa0, pa1, pa2, pa3);
    if (half == 1) BAR_ISSUE(NT - 1, vw);
    SBAR(); pv_d0(o, vb0 + vr * SHM_V, pa0, pa1, pa2, pa3); partialSM(pB0, pB1, m_reg, mnB, alB, C, thr);
    if (half == 0) BAR_ISSUE(NT - 1, vw);
    RESC(alB); vr = vr == 2 ? 0 : vr + 1; }
  finishSM(pB0, pB1, alB, l_reg, pa0, pa1, pa2, pa3); SBAR();
  pv_d0(o, vb0 + vr * SHM_V, pa0, pa1, pa2, pa3);
  SBAR(); asm volatile("s_waitcnt lgkmcnt(0)\n\ts_barrier" ::: "memory"); SBAR();
#undef DMA_K
#undef DMA_V
#undef RESC
#undef QKT
#undef BAR_ISSUE
}

__device__ __forceinline__ void store_o(LAS char* lds, const f32x16 (&o)[4], float l_reg, bf16* Ow, const int ldo, const int wv) {
  const int tid = opq_tid(wv), lane = tid & 63, r32 = lane & 31, hi = lane >> 5; const int wid = __builtin_amdgcn_readfirstlane(tid >> 6);
  LAS float* li_l = (LAS float*)(lds + OFF_WS) + wid * 64;
  if (hi == 0) li_l[r32] = l_reg; asm volatile("s_waitcnt lgkmcnt(0)" ::: "memory");
  float rli[16];
#pragma unroll
  for (int r = 0; r < 16; ++r) rli[r] = __builtin_amdgcn_rcpf(li_l[crow(r, hi)]);
#pragma unroll
  for (int r = 0; r < 16; ++r) { const int orow = crow(r, hi);
#pragma unroll
    for (int d0 = 0; d0 < 4; ++d0) Ow[(long)orow * ldo + d0 * 32 + r32] = (bf16)f2bf(o[d0][r] * rli[r]); }
}
}
struct Frame {
    LAS unsigned char* lds;
    volatile LAS unsigned* MISC;
    gu32* ctl;
    int tid, lane, wave;
    int vcu, G;
};

struct WItem { const float* W; bf16* WT; int N, K, k0, n0, drow0; float* cm; };
struct WSrc { const float *w_in, *w_uq, *w_ukv, *w_br, *w_bg, *w_o, *w_fi, *w_fo, *w_ple, *w_pg; float* cm; };
constexpr int IT_IN = 146 * 32, IT_BG = 4 * 64 * 32, IT_UQ = 24 * 8, IT_UKV = 32 * 8, IT_BR = 4 * 64 * 8, IT_WO = 64 * 32, IT_FI = 352 * 32, IT_FO = 64 * 88, IT_PLE = 64 * 4, IT_PG = 64 * 32;
constexpr int IT_LAYER = IT_IN + IT_BG + IT_UQ + IT_UKV + IT_BR + IT_WO + IT_FI + IT_FO + IT_PLE + IT_PG;
__device__ __forceinline__ WItem witem(const WSrc& ws, bf16* WL, int L, int r) {
    if (r < IT_IN) { const int kb = r / 146, nb = r % 146; return WItem{ws.w_in + (size_t)L * D * ZC, WL + WL_W1, ZC, D, 64 * kb, 32 * nb, 32 * nb, nullptr}; } r -= IT_IN;
    if (r < IT_BG) { const int j = r / (64 * 32), q = r % (64 * 32), kb = q / 64, nb = q % 64; if (GATES_I8) return WItem{ws.w_bg + ((size_t)L * 4 + j) * D * D, WL + WL_W1 + (size_t)ZP * D, D, D, 64 * kb, 32 * nb, j * D + 32 * nb, ws.cm + (L * 5 + j) * D};
        return WItem{ws.w_bg + ((size_t)L * 4 + j) * D * D, WL + WL_W1, D, D, 64 * kb, 32 * nb, ZP + j * D + 32 * nb, nullptr}; } r -= IT_BG;
    if (r < IT_UQ) { const int kb = r / 24, nb = r % 24; return WItem{ws.w_uq + (size_t)L * 512 * 768, WL + WL_UQKV, 768, 512, 64 * kb, 32 * nb, 32 * nb, nullptr}; } r -= IT_UQ;
    if (r < IT_UKV) { const int kb = r / 32, nb = r % 32; return WItem{ws.w_ukv + (size_t)L * 512 * 1024, WL + WL_UQKV, 1024, 512, 64 * kb, 32 * nb, 768 + 32 * nb, nullptr}; } r -= IT_UKV;
    if (r < IT_BR) { const int j = r / (64 * 8), q = r % (64 * 8), kb = q / 64, nb = q % 64; return WItem{ws.w_br + ((size_t)L * 4 + j) * 512 * D, WL + WL_BR + (size_t)j * D * 512, D, 512, 64 * kb, 32 * nb, 32 * nb, nullptr}; } r -= IT_BR;
    if (r < IT_WO) { const int kb = r / 64, nb = r % 64; return WItem{ws.w_o + (size_t)L * D * D, WL + WL_WO, D, D, 64 * kb, 32 * nb, 32 * nb, nullptr}; } r -= IT_WO;
    if (r < IT_FI) { const int kb = r / 352, nb = r % 352; const int c0 = 32 * nb; const int up = c0 >= FF ? 1 : 0, cc = c0 - up * FF;
        return WItem{ws.w_fi + (size_t)L * D * 2 * FF, WL + WL_FI, 2 * FF, D, 64 * kb, c0, (cc >> 7) * 256 + up * 128 + (cc & 127), (GATES_I8 && FFN_I8) ? ws.cm + (CW_CMF - CW_CM) + L * 2 * FF : nullptr}; } r -= IT_FI;
    if (r < IT_FO) { const int kb = r / 64, nb = r % 64; return WItem{ws.w_fo + (size_t)L * FF * D, WL + WL_FO, D, FF, 64 * kb, 32 * nb, 32 * nb, nullptr}; } r -= IT_FO;
    if (r < IT_PLE) { const int kb = r / 64, nb = r % 64; return WItem{ws.w_ple + (size_t)L * PLE * D, WL + WL_PLE, D, PLE, 64 * kb, 32 * nb, 32 * nb, nullptr}; } r -= IT_PLE;
    { const int kb = r / 64, nb = r % 64; return WItem{ws.w_pg + (size_t)L * D * D, WL + WL_PG, D, D, 64 * kb, 32 * nb, 32 * nb, GATES_I8 ? ws.cm + (L * 5 + 4) * D : nullptr}; }
}
struct WRegs { f32x4 v[8]; };
__device__ __forceinline__ WRegs witem_load(const WItem& it, int lane) { WRegs r; const int lr = lane >> 3, lc = (lane & 7) * 4;
#pragma unroll
    for (int i = 0; i < 8; ++i) r.v[i] = *(const f32x4*)(it.W + (size_t)(it.k0 + 8 * i + lr) * it.N + it.n0 + lc);
    return r; }
__device__ __forceinline__ void witem_store(const WItem& it, const WRegs& r, LAS float* scr, int lane) {
    const int lr = lane >> 3, lc = (lane & 7) * 4;
#pragma unroll
    for (int i = 0; i < 8; ++i) { LAS float* s = scr + (8 * i + lr) * 33 + lc; s[0] = r.v[i][0]; s[1] = r.v[i][1]; s[2] = r.v[i][2]; s[3] = r.v[i][3]; }
    LDS_WAIT(); asm volatile("" ::: "memory");
    const int c = lane & 7;
    if (it.cm) {
        unsigned char* W8 = (unsigned char*)it.WT;
#pragma unroll
        for (int j = 0; j < 4; ++j) { const int n = (lane >> 3) + 8 * j; const LAS float* s = scr + (8 * c) * 33 + n; const float cmx = it.cm[it.n0 + n]; const float q = cmx > 0.f ? 127.0f / cmx : 0.f;
            v2u o; o.x = pk4_i8(q * s[0 * 33], q * s[1 * 33], q * s[2 * 33], q * s[3 * 33]); o.y = pk4_i8(q * s[4 * 33], q * s[5 * 33], q * s[6 * 33], q * s[7 * 33]);
            *(v2u*)(W8 + (size_t)(it.drow0 + n) * it.K + it.k0 + 8 * c) = o; }
    } else {
#pragma unroll
        for (int j = 0; j < 4; ++j) { const int n = (lane >> 3) + 8 * j; const LAS float* s = scr + (8 * c) * 33 + n;
            v4u o; o.x = pk2(s[0 * 33], s[1 * 33]); o.y = pk2(s[2 * 33], s[3 * 33]); o.z = pk2(s[4 * 33], s[5 * 33]); o.w = pk2(s[6 * 33], s[7 * 33]);
            *(v4u*)(it.WT + (size_t)(it.drow0 + n) * it.K + it.k0 + 8 * c) = o; }
    }
    LDS_WAIT(); asm volatile("" ::: "memory");
}
__device__ __forceinline__ void witem_colmax(const WItem& it, const WRegs& r, int lane) {
    f32x4 m = (f32x4){0.f, 0.f, 0.f, 0.f};
#pragma unroll
    for (int i = 0; i < 8; ++i) { m[0] = fmaxf(m[0], fabsf(r.v[i][0])); m[1] = fmaxf(m[1], fabsf(r.v[i][1])); m[2] = fmaxf(m[2], fabsf(r.v[i][2])); m[3] = fmaxf(m[3], fabsf(r.v[i][3])); }
#pragma unroll
    for (int e = 0; e < 4; ++e) { float v = m[e]; v = fmaxf(v, shx<8>(v)); v = fmaxf(v, shx<16>(v));
        auto rr = __builtin_amdgcn_permlane32_swap(__float_as_uint(v), __float_as_uint(v), false, false); m[e] = fmaxf(__uint_as_float(rr[0]), __uint_as_float(rr[1])); }
    if (lane < 8) {
#pragma unroll
        for (int e = 0; e < 4; ++e) atomicMax((unsigned*)it.cm + it.n0 + 4 * lane + e, __float_as_uint(m[e])); }
}

#ifndef THIN_XAL
#define THIN_XAL 0
#endif
#ifndef THIN_NT
#define THIN_NT 1
#endif
#if THIN_NT
#define XLD(p) __builtin_nontemporal_load(p)
#define XST(p, v) __builtin_nontemporal_store(v, p)
#else
#define XLD(p) (*(p))
#define XST(p, v) (*(p) = (v))
#endif
#ifndef THIN_NTH
#define THIN_NTH 0
#endif
#if THIN_NTH
#define HST(p, v) __builtin_nontemporal_store(v, p)
#else
#define HST(p, v) (*(p) = (v))
#endif
template <int MODE, bool Y2 = false>
__device__ __forceinline__ void thin_phase(Frame& F, const float* __restrict__ xin, const bf16* __restrict__ y, float* __restrict__ x, bf16* __restrict__ h,
                                           const float* __restrict__ gpost, const float* __restrict__ gpre, unsigned char* __restrict__ h8 = nullptr, float* __restrict__ sa8 = nullptr,
                                           const bool wx = true, const bf16* __restrict__ y2 = nullptr, const float* __restrict__ gpost2 = nullptr) {
    const int tid_ = opq_tid(F.wave), lane = tid_ & 63, wave_ = __builtin_amdgcn_readfirstlane(tid_ >> 6);
    const int gw = F.vcu * NWAVES + wave_, NGW = F.G * NWAVES;
    const bool xal = THIN_XAL && NGW == 2048 && S == 16384;
    const int rw0 = xal ? (gw >> 8) * 2048 + (gw & 255) : gw, rstep = xal ? 256 : NGW, rend = xal ? (gw >> 8) * 2048 + 2048 : S;
    f32x4 gp[8], gq[8];
#pragma unroll
    for (int j = 0; j < 8; ++j) { gp[j] = (MODE >= 1) ? *(const f32x4*)(gpost + 256 * j + 4 * lane) : (f32x4){0.f, 0.f, 0.f, 0.f};
                                  gq[j] = (MODE <= 1 || MODE == 4) ? *(const f32x4*)(gpre + 256 * j + 4 * lane) : (f32x4){0.f, 0.f, 0.f, 0.f}; }
    const float* const xsrc = (MODE == 0 || MODE == 4 || xin != nullptr) ? xin : x;
    f32x4 v[8]; v2u yw[8], yw2[8];
    if (rw0 < rend) {
#pragma unroll
        for (int j = 0; j < 8; ++j) v[j] = XLD((const f32x4*)(xsrc + (size_t)rw0 * D + 4 * lane + 256 * j));
        if constexpr (MODE >= 1) {
#pragma unroll
            for (int j = 0; j < 8; ++j) yw[j] = *(const v2u*)(y + (size_t)rw0 * D + 4 * lane + 256 * j); }
        if constexpr (Y2) {
#pragma unroll
            for (int j = 0; j < 8; ++j) yw2[j] = *(const v2u*)(y2 + (size_t)rw0 * D + 4 * lane + 256 * j); }
    }
    for (int row = rw0; row < rend; row += rstep) {
        const int nrow = row + rstep; const bool more = nrow < rend;
        f32x4 vn[8]; v2u ywn[8];
        if constexpr (!Y2) {
#pragma unroll
            for (int j = 0; j < 8; ++j) { vn[j] = v[j]; ywn[j] = (MODE >= 1) ? yw[j] : (v2u){0u, 0u}; }
            if (more) {
#pragma unroll
                for (int j = 0; j < 8; ++j) vn[j] = XLD((const f32x4*)(xsrc + (size_t)nrow * D + 4 * lane + 256 * j));
                if constexpr (MODE >= 1) {
#pragma unroll
                    for (int j = 0; j < 8; ++j) ywn[j] = *(const v2u*)(y + (size_t)nrow * D + 4 * lane + 256 * j); }
            }
        } else if (row != rw0) {
#pragma unroll
            for (int j = 0; j < 8; ++j) v[j] = XLD((const f32x4*)(xsrc + (size_t)row * D + 4 * lane + 256 * j));
#pragma unroll
            for (int j = 0; j < 8; ++j) yw[j] = *(const v2u*)(y + (size_t)row * D + 4 * lane + 256 * j);
#pragma unroll
            for (int j = 0; j < 8; ++j) yw2[j] = *(const v2u*)(y2 + (size_t)row * D + 4 * lane + 256 * j);
        }
        if constexpr (MODE >= 1) {
            f32x4 yv[8]; float s = 0.f;
#pragma unroll
            for (int j = 0; j < 8; ++j) { const v2u w = yw[j]; yv[j] = (f32x4){bflo(w.x), bfhi(w.x), bflo(w.y), bfhi(w.y)};
                s += (yv[j][0] * yv[j][0] + yv[j][1] * yv[j][1]) + (yv[j][2] * yv[j][2] + yv[j][3] * yv[j][3]); }
            const float rstd = 1.0f / sqrtf(wave_sum(s) * (1.0f / D) + RMS_EPS);
#pragma unroll
            for (int j = 0; j < 8; ++j) v[j] += yv[j] * rstd * gp[j];
        }
        if constexpr (Y2) {
            f32x4 yv[8]; float s = 0.f;
#pragma unroll
            for (int j = 0; j < 8; ++j) { const v2u w = yw2[j]; yv[j] = (f32x4){bflo(w.x), bfhi(w.x), bflo(w.y), bfhi(w.y)};
                s += (yv[j][0] * yv[j][0] + yv[j][1] * yv[j][1]) + (yv[j][2] * yv[j][2] + yv[j][3] * yv[j][3]); }
            const float rstd = 1.0f / sqrtf(wave_sum(s) * (1.0f / D) + RMS_EPS);
#pragma unroll
            for (int j = 0; j < 8; ++j) v[j] += yv[j] * rstd * *(const f32x4*)(gpost2 + 256 * j + 4 * lane);
        }
        if (wx) { float* xo = x + (size_t)row * D + 4 * lane;
#pragma unroll
            for (int j = 0; j < 8; ++j) XST((f32x4*)(xo + 256 * j), v[j]); }
        if constexpr (MODE <= 1 || MODE == 4) {
            float s = 0.f;
#pragma unroll
            for (int j = 0; j < 8; ++j) s += (v[j][0] * v[j][0] + v[j][1] * v[j][1]) + (v[j][2] * v[j][2] + v[j][3] * v[j][3]);
            const float rstd = 1.0f / sqrtf(wave_sum(s) * (1.0f / D) + RMS_EPS);
            bf16* hr = h + (size_t)row * D + 4 * lane;
            float amax = 0.f;
#pragma unroll
            for (int j = 0; j < 8; ++j) { const f32x4 t = v[j] * rstd * gq[j]; v[j] = t; if (h) { v2u w; w.x = pk2(t[0], t[1]); w.y = pk2(t[2], t[3]); HST((v2u*)(hr + 256 * j), w); }
                amax = fmaxf(fmaxf(amax, fmaxf(fabsf(t[0]), fabsf(t[1]))), fmaxf(fabsf(t[2]), fabsf(t[3]))); }
            if (h8) { amax = wave_max(amax); const float q = amax > 0.f ? 127.0f / amax : 0.f; if (lane == 0) sa8[row] = amax * (1.0f / 127.0f);
#pragma unroll
                for (int j = 0; j < 8; ++j) HST((unsigned*)(h8 + (size_t)row * D + 4 * lane + 256 * j), pk4_i8(q * v[j][0], q * v[j][1], q * v[j][2], q * v[j][3])); }
        }
        if constexpr (MODE == 2) {
            if (h8) { float amax = 0.f;
#pragma unroll
                for (int j = 0; j < 8; ++j) amax = fmaxf(fmaxf(amax, fmaxf(fabsf(v[j][0]), fabsf(v[j][1]))), fmaxf(fabsf(v[j][2]), fabsf(v[j][3])));
                amax = wave_max(amax); const float q = amax > 0.f ? 127.0f / amax : 0.f; if (lane == 0) sa8[row] = amax * (1.0f / 127.0f);
#pragma unroll
                for (int j = 0; j < 8; ++j) HST((unsigned*)(h8 + (size_t)row * D + 4 * lane + 256 * j), pk4_i8(q * v[j][0], q * v[j][1], q * v[j][2], q * v[j][3]));
            } else { bf16* hr = h + (size_t)row * D + 4 * lane;
#pragma unroll
                for (int j = 0; j < 8; ++j) { v2u w; w.x = pk2(v[j][0], v[j][1]); w.y = pk2(v[j][2], v[j][3]); *(v2u*)(hr + 256 * j) = w; } }
        }
#pragma unroll
        for (int j = 0; j < 8; ++j) { if constexpr (!Y2) { v[j] = vn[j]; if constexpr (MODE >= 1) yw[j] = ywn[j]; } }
    }
}

struct PrepP { bf16* Z; const float *c64, *s64, *c128, *s128; const float *qa, *kva, *axq, *axk; };
struct Sp2 { unsigned w1, w2; };
__device__ __forceinline__ Sp2 span64_load(const bf16* zr, int base, int lane, bool active) {
    const int col = base + (lane >> 4) * 64 + 2 * (lane & 15); Sp2 r{0u, 0u};
    if (active) { r.w1 = *(const unsigned*)(zr + col); r.w2 = *(const unsigned*)(zr + col + 32); } return r; }
template <bool NORM>
__device__ __forceinline__ void span64_apply(bf16* zr, int base, const Sp2 in, const float* c64, const float* s64, int pos_e, int pos_o, const float* g, int lane, bool active) {
    const int chunk = lane >> 4, jp = lane & 15, col = base + chunk * 64 + 2 * jp;
    float a0 = bflo(in.w1), a1 = bfhi(in.w1), b0 = bflo(in.w2), b1 = bfhi(in.w2);
    if constexpr (NORM) {
        const float s = sum32((a0 * a0 + a1 * a1) + (b0 * b0 + b1 * b1));
        const float rstd = 1.0f / sqrtf(s * (1.0f / 128.0f) + RMS_EPS);
        const int gi = (chunk & 1) * 64 + 2 * jp;
        a0 *= rstd * g[gi]; a1 *= rstd * g[gi + 1]; b0 *= rstd * g[gi + 32]; b1 *= rstd * g[gi + 33];
    }
    const int pos = (chunk & 1) ? pos_o : pos_e;
    const f32x2 c = *(const f32x2*)(c64 + (size_t)pos * 32 + 2 * jp), s = *(const f32x2*)(s64 + (size_t)pos * 32 + 2 * jp);
    const float n0 = a0 * c[0] - b0 * s[0], n1 = a1 * c[1] - b1 * s[1], m0 = b0 * c[0] + a0 * s[0], m1 = b1 * c[1] + a1 * s[1];
    if (active) { *(unsigned*)(zr + col) = pk2(n0, n1); *(unsigned*)(zr + col + 32) = pk2(m0, m1); }
}
__device__ __forceinline__ Sp2 span128_load(const bf16* zr, int base, int lane) { const int col = base + (lane >> 5) * 128 + 2 * (lane & 31); return Sp2{*(const unsigned*)(zr + col), *(const unsigned*)(zr + col + 64)}; }
__device__ __forceinline__ void span128_apply(bf16* zr, int base, const Sp2 in, const float* c128, const float* s128, int pos, int lane) {
    const int head = lane >> 5, jp = lane & 31, col = base + head * 128 + 2 * jp;
    const float a0 = bflo(in.w1), a1 = bfhi(in.w1), b0 = bflo(in.w2), b1 = bfhi(in.w2);
    const f32x2 c = *(const f32x2*)(c128 + (size_t)pos * 64 + 2 * jp), s = *(const f32x2*)(s128 + (size_t)pos * 64 + 2 * jp);
    *(unsigned*)(zr + col) = pk2(a0 * c[0] - b0 * s[0], a1 * c[1] - b1 * s[1]);
    *(unsigned*)(zr + col + 64) = pk2(b0 * c[0] + a0 * s[0], b1 * c[1] + a1 * s[1]);
}
__device__ __forceinline__ void latent_apply(bf16* zr, int base, const v4u w, const float* g, int lane) {
    f32x4 a, b; pg8::unpack8(w, a, b);
    float s = (a[0] * a[0] + a[1] * a[1]) + (a[2] * a[2] + a[3] * a[3]) + (b[0] * b[0] + b[1] * b[1]) + (b[2] * b[2] + b[3] * b[3]);
    const float rstd = 1.0f / sqrtf(wave_sum(s) * (1.0f / 512.0f) + RMS_EPS);
    const f32x4 g0 = *(const f32x4*)(g + 8 * lane), g1 = *(const f32x4*)(g + 8 * lane + 4);
    a = a * rstd * g0; b = b * rstd * g1;
    v4u o; o.x = pk2(a[0], a[1]); o.y = pk2(a[2], a[3]); o.z = pk2(b[0], b[1]); o.w = pk2(b[2], b[3]);
    *(v4u*)(zr + base + 8 * lane) = o;
}
__device__ __forceinline__ void prep_phase(Frame& F, const PrepP& P) {
    const int tid_ = opq_tid(F.wave), lane = tid_ & 63, wave_ = __builtin_amdgcn_readfirstlane(tid_ >> 6);
    const int gw = F.vcu * NWAVES + wave_, NGW = F.G * NWAVES;
    for (int t = gw; t < S; t += NGW) {
        bf16* zr = P.Z + (size_t)t * ZP;
        const v4u lq = *(const v4u*)(zr + Z_CQ + 8 * lane), lkv = *(const v4u*)(zr + Z_CKV + 8 * lane);
        const Sp2 kr = span64_load(zr, Z_KR, lane, lane < 16);
        const Sp2 dq0 = span64_load(zr, Z_DQ, lane, true), dq1 = span64_load(zr, Z_DQ + 256, lane, true), dk0 = span64_load(zr, Z_DK, lane, true), dk1 = span64_load(zr, Z_DK + 256, lane, true);
        const Sp2 sq0 = span128_load(zr, Z_SQ, lane), sq1 = span128_load(zr, Z_SQ + 256, lane), sk0 = span128_load(zr, Z_SK, lane);
        const Sp2 aq0 = span64_load(zr, Z_AQ, lane, true), aq1 = span64_load(zr, Z_AQ + 256, lane, true), ak0 = span64_load(zr, Z_AK, lane, true);
        asm volatile("" ::: "memory");
        latent_apply(zr, Z_CQ, lq, P.qa, lane);
        latent_apply(zr, Z_CKV, lkv, P.kva, lane);
        span64_apply<false>(zr, Z_KR, kr, P.c64, P.s64, t, t, nullptr, lane, lane < 16);
        span64_apply<false>(zr, Z_DQ, dq0, P.c64, P.s64, t, t, nullptr, lane, true);
        span64_apply<false>(zr, Z_DQ + 256, dq1, P.c64, P.s64, t, t, nullptr, lane, true);
        span64_apply<false>(zr, Z_DK, dk0, P.c64, P.s64, t, t, nullptr, lane, true);
        span64_apply<false>(zr, Z_DK + 256, dk1, P.c64, P.s64, t, t, nullptr, lane, true);
        span128_apply(zr, Z_SQ, sq0, P.c128, P.s128, t, lane);
        span128_apply(zr, Z_SQ + 256, sq1, P.c128, P.s128, t, lane);
        span128_apply(zr, Z_SK, sk0, P.c128, P.s128, t, lane);
        span64_apply<true>(zr, Z_AQ, aq0, P.c64, P.s64, t >> 6, t & 63, P.axq, lane, true);
        span64_apply<true>(zr, Z_AQ + 256, aq1, P.c64, P.s64, t >> 6, t & 63, P.axq, lane, true);
        span64_apply<true>(zr, Z_AK, ak0, P.c64, P.s64, t >> 6, t & 63, P.axk, lane, true);
        asm volatile("" ::: "memory");
    }
}

__device__ __forceinline__ void knorm_pass(Frame& F, const bf16* __restrict__ Z, unsigned* __restrict__ slot) {
    const int tid_ = opq_tid(F.wave), lane = tid_ & 63, wave_ = __builtin_amdgcn_readfirstlane(tid_ >> 6);
    const int gw = F.vcu * NWAVES + wave_, NGW = F.G * NWAVES;
    float md = 0.f, ma = 0.f, mr = 0.f;
    for (int t = gw; t < S; t += NGW) {
        const bf16* zr = Z + (size_t)t * ZP;
        const v4u dk = *(const v4u*)(zr + Z_DK + 8 * lane);
        const v4u ak = *(const v4u*)(zr + Z_AK + 8 * (lane & 31));
        const v4u kr = *(const v4u*)(zr + Z_KR + 8 * (lane & 7));
        f32x4 a, b; pg8::unpack8(dk, a, b);
        float sd = (a[0] * a[0] + a[1] * a[1]) + (a[2] * a[2] + a[3] * a[3]) + (b[0] * b[0] + b[1] * b[1]) + (b[2] * b[2] + b[3] * b[3]);
        pg8::unpack8(ak, a, b);
        float sa = (a[0] * a[0] + a[1] * a[1]) + (a[2] * a[2] + a[3] * a[3]) + (b[0] * b[0] + b[1] * b[1]) + (b[2] * b[2] + b[3] * b[3]);
        sd += shx<1>(sd); sd += shx<2>(sd); sd += shx<4>(sd);
        sa += shx<1>(sa); sa += shx<2>(sa); sa += shx<4>(sa); sa += shx<8>(sa);
        pg8::unpack8(kr, a, b);
        float sr = (a[0] * a[0] + a[1] * a[1]) + (a[2] * a[2] + a[3] * a[3]) + (b[0] * b[0] + b[1] * b[1]) + (b[2] * b[2] + b[3] * b[3]);
        sr += shx<1>(sr); sr += shx<2>(sr); sr += shx<4>(sr);
        md = fmaxf(md, sd); ma = fmaxf(ma, sa); mr = fmaxf(mr, sr);
    }
    md = wave_max(md); ma = wave_max(ma); mr = wave_max(mr);
    if (lane == 0) { atomicMax(slot + 0, __float_as_uint(md)); atomicMax(slot + 1, __float_as_uint(ma)); atomicMax(slot + 2, __float_as_uint(mr)); }
}

__device__ __forceinline__ bf16x8 qscale(const bf16x8 q, const float c) { if (!ATT_NEGM) return q; f32x4 a, b; pg8::unpack8(__builtin_bit_cast(v4u, q), a, b); return __builtin_bit_cast(bf16x8, pg8::pack8(a * c, b * c)); }
constexpr float M0 = ATT_NEGM ? 0.f : -1e30f;
#ifndef ATT_STAG
#define ATT_STAG 0
#endif
#if ATT_STAG
#define ATTN_CORE att::attn_core_stag
#elif ATT_HS
#define ATTN_CORE att::attn_core_hs
#else
#define ATTN_CORE att::attn_core
#endif
#ifndef SD_AX
#define SD_AX 2
#endif
#ifndef SD_SWA
#define SD_SWA 1
#endif
#ifndef SD_MLA
#define SD_MLA 1
#endif
#ifndef SD_DIFF
#define SD_DIFF 1
#endif
struct AttP { unsigned* stamp; const bf16* Z; const bf16* QM; const bf16* KVM; bf16* BR; const float *c64, *s64; const float* sink; const float* lam_p; const float* subln; float lam_init; const unsigned* kn; const unsigned* kn2; };
__device__ __forceinline__ float kn_load(const unsigned* p) { return ATT_FASTREF ? __uint_as_float(*p) : -1.f; }

__device__ __forceinline__ void unit_axial(Frame& F, const AttP& P, int h, int qb) {
    using namespace att;
    const int tid_ = opq_tid(F.wave), lane = tid_ & 63, r32 = lane & 31, hi = lane >> 5, wid = __builtin_amdgcn_readfirstlane(tid_ >> 6);
    LAS char* lds = (LAS char*)F.lds;
    const int row = qb * 256 + wid * 32 + r32;
    const bf16* Qw = P.Z + (size_t)row * ZP + Z_AQ + h * 128 + hi * 8;
    bf16x8 qr[8];
#pragma unroll
    for (int d0 = 0; d0 < 8; ++d0) qr[d0] = qscale(ld8(Qw + d0 * 16), 0.088388347648318440f * LOG2E);
    f32x16 o[4] = {}; float m_reg = M0, l_reg = 0.f;
    const float scale = 0.088388347648318440f;
#ifdef PROBE_STAMP
    ATTN_CORE<8, false, false>(lds, qr, P.Z + Z_AK + (h >> 1) * 128, P.Z + Z_AV + (h >> 1) * 128, ZP, nullptr, 0, S / KVBLK, scale * LOG2E, 8.f / scale, 0, 0, 0, o, m_reg, l_reg, F.wave, P.stamp);
#else
    ATTN_CORE<8, false, false>(lds, qr, P.Z + Z_AK + (h >> 1) * 128, P.Z + Z_AV + (h >> 1) * 128, ZP, nullptr, 0, S / KVBLK, scale * LOG2E, 8.f / scale, 0, 0, 0, o, m_reg, l_reg, F.wave, kn_load(P.kn + 1));
#endif
    store_o(lds, o, l_reg, P.BR + (size_t)(qb * 256 + wid * 32) * D + 1536 + h * 128, D, F.wave);
}
__device__ __forceinline__ void unit_swa(Frame& F, const AttP& P, int h, int qb) {
    using namespace att;
    const int tid_ = opq_tid(F.wave), lane = tid_ & 63, r32 = lane & 31, hi = lane >> 5, wid = __builtin_amdgcn_readfirstlane(tid_ >> 6);
    LAS char* lds = (LAS char*)F.lds;
    const int row = qb * 256 + wid * 32 + r32;
    const bf16* Qw = P.Z + (size_t)row * ZP + Z_SQ + h * 128 + hi * 8;
    bf16x8 qr[8];
#pragma unroll
    for (int d0 = 0; d0 < 8; ++d0) qr[d0] = qscale(ld8(Qw + d0 * 16), 0.088388347648318440f * LOG2E);
    f32x16 o[4] = {}; float m_reg = M0, l_reg = 0.f;
    const float scale = 0.088388347648318440f, C = scale * LOG2E;
    int k_lo = qb * 256 - 128; if (k_lo < 0) k_lo = 0; int k_hi = qb * 256 + 384; if (k_hi > S) k_hi = S;
    const int NT = (k_hi - k_lo) / KVBLK;
    ATTN_CORE<8, false, true>(lds, qr, P.Z + (size_t)k_lo * ZP + Z_SK + (h >> 1) * 128, P.Z + (size_t)k_lo * ZP + Z_SV + (h >> 1) * 128, ZP, nullptr, 0, NT, C, 8.f / scale, 0, row, k_lo, o, m_reg, l_reg, F.wave);
    l_reg += __builtin_amdgcn_exp2f(P.sink[h] * LOG2E - (ATT_NEGM ? m_reg : m_reg * C));
    store_o(lds, o, l_reg, P.BR + (size_t)(qb * 256 + wid * 32) * D + 1024 + h * 128, D, F.wave);
}
__device__ __forceinline__ void unit_mla(Frame& F, const AttP& P, int h, int qb) {
    using namespace att;
    const int tid_ = opq_tid(F.wave), lane = tid_ & 63, r32 = lane & 31, hi = lane >> 5, wid = __builtin_amdgcn_readfirstlane(tid_ >> 6);
    LAS char* lds = (LAS char*)F.lds;
    const int row = qb * 256 + wid * 32 + r32;
    const bf16* Qw = P.QM + (size_t)row * QM_P + h * 192 + hi * 8;
    bf16x8 qr[8];
    LAS char* QRw = lds + OFF_QR + wid * 4096 + lane * 16;
#pragma unroll
    for (int d0 = 0; d0 < 8; ++d0) qr[d0] = qscale(ld8(Qw + d0 * 16), 0.072168783648703220f * LOG2E);
    float qx2 = 0.f;
#pragma unroll
    for (int d = 0; d < 2; ++d) {
        const v4u wa = __builtin_bit_cast(v4u, ld8(Qw + 128 + d * 16)), wb = __builtin_bit_cast(v4u, ld8(Qw + 160 + d * 16));
        f32x4 a0, a1, b0, b1; pg8::unpack8(wa, a0, a1); pg8::unpack8(wb, b0, b1);
        const float* cp = P.c64 + (size_t)row * 32 + d * 16 + hi * 8; const float* sp = P.s64 + (size_t)row * 32 + d * 16 + hi * 8;
        const f32x4 c0 = *(const f32x4*)cp, c1 = *(const f32x4*)(cp + 4), s0 = *(const f32x4*)sp, s1 = *(const f32x4*)(sp + 4);
        const float qs_ = ATT_NEGM ? 0.072168783648703220f * LOG2E : 1.f;
        const f32x4 n0 = (a0 * c0 - b0 * s0) * qs_, n1 = (a1 * c1 - b1 * s1) * qs_, m0 = (b0 * c0 + a0 * s0) * qs_, m1 = (b1 * c1 + a1 * s1) * qs_;
        qx2 += (n0[0] * n0[0] + n0[1] * n0[1]) + (n0[2] * n0[2] + n0[3] * n0[3]) + (n1[0] * n1[0] + n1[1] * n1[1]) + (n1[2] * n1[2] + n1[3] * n1[3])
             + (m0[0] * m0[0] + m0[1] * m0[1]) + (m0[2] * m0[2] + m0[3] * m0[3]) + (m1[0] * m1[0] + m1[1] * m1[1]) + (m1[2] * m1[2] + m1[3] * m1[3]);
        v4u o1, o2; o1.x = pk2(n0[0], n0[1]); o1.y = pk2(n0[2], n0[3]); o1.z = pk2(n1[0], n1[1]); o1.w = pk2(n1[2], n1[3]);
        o2.x = pk2(m0[0], m0[1]); o2.y = pk2(m0[2], m0[3]); o2.z = pk2(m1[0], m1[1]); o2.w = pk2(m1[2], m1[3]);
        *(LAS v4u*)(QRw + d * 1024) = o1; *(LAS v4u*)(QRw + (2 + d) * 1024) = o2;
    }
    f32x16 o[4] = {}; float m_reg = M0, l_reg = 0.f;
    const float scale = 0.072168783648703220f;
    float kmax2 = -1.f;
    if (ATT_FASTREF) {
        const v4u* g4 = (const v4u*)(P.kn2 + h * 16); const v4u g0 = g4[0], g1 = g4[1], g2 = g4[2], g3 = g4[3];
        kmax2 = __uint_as_float(P.kn[2]) + ((__uint_as_float(g0.x) + __uint_as_float(g0.y)) + (__uint_as_float(g0.z) + __uint_as_float(g0.w))) + ((__uint_as_float(g1.x) + __uint_as_float(g1.y)) + (__uint_as_float(g1.z) + __uint_as_float(g1.w)))
              + ((__uint_as_float(g2.x) + __uint_as_float(g2.y)) + (__uint_as_float(g2.z) + __uint_as_float(g2.w))) + ((__uint_as_float(g3.x) + __uint_as_float(g3.y)) + (__uint_as_float(g3.z) + __uint_as_float(g3.w))); }
    ATTN_CORE<8, true, false>(lds, qr, P.KVM + h * 256, P.KVM + h * 256 + 128, KVM_P, P.Z + Z_KR, ZP, S / KVBLK, scale * LOG2E, 8.f / scale, 0, 0, 0, o, m_reg, l_reg, F.wave, kmax2, qx2);
    store_o(lds, o, l_reg, P.BR + (size_t)(qb * 256 + wid * 32) * D + 0 + h * 128, D, F.wave);
}
__device__ __forceinline__ void unit_diff(Frame& F, const AttP& P, int h, int qb128) {
    using namespace att;
    const int tid_ = opq_tid(F.wave), lane = tid_ & 63, r32 = lane & 31, hi = lane >> 5, wid = __builtin_amdgcn_readfirstlane(tid_ >> 6);
    LAS char* lds = (LAS char*)F.lds;
    const int comp = wid >> 2, wq = wid & 3;
    const int row = qb128 * 128 + wq * 32 + r32;
    const bf16* Qw = P.Z + (size_t)row * ZP + Z_DQ + (2 * h + comp) * 64 + hi * 8;
    bf16x8 qr[4];
#pragma unroll
    for (int d0 = 0; d0 < 4; ++d0) qr[d0] = qscale(ld8(Qw + d0 * 16), 0.125f * LOG2E);
    f32x16 o[4] = {}; float m_reg = M0, l_reg = 0.f;
    const float scale = 0.125f;
    ATTN_CORE<4, false, false>(lds, qr, P.Z + Z_DK + h * 128, P.Z + Z_DV + h * 128, ZP, nullptr, 0, S / KVBLK, scale * LOG2E, 8.f / scale, 4 * comp, 0, 0, o, m_reg, l_reg, F.wave, kn_load(P.kn + 0));
    const float la = wave_sum(P.lam_p[lane] * P.lam_p[64 + lane]), lb = wave_sum(P.lam_p[128 + lane] * P.lam_p[192 + lane]);
    const float lam = expf(la) - expf(lb) + P.lam_init;
    LAS float* li_l = (LAS float*)(lds + OFF_WS) + wid * 64;
    if (hi == 0) li_l[r32] = l_reg; asm volatile("s_waitcnt lgkmcnt(0)" ::: "memory");
#pragma unroll
    for (int r = 0; r < 16; ++r) { const float rl = __builtin_amdgcn_rcpf(li_l[crow(r, hi)]);
#pragma unroll
        for (int d = 0; d < 4; ++d) o[d][r] *= rl; }
    __syncthreads();
    LAS float* X = (LAS float*)lds + wq * 4096;
    if (comp == 1) {
#pragma unroll
        for (int d = 0; d < 4; ++d)
#pragma unroll
            for (int r = 0; r < 16; ++r) X[(d * 16 + r) * 64 + lane] = o[d][r];
    }
    __syncthreads();
    if (comp == 0) {
        float ss[16];
#pragma unroll
        for (int r = 0; r < 16; ++r) { float s = 0.f;
#pragma unroll
            for (int d = 0; d < 4; ++d) { const float v = o[d][r] - lam * X[(d * 16 + r) * 64 + lane]; o[d][r] = v; s += v * v; }
            ss[r] = s; }
#pragma unroll
        for (int r = 0; r < 16; ++r) { float s = sum32(ss[r]);
            ss[r] = (1.0f - P.lam_init) / sqrtf(s * (1.0f / 128.0f) + RMS_EPS); }
        float gn[4];
#pragma unroll
        for (int d = 0; d < 4; ++d) gn[d] = P.subln[d * 32 + r32];
        bf16* Ow = P.BR + (size_t)(qb128 * 128 + wq * 32) * D + 512 + h * 128;
#pragma unroll
        for (int r = 0; r < 16; ++r) { const int orow = crow(r, hi);
#pragma unroll
            for (int d = 0; d < 4; ++d) Ow[(long)orow * D + d * 32 + r32] = (bf16)f2bf(o[d][r] * ss[r] * gn[d]); }
    }
    __syncthreads();
}
__device__ const float INVF128[64] = {
1.000000000e+00f, 8.659643531e-01f, 7.498942018e-01f, 6.493816376e-01f, 5.623413324e-01f, 4.869675338e-01f, 4.216965139e-01f, 3.651741147e-01f, 3.162277639e-01f, 2.738419771e-01f, 2.371373773e-01f, 2.053525001e-01f, 1.778279394e-01f, 1.539926529e-01f, 1.333521456e-01f, 1.154781953e-01f, 1.000000015e-01f, 8.659642935e-02f, 7.498942316e-02f, 6.493816525e-02f, 5.623413250e-02f, 4.869675264e-02f, 4.216964915e-02f, 3.651741147e-02f, 3.162277490e-02f, 2.738419548e-02f, 2.371373773e-02f, 2.053525113e-02f, 1.778279431e-02f, 1.539926510e-02f, 1.333521400e-02f, 1.154781971e-02f, 9.999999776e-03f, 8.659643121e-03f, 7.498942316e-03f, 6.493816152e-03f, 5.623413250e-03f, 4.869675264e-03f, 4.216964822e-03f, 3.651741194e-03f, 3.162277630e-03f, 2.738419687e-03f, 2.371373819e-03f, 2.053525066e-03f, 1.778279431e-03f, 1.539926510e-03f, 1.333521446e-03f, 1.154782018e-03f, 1.000000047e-03f, 8.659643354e-04f, 7.498941850e-04f, 6.493816036e-04f, 5.623413017e-04f, 4.869675322e-04f, 4.216965172e-04f, 3.651741135e-04f, 3.162277571e-04f, 2.738419571e-04f, 2.371373703e-04f, 2.053525095e-04f, 1.778279402e-04f, 1.539926598e-04f, 1.333521504e-04f, 1.154782003e-04f };
__device__ __forceinline__ void sincos_d(double a, float& sn, float& cs) {
    const double k = rint(a * 0.63661977236758134308);
    const double r = (a - k * 1.57079632673412561417e+00) - k * 6.07710050650619224932e-11;
    const double r2 = r * r;
    double ps = -1.0 / 6227020800.0; ps = ps * r2 + 1.0 / 39916800.0; ps = ps * r2 - 1.0 / 362880.0; ps = ps * r2 + 1.0 / 5040.0; ps = ps * r2 - 1.0 / 120.0; ps = ps * r2 + 1.0 / 6.0;
    const double s = r - r * r2 * ps;
    double pc = 1.0 / 87178291200.0; pc = pc * r2 - 1.0 / 479001600.0; pc = pc * r2 + 1.0 / 3628800.0; pc = pc * r2 - 1.0 / 40320.0; pc = pc * r2 + 1.0 / 720.0; pc = pc * r2 - 1.0 / 24.0; pc = pc * r2 + 0.5;
    const double c = 1.0 - r2 * pc;
    const int q = (int)((long long)k & 3);
    const double so = (q == 0) ? s : (q == 1) ? c : (q == 2) ? -s : -c;
    const double co = (q == 0) ? c : (q == 1) ? -s : (q == 2) ? -c : s;
    sn = (float)so; cs = (float)co;
}

#ifndef PHMASK
#define PHMASK 0xFFFFFF
#endif
#define PHEN(i) (((PHMASK) >> (i)) & 1)
#ifndef FUSE_NORM
#define FUSE_NORM 0
#endif
#ifndef G3_HALF
#define G3_HALF 1
#endif
#ifndef I8_ALIGN
#define I8_ALIGN true
#endif
#ifndef GATE_ALIGN
#define GATE_ALIGN true
#endif
#ifndef G1_ALIGN
#define G1_ALIGN true
#endif
#ifndef G3_ALIGN
#define G3_ALIGN true
#endif
#ifndef LEAN_X
#define LEAN_X (GATES_I8 && !MK_DEBUG && !FUSE_NORM)
#endif
#ifndef REP_MASK
#define REP_MASK 0
#endif
#define REPN(i) (1 + (((REP_MASK) >> (i)) & 1))
#ifndef AMASK
#define AMASK 0xF
#endif
#define AEN(i) (((AMASK) >> (i)) & 1)
constexpr int NPH = 12;
constexpr int NPHASES = 1 + DEPTH * NPH;
struct Args { const float* in[24]; float* out; unsigned char* ws; int ph_lo, ph_hi, li, pad; float lam_init[4]; };

__global__ void __launch_bounds__(NWAVES * 64, 2) mk_fwd(Args args) {
    extern __shared__ __attribute__((aligned(16))) unsigned char lds[];
    Frame F;
    F.lds = (LAS unsigned char*)lds;
    F.MISC = (volatile LAS unsigned*)(F.lds + MISC_OFF);
    F.tid = threadIdx.x; F.lane = F.tid & 63; F.wave = __builtin_amdgcn_readfirstlane(F.tid >> 6);
    F.G = gridDim.x; { const int bx = blockIdx.x; F.vcu = (F.G % 8 == 0) ? (bx % 8) * (F.G / 8) + bx / 8 : bx; }
    unsigned char* ws = args.ws;
    F.ctl = (gu32*)(ws + WS_CTL);
    for (int u = F.tid; u < (LDS_BYTES - LDSCTL_OFF) / 4; u += NWAVES * 64) ((LAS unsigned*)(F.lds + LDSCTL_OFF))[u] = 0u;
    __syncthreads();
    XcdBarrier bar = xcd_barrier_post((unsigned*)(F.ctl + CW_BAR) + args.li * XCD_BAR_WORDS, F.MISC + 8, F.wave);
    const int lo = args.ph_lo, hi = args.ph_hi;
#define IN(k) (lo <= (k) && (k) < hi)
#ifdef PROBE_SEAM2
#define SEAM(k) do { if (IN(k) && (k) + 1 < hi && (k) + 1 < NPHASES) { xcd_barrier(bar); xcd_barrier(bar); } } while (0)
#else
#define SEAM(k) do { if (IN(k) && (k) + 1 < hi && (k) + 1 < NPHASES) xcd_barrier(bar); } while (0)
#endif
    float* const X = args.out;
    float* const c64 = (float*)(ws + WS_TAB64); float* const s64 = c64 + (size_t)S * 32;
    float* const c128 = (float*)(ws + WS_TAB128); float* const s128 = c128 + (size_t)S * 64;
    bf16* const Hb = (bf16*)(ws + WS_H); bf16* const Zb = (bf16*)(ws + WS_Z); bf16* const GTb = (bf16*)(ws + WS_GT);
    bf16* const QMb = (bf16*)(ws + WS_QM); bf16* const KVMb = (bf16*)(ws + WS_KVM); bf16* const BRb = (bf16*)(ws + WS_BR);
    bf16* const Yb = (bf16*)(ws + WS_Z); float* const MFf = (float*)(ws + WS_Z); bf16* const MGb = FUSE_NORM ? (bf16*)(ws + WS_Z + 64 * MiB) : Hb; bf16* const XBb = FUSE_NORM ? (bf16*)(ws + WS_Z) : Hb; bf16* const HIDb = GTb; bf16* const P2b = BRb;
    bf16* const PBb = (bf16*)(ws + WS_PB);
    unsigned char* const A8 = (GATES_FP8 || GATES_I8) ? (unsigned char*)(ws + WS_A8) : nullptr;
    float* const SA8 = (float*)(ws + WS_SA); float* const CMf = (float*)(F.ctl + CW_CM);

    if (PHEN(12) && IN(0)) for (int rep_ = 0; rep_ < REPN(12); ++rep_) {
        const int tid_ = opq_tid(F.wave), lane_ = tid_ & 63, wave_ = __builtin_amdgcn_readfirstlane(tid_ >> 6);
        const int gw = F.vcu * NWAVES + wave_, NGW = F.G * NWAVES;
        const int gt = F.vcu * (NWAVES * 64) + tid_, NGT = F.G * NWAVES * 64;
        {
            WSrc wsrc{args.in[7], args.in[9], args.in[11], args.in[17], args.in[18], args.in[19], args.in[20], args.in[21], args.in[22], args.in[23], CMf};
#if GATES_I8
            constexpr int IT_Q = IT_BG + IT_PG + (FFN_I8 ? IT_FI : 0);
            for (int it2 = gw; it2 < DEPTH * IT_Q; it2 += NGW) { const int L2 = DEPTH - 1 - it2 / IT_Q, q2 = it2 % IT_Q;
                const int r2 = q2 < IT_BG ? IT_IN + q2 : (q2 < IT_BG + IT_PG ? IT_LAYER - IT_PG + (q2 - IT_BG) : IT_IN + IT_BG + IT_UQ + IT_UKV + IT_BR + IT_WO + (q2 - IT_BG - IT_PG));
                const WItem wi = witem(wsrc, (bf16*)(ws + WS_W + (size_t)L2 * WL_BYTES), L2, r2); const WRegs rr2 = witem_load(wi, lane_); witem_colmax(wi, rr2, lane_); }
            xcd_barrier(bar);
#endif
            LAS float* scr = (LAS float*)(F.lds + RING_OFF + wave_ * 16384);
            int it = gw;
            if (it < DEPTH * IT_LAYER) {
                WItem cur = witem(wsrc, (bf16*)(ws + WS_W + (size_t)(it / IT_LAYER) * WL_BYTES), it / IT_LAYER, it % IT_LAYER); WRegs rv = witem_load(cur, lane_);
                for (;;) { const int nx = it + NGW; const bool more = nx < DEPTH * IT_LAYER;
                    WItem nxt = cur; WRegs rn = rv;
                    if (more) { nxt = witem(wsrc, (bf16*)(ws + WS_W + (size_t)(nx / IT_LAYER) * WL_BYTES), nx / IT_LAYER, nx % IT_LAYER); rn = witem_load(nxt, lane_); }
                    witem_store(cur, rv, scr, lane_);
                    if (!more) break;
                    cur = nxt; rv = rn; it = nx; }
            }
            for (int i = gt; i < DEPTH * 49152; i += NGT) { const int L = i / 49152, q = i - L * 49152;
                *(v4u*)((bf16*)(ws + WS_W + (size_t)L * WL_BYTES) + WL_W1 + (size_t)ZC * D + (size_t)q * 8) = (v4u){0u, 0u, 0u, 0u}; }
        }
        for (int i = gt; i < S * 32; i += NGT) { const int pos = i >> 5, j = i & 31; const float ang = (float)pos * INVF128[2 * j]; float sn, cs; sincos_d((double)ang, sn, cs); c64[i] = cs; s64[i] = sn; }
        for (int i = gt; i < S * 64; i += NGT) { const int pos = i >> 6, j = i & 63; const float ang = (float)pos * INVF128[j]; float sn, cs; sincos_d((double)ang, sn, cs); c128[i] = cs; s128[i] = sn; }
        { const float* p = args.in[1];
          for (int i = gt; i < DEPTH * S * PLE / 8; i += NGT) { const f32x4 a = *(const f32x4*)(p + (size_t)i * 8), b = *(const f32x4*)(p + (size_t)i * 8 + 4);
              v4u o; o.x = pk2(a[0], a[1]); o.y = pk2(a[2], a[3]); o.z = pk2(b[0], b[1]); o.w = pk2(b[2], b[3]); *(v4u*)(PBb + (size_t)i * 8) = o; } }
        thin_phase<0>(F, args.in[0], nullptr, X, Hb, nullptr, args.in[2], A8, SA8, !LEAN_X);
    }
    SEAM(0);

    for (int L = 0; L < DEPTH; ++L) {
        const int pb = 1 + L * NPH;
        const bf16* WL = (const bf16*)(ws + WS_W + (size_t)L * WL_BYTES);
        if (PHEN(0) && IN(pb + 0)) for (int rep_ = 0; rep_ < REPN(0); ++rep_) {
#if GATES_I8
            { pg8::StaticOrder So; So.init(Hb, D, WL + WL_W1, D, S, ZP, F.G, (int)blockIdx.x);
              pg8::EpiPlain E{Zb, ZP};
              pg8::gemm_phase<pg8::EpiPlain, pg8::StaticOrder>(F.lds + RING_OFF, F.wave, D, D, D, So, E); }
            { pg8::StaticOrder So; So.init((const bf16*)A8, D / 2, WL + WL_W1 + (size_t)ZP * D, D / 2, S, NG, F.G, (int)blockIdx.x);
              pg8::EpiGateI8 E{GTb, SA8, CMf + L * 5 * D};
              pg8::gemm_phase<pg8::EpiGateI8, pg8::StaticOrder, GATE_ALIGN, false, true>(F.lds + RING_OFF, F.wave, D / 2, D / 2, D / 2, So, E); }
#elif GATES_FP8
            { pg8::StaticOrder So; So.init(Hb, D, WL + WL_W1, D, S, ZP, F.G, (int)blockIdx.x);
              pg8::EpiPlain E{Zb, ZP};
              pg8::gemm_phase<pg8::EpiPlain, pg8::StaticOrder>(F.lds + RING_OFF, F.wave, D, D, D, So, E); }
            { pg8::StaticOrder So; So.init((const bf16*)A8, D / 2, WL + WL_W1 + (size_t)ZP * D, D / 2, S, NG, F.G, (int)blockIdx.x);
              pg8::EpiGate E{GTb};
              pg8::gemm_phase<pg8::EpiGate, pg8::StaticOrder, true, true>(F.lds + RING_OFF, F.wave, D, D, D, So, E); }
#else
            pg8::StaticOrder So; So.init(Hb, D, WL + WL_W1, D, S, N1, F.G, (int)blockIdx.x);
            pg8::EpiG1 E{Zb, GTb};
            pg8::gemm_phase<pg8::EpiG1, pg8::StaticOrder, G1_ALIGN>(F.lds + RING_OFF, F.wave, D, D, D, So, E);
#endif
        }
        SEAM(pb + 0);
        if (PHEN(1) && IN(pb + 1)) {
            PrepP P{Zb, c64, s64, c128, s128, args.in[8] + L * 512, args.in[10] + L * 512, args.in[15] + L * 128, args.in[16] + L * 128};
            prep_phase(F, P);
            if (REPN(1) > 1) { PrepP P2{(bf16*)(ws + WS_END), c64, s64, c128, s128, args.in[8] + L * 512, args.in[10] + L * 512, args.in[15] + L * 128, args.in[16] + L * 128}; prep_phase(F, P2); }
#ifdef REP_BARRIERS
            for (int rb_ = 0; rb_ < REP_BARRIERS; ++rb_) xcd_barrier(bar);
#endif
        }
        SEAM(pb + 1);
        if (PHEN(2) && IN(pb + 2)) for (int rep_ = 0; rep_ < REPN(2); ++rep_) {
            pg8::OrderG2 So{Zb, WL + WL_UQKV, F.G, (int)blockIdx.x};
            pg8::EpiG2 E{QMb, KVMb, (ATT_NEGM && ATT_FASTREF && rep_ == 0) ? (unsigned*)(F.ctl + CW_KN2) + L * 64 : nullptr};
            pg8::gemm_phase<pg8::EpiG2, pg8::OrderG2>(F.lds + RING_OFF, F.wave, 512, ZP, 512, So, E);
#if ATT_NEGM && ATT_FASTREF
            if (rep_ == 0) knorm_pass(F, Zb, (unsigned*)(F.ctl + CW_KN) + L * 4);
#endif
        }
        SEAM(pb + 2);
        if (PHEN(3) && IN(pb + 3)) for (int rep_ = 0; rep_ < REPN(3); ++rep_) {
            AttP P{(L == 0) ? (unsigned*)(F.ctl + 200) : nullptr, Zb, QMb, KVMb, BRb, c64, s64, args.in[14] + L * 4, args.in[12] + L * 256, args.in[13] + L * 128, args.lam_init[L], (const unsigned*)(F.ctl + CW_KN) + L * 4, (const unsigned*)(F.ctl + CW_KN2) + L * 64};
            if (AEN(0)) for (int u = F.vcu; u < 256; u += F.G) unit_mla(F, P, u >> 6, u & 63);
            __syncthreads();
#if defined(PROBE_MIDBAR) && PROBE_MIDBAR >= 2
            xcd_barrier(bar);
#endif
            if (AEN(1)) for (int u = F.vcu; u < 256; u += F.G) unit_axial(F, P, u >> 6, u & 63);
            __syncthreads();
#ifdef PROBE_MIDBAR
            xcd_barrier(bar);
#endif
            if (AEN(2)) for (int u = F.vcu; u < 256; u += F.G) {
_Pragma("unroll 1")
                for (int i2 = 0; i2 < 2; ++i2) { const int uu = 2 * u + i2; unit_diff(F, P, uu >> 7, uu & 127);
#if defined(PROBE_MIDBAR) && PROBE_MIDBAR >= 2
                    xcd_barrier(bar);
#endif
                } }
            if (AEN(3)) for (int u = F.vcu; u < 256; u += F.G) unit_swa(F, P, u >> 6, u & 63);
            __syncthreads();
        }
        SEAM(pb + 3);
        if (PHEN(4) && IN(pb + 4)) for (int rep_ = 0; rep_ < REPN(4); ++rep_) {
#if G3_HALF
            pg8::OrderG3h So{BRb, WL + WL_BR, F.G, (int)blockIdx.x};
            pg8::EpiG3h E{GTb, MGb};
            pg8::gemm_phase_h<pg8::EpiG3h, pg8::OrderG3h>(F.lds + RING_OFF, F.wave, 512, D, 512, So, E);
#else
            pg8::OrderG3 So{BRb, WL + WL_BR, F.G, (int)blockIdx.x};
            pg8::EpiG3 E{GTb, (bf16*)MFf, MGb};
            pg8::gemm_phase<pg8::EpiG3, pg8::OrderG3, G3_ALIGN>(F.lds + RING_OFF, F.wave, 512, D, 512, So, E);
#endif
        }
        SEAM(pb + 4);
#define XCHI(k) pg8::RmsXchg{(float*)(ws + WS_XCH + (size_t)(L * 6 + (k)) * 512 * 1024), (unsigned*)(F.ctl + CW_SEAM + (L * 6 + (k)) * SEAM_BANK), (unsigned*)(F.ctl + CW_TMO)}
        if (PHEN(5) && IN(pb + 5)) for (int rep_ = 0; rep_ < REPN(5); ++rep_) {
#if FUSE_NORM
            pg8::EpiNorm<0, 1> E{X, Hb, nullptr, args.in[3] + L * D, args.in[4] + L * D, XCHI(0), XCHI(1)};
            { pg8::PanelOrder So{MGb, WL + WL_WO, D, D, F.G, (int)blockIdx.x, 0}; pg8::gemm_phase<pg8::EpiNorm<0, 1>, pg8::PanelOrder>(F.lds + RING_OFF, F.wave, D, D, D, So, E); }
            { pg8::PanelOrder So{MGb, WL + WL_WO, D, D, F.G, (int)blockIdx.x, 1}; pg8::gemm_phase<pg8::EpiNorm<0, 1>, pg8::PanelOrder>(F.lds + RING_OFF, F.wave, D, D, D, So, E); }
#else
#ifdef PANEL_PLAIN
            pg8::EpiPlain E{Yb, D};
            { pg8::PanelOrder So{MGb, WL + WL_WO, D, D, F.G, (int)blockIdx.x, 0}; pg8::gemm_phase<pg8::EpiPlain, pg8::PanelOrder>(F.lds + RING_OFF, F.wave, D, D, D, So, E); }
            { pg8::PanelOrder So{MGb, WL + WL_WO, D, D, F.G, (int)blockIdx.x, 1}; pg8::gemm_phase<pg8::EpiPlain, pg8::PanelOrder>(F.lds + RING_OFF, F.wave, D, D, D, So, E); }
#else
            pg8::StaticOrder So; So.init(MGb, D, WL + WL_WO, D, S, D, F.G, (int)blockIdx.x);
            pg8::EpiPlain E{Yb, D};
            pg8::gemm_phase<pg8::EpiPlain, pg8::StaticOrder>(F.lds + RING_OFF, F.wave, D, D, D, So, E);
#endif
#endif
        }
        SEAM(pb + 5);
#if !FUSE_NORM
        if (PHEN(6) && IN(pb + 6)) { thin_phase<1>(F, (LEAN_X && L == 0) ? args.in[0] : nullptr, Yb, X, (GATES_I8 && FFN_I8 && !MK_DEBUG) ? nullptr : Hb, args.in[3] + L * D, args.in[4] + L * D, (GATES_I8 && FFN_I8) ? A8 : nullptr, SA8);
            if (REPN(6) > 1) thin_phase<4>(F, X, Yb, (float*)GTb, GTb + (size_t)S * D * 2, args.in[3] + L * D, args.in[4] + L * D); }
        SEAM(pb + 6);
#endif
        if (PHEN(7) && IN(pb + 7)) for (int rep_ = 0; rep_ < REPN(7); ++rep_) {
#if GATES_I8 && FFN_I8
            pg8::StaticOrder So; So.init((const bf16*)A8, D / 2, WL + WL_FI, D / 2, S, 2 * FF, F.G, (int)blockIdx.x);
            pg8::EpiSwiGLUI8 E{HIDb, SA8, CMf + (CW_CMF - CW_CM) + L * 2 * FF};
            pg8::gemm_phase<pg8::EpiSwiGLUI8, pg8::StaticOrder, I8_ALIGN, false, true>(F.lds + RING_OFF, F.wave, D / 2, D / 2, D / 2, So, E);
#else
            pg8::StaticOrder So; So.init(Hb, D, WL + WL_FI, D, S, 2 * FF, F.G, (int)blockIdx.x);
            pg8::EpiSwiGLU E{HIDb};
            pg8::gemm_phase<pg8::EpiSwiGLU, pg8::StaticOrder>(F.lds + RING_OFF, F.wave, D, D, D, So, E);
#endif
        }
        SEAM(pb + 7);
        if (PHEN(8) && IN(pb + 8)) for (int rep_ = 0; rep_ < REPN(8); ++rep_) {
#if FUSE_NORM
            { pg8::EpiNorm<0, 2> E{X, XBb, nullptr, args.in[5] + L * D, nullptr, XCHI(2), XCHI(2)};
              { pg8::PanelOrder So{HIDb, WL + WL_FO, FF, FF, F.G, (int)blockIdx.x, 0}; pg8::gemm_phase<pg8::EpiNorm<0, 2>, pg8::PanelOrder>(F.lds + RING_OFF, F.wave, FF, FF, FF, So, E); }
              { pg8::PanelOrder So{HIDb, WL + WL_FO, FF, FF, F.G, (int)blockIdx.x, 1}; pg8::gemm_phase<pg8::EpiNorm<0, 2>, pg8::PanelOrder>(F.lds + RING_OFF, F.wave, FF, FF, FF, So, E); } }
#else
#ifdef PANEL_PLAIN
            { pg8::EpiPlain E{Yb, D};
              { pg8::PanelOrder So{HIDb, WL + WL_FO, FF, FF, F.G, (int)blockIdx.x, 0}; pg8::gemm_phase<pg8::EpiPlain, pg8::PanelOrder>(F.lds + RING_OFF, F.wave, FF, FF, FF, So, E); }
              { pg8::PanelOrder So{HIDb, WL + WL_FO, FF, FF, F.G, (int)blockIdx.x, 1}; pg8::gemm_phase<pg8::EpiPlain, pg8::PanelOrder>(F.lds + RING_OFF, F.wave, FF, FF, FF, So, E); } }
#else
            { pg8::StaticOrder So; So.init(HIDb, FF, WL + WL_FO, FF, S, D, F.G, (int)blockIdx.x);
              pg8::EpiPlain E{Yb, D};
              pg8::gemm_phase<pg8::EpiPlain, pg8::StaticOrder>(F.lds + RING_OFF, F.wave, FF, FF, FF, So, E); }
#endif
#endif
            { pg8::StaticOrder So; So.init(PBb + (size_t)L * S * PLE, PLE, WL + WL_PLE, PLE, S, D, F.G, (int)blockIdx.x);
              pg8::EpiPlain E{P2b, D};
              pg8::gemm_phase<pg8::EpiPlain, pg8::StaticOrder>(F.lds + RING_OFF, F.wave, PLE, PLE, PLE, So, E); }
        }
        SEAM(pb + 8);
#if !FUSE_NORM
        if (PHEN(9) && IN(pb + 9)) { thin_phase<2>(F, nullptr, Yb, X, Hb, args.in[5] + L * D, nullptr, A8, SA8, !LEAN_X);
            if (REPN(9) > 1) thin_phase<4>(F, X, Yb, (float*)GTb, GTb + (size_t)S * D * 2, args.in[5] + L * D, args.in[5] + L * D); }
        SEAM(pb + 9);
#endif
        if (PHEN(10) && IN(pb + 10)) for (int rep_ = 0; rep_ < REPN(10); ++rep_) {
#if FUSE_NORM
            if (L + 1 < DEPTH) { pg8::EpiNorm<1, 1> E{X, Hb, P2b, args.in[6] + L * D, args.in[2] + (L + 1) * D, XCHI(3), XCHI(4)};
                { pg8::PanelOrder So{XBb, WL + WL_PG, D, D, F.G, (int)blockIdx.x, 0}; pg8::gemm_phase<pg8::EpiNorm<1, 1>, pg8::PanelOrder>(F.lds + RING_OFF, F.wave, D, D, D, So, E); }
                { pg8::PanelOrder So{XBb, WL + WL_PG, D, D, F.G, (int)blockIdx.x, 1}; pg8::gemm_phase<pg8::EpiNorm<1, 1>, pg8::PanelOrder>(F.lds + RING_OFF, F.wave, D, D, D, So, E); } }
            else { pg8::EpiNorm<1, 0> E{X, nullptr, P2b, args.in[6] + L * D, nullptr, XCHI(3), XCHI(3)};
                { pg8::PanelOrder So{XBb, WL + WL_PG, D, D, F.G, (int)blockIdx.x, 0}; pg8::gemm_phase<pg8::EpiNorm<1, 0>, pg8::PanelOrder>(F.lds + RING_OFF, F.wave, D, D, D, So, E); }
                { pg8::PanelOrder So{XBb, WL + WL_PG, D, D, F.G, (int)blockIdx.x, 1}; pg8::gemm_phase<pg8::EpiNorm<1, 0>, pg8::PanelOrder>(F.lds + RING_OFF, F.wave, D, D, D, So, E); } }
#else
#if GATES_I8
            pg8::EpiPleI8 E8{P2b, LEAN_X ? GTb : Yb, SA8, CMf + (L * 5 + 4) * D};
            pg8::StaticOrder So8; So8.init((const bf16*)A8, D / 2, WL + WL_PG, D / 2, S, D, F.G, (int)blockIdx.x);
            pg8::gemm_phase<pg8::EpiPleI8, pg8::StaticOrder, I8_ALIGN, false, true>(F.lds + RING_OFF, F.wave, D / 2, D / 2, D / 2, So8, E8);
#else
            pg8::EpiPle E{P2b, Yb};
#if GATES_FP8
            pg8::StaticOrder So; So.init((const bf16*)A8, D / 2, WL + WL_PG, D / 2, S, D, F.G, (int)blockIdx.x);
            pg8::gemm_phase<pg8::EpiPle, pg8::StaticOrder, true, true>(F.lds + RING_OFF, F.wave, D, D, D, So, E);
#else
            pg8::StaticOrder So; So.init(Hb, D, WL + WL_PG, D, S, D, F.G, (int)blockIdx.x);
            pg8::gemm_phase<pg8::EpiPle, pg8::StaticOrder>(F.lds + RING_OFF, F.wave, D, D, D, So, E);
#endif
#endif
#endif
        }
        SEAM(pb + 10);
#if !FUSE_NORM
        if (PHEN(11) && IN(pb + 11)) {
#if LEAN_X
            if (L + 1 < DEPTH) thin_phase<1, true>(F, nullptr, Yb, X, Hb, args.in[5] + L * D, args.in[2] + (L + 1) * D, A8, SA8, true, GTb, args.in[6] + L * D);
            else thin_phase<3, true>(F, nullptr, Yb, X, Hb, args.in[5] + L * D, nullptr, nullptr, nullptr, true, GTb, args.in[6] + L * D);
#else
            if (L + 1 < DEPTH) thin_phase<1>(F, nullptr, Yb, X, Hb, args.in[6] + L * D, args.in[2] + (L + 1) * D, A8, SA8);
            else thin_phase<3>(F, nullptr, Yb, X, Hb, args.in[6] + L * D, nullptr);
#endif
            if (REPN(11) > 1) thin_phase<4>(F, X, Yb, (float*)GTb, GTb + (size_t)S * D * 2, args.in[6] + L * D, args.in[6] + L * D);
        }
        SEAM(pb + 11);
#endif
    }
#undef IN
#undef SEAM
}
extern "C" void kernel_launch(void* const* d_in, const int* in_sizes, int n_in, void* d_out, int out_size, void* d_ws, size_t ws_size, hipStream_t stream) {
    static int grid = 0;
    if (grid == 0) {
        const size_t need = MK_DEBUG ? WS_DBG_END : WS_END4;
        if (n_in != 24 || in_sizes[0] != S * D || out_size != S * D || ws_size < need) {
            fprintf(stderr, "kernel_launch: built for 24 inputs, x and out of %d floats, >= %zu bytes of workspace; got n_in %d, in0 %d, out %d, ws %zu; nothing launched\n", S * D, need, n_in, n_in > 0 ? in_sizes[0] : -1, out_size, ws_size);
            grid = -1; return; }
        int dev = 0, cus = 0, per_cu = 0;
        if (hipGetDevice(&dev) != hipSuccess || hipDeviceGetAttribute(&cus, hipDeviceAttributeMultiprocessorCount, dev) != hipSuccess) { fprintf(stderr, "kernel_launch: hipGetDevice / hipDeviceGetAttribute failed\n"); grid = -1; return; }
        if (hipFuncSetAttribute((const void*)mk_fwd, hipFuncAttributeMaxDynamicSharedMemorySize, LDS_BYTES) != hipSuccess) { fprintf(stderr, "kernel_launch: hipFuncSetAttribute failed\n"); grid = -1; return; }
        if (hipOccupancyMaxActiveBlocksPerMultiprocessor(&per_cu, (const void*)mk_fwd, NWAVES * 64, LDS_BYTES) != hipSuccess || per_cu < 1)
            fprintf(stderr, "kernel_launch: note: the occupancy query reports %d workgroups per CU\n", per_cu);
        (void)hipGetLastError();
        grid = cus;
    }
    if (grid < 0) return;
    if (hipMemsetAsync((char*)d_ws + WS_CTL, 0, CTL_ZERO_BYTES, stream) != hipSuccess) { fprintf(stderr, "kernel_launch: hipMemsetAsync failed\n"); return; }
    Args a{};
    for (int i = 0; i < 24; ++i) a.in[i] = (const float*)d_in[i];
    a.out = (float*)d_out; a.ws = (unsigned char*)d_ws;
    for (int i = 0; i < DEPTH; ++i) a.lam_init[i] = (float)(0.8 - 0.6 * exp(-0.3 * (double)i));
#if MK_DEBUG
    for (int ph = 0; ph < NPHASES; ++ph) {
        a.ph_lo = ph; a.ph_hi = ph + 1; a.li = 0;
        dbg_pre(ph, a, stream);
        hipLaunchKernelGGL(mk_fwd, dim3(grid), dim3(NWAVES * 64), LDS_BYTES, stream, a);
        dbg_post(ph, a, stream);
    }
    dbg_final(a, stream);
#else
    a.ph_lo = 0; a.ph_hi = NPHASES; a.li = 0;
    hipLaunchKernelGGL(mk_fwd, dim3(grid), dim3(NWAVES * 64), LDS_BYTES, stream, a);
#endif
    const hipError_t le = hipPeekAtLastError();
    if (le != hipSuccess) fprintf(stderr, "kernel_launch: launch failed: %s (grid %d)\n", hipGetErrorName(le), grid);
}
```
